# Optimizing an MI355X kernel written in HIP

```python
import math
import jax, jax.numpy as jnp
from jax import lax
import numpy as np

D_MODEL = 1024
BATCH = 8
SEQ = 4096
DEPTH = 1

HY_WIDTH = 512
HY_GROUPS = 8
HY_ORDER = 2
HY_EMB = 33
HY_BANDS = (HY_EMB - 1) // 2
HY_FILT_HIDDEN = 64
HY_FAST_DECAY = 0.3
HY_SLOW_DECAY = 1.5
HY_DECAY_TARGET = 1e-2
HY_MAX_DECAY = math.log(HY_DECAY_TARGET) / HY_FAST_DECAY
HY_MIN_DECAY = math.log(HY_DECAY_TARGET) / HY_SLOW_DECAY
HY_COLS = 3 * HY_WIDTH

RW_WIDTH = 512
RW_HEAD = 64
RW_HEADS = RW_WIDTH // RW_HEAD
RW_LORA_W = 64
RW_LORA_A = 64
RW_LORA_G = 128
RW_GN_EPS = 64e-5
RW_SIZES = [RW_WIDTH, RW_WIDTH, RW_WIDTH, RW_LORA_W, RW_LORA_W, RW_LORA_A, RW_LORA_A, RW_LORA_G]
RW_OFFSETS = [sum(RW_SIZES[:i + 1]) for i in range(len(RW_SIZES) - 1)]
RW_COLS = sum(RW_SIZES)

GATE_COLS = 2 * D_MODEL
IN_COLS = HY_COLS + RW_COLS + GATE_COLS

FFN_HIDDEN = ((8 * D_MODEL + 3 * 256 - 1) // (3 * 256)) * 256

DN_ALPHA = (2.0 * DEPTH) ** 0.25
DN_BETA = (8.0 * DEPTH) ** -0.25
LN_EPS = 1e-5

kernel_name = "hyena_rwkv7_gated_hybrid_encoder_layer"


def layer_norm(x, w, b):
    xf = x.astype(jnp.float32)
    mu = jnp.mean(xf, axis=-1, keepdims=True)
    var = jnp.mean(jnp.square(xf - mu), axis=-1, keepdims=True)
    return ((xf - mu) * lax.rsqrt(var + LN_EPS) * w + b).astype(x.dtype)


def shift_prev(z):
    return jnp.pad(z[:, :-1], ((0, 0), (1, 0), (0, 0)))


def shift_next(z):
    return jnp.pad(z[:, 1:], ((0, 0), (0, 1), (0, 0)))


def short_conv3(z, w, b):
    return w[0] * shift_prev(z) + w[1] * z + w[2] * shift_next(z) + b


def hyena_filters(L, fw1, fb1, fw2, fb2, fw3, fb3, fw4, sin_freq):
    f32 = jnp.float32
    t = jnp.linspace(0.0, 1.0, L, dtype=f32)[:, None]
    w = 2.0 * math.pi * jnp.arange(L, dtype=f32) / L
    f = jnp.linspace(1e-4, HY_BANDS - 1, HY_BANDS, dtype=f32)
    ang = w[:, None] * f[None, :]
    feats = jnp.concatenate([t, jnp.cos(ang), -jnp.sin(ang)], axis=-1)
    sf = sin_freq.astype(f32)
    h = jnp.sin(sf[0] * (feats @ fw1.astype(f32) + fb1.astype(f32)))
    h = jnp.sin(sf[1] * (h @ fw2.astype(f32) + fb2.astype(f32)))
    h = jnp.sin(sf[2] * (h @ fw3.astype(f32) + fb3.astype(f32)))
    h = (h @ fw4.astype(f32)).reshape(L, HY_ORDER, 2, HY_WIDTH)
    deltas = jnp.abs(jnp.linspace(HY_MIN_DECAY, HY_MAX_DECAY, HY_WIDTH, dtype=f32))
    window = jnp.exp(-t * deltas[None, :])
    return h * window[:, None, None, :]


def long_conv(z, h_fwd, h_bwd, d_skip):
    L = z.shape[1]
    n = 2 * L
    zf = jnp.fft.rfft(z, n=n, axis=1)
    hf = jnp.fft.rfft(h_fwd, n=n, axis=0) + jnp.conj(jnp.fft.rfft(h_bwd, n=n, axis=0))
    y = jnp.fft.irfft(zf * hf[None], n=n, axis=1)[:, :L]
    return y + z * d_skip


def hyena_mixer(u, conv_w, conv_b, fw1, fb1, fw2, fb2, fw3, fb3, fw4, sin_freq, skip):
    L = u.shape[1]
    u = short_conv3(u, conv_w, conv_b).astype(jnp.float32)
    v, x1, x2 = jnp.split(u, 3, axis=-1)
    h = hyena_filters(L, fw1, fb1, fw2, fb2, fw3, fb3, fw4, sin_freq)
    sk = skip.astype(jnp.float32)
    z = x1 * long_conv(v, h[:, 0, 0], h[:, 0, 1], sk[0])
    z = x2 * long_conv(z, h[:, 1, 0], h[:, 1, 1], sk[1])
    return z


def rwkv_step(S, inp):
    r, w, k, v, kk, a = inp
    sa = jnp.einsum('dbhvk,dbhk->dbhv', S, -kk)
    S = S * w[..., None, :] + sa[..., :, None] * (kk * a)[..., None, :] + v[..., :, None] * k[..., None, :]
    y = jnp.einsum('dbhvk,dbhk->dbhv', S, r)
    return S, y


def rwkv_mixer(u, mu, w0, w2, a0, a2, g2, k_k, k_a, r_k, gn_w, gn_b):
    f32 = jnp.float32
    B, L, _ = u.shape
    u = u + mu * (0.5 * (shift_prev(u) + shift_next(u)) - u)
    r, k, v, wd_f, wd_b, ad_f, ad_b, gd = jnp.split(u.astype(f32), RW_OFFSETS, axis=-1)
    d = w0.astype(f32)[:, None, None, :] + jnp.einsum('dblr,drc->dblc', jnp.tanh(jnp.stack([wd_f, wd_b])), w2.astype(f32))
    decay = jnp.exp(-math.exp(-0.5) * jax.nn.sigmoid(d))
    a = jax.nn.sigmoid(a0.astype(f32)[:, None, None, :] + jnp.einsum('dblr,drc->dblc', jnp.stack([ad_f, ad_b]), a2.astype(f32)))
    g = jax.nn.sigmoid(gd) @ g2.astype(f32)

    def heads(z):
        return z.reshape(z.shape[:-1] + (RW_HEADS, RW_HEAD))

    kk = heads(k * k_k.astype(f32))
    kk = kk / jnp.maximum(jnp.sqrt(jnp.sum(kk * kk, axis=-1, keepdims=True)), 1e-12)
    kd = heads(k[None] * (1.0 + (a - 1.0) * k_a.astype(f32)))
    r_h, v_h, w_h, a_h = heads(r), heads(v), heads(decay), heads(a)

    def dirs(z_f, z_b):
        return jnp.moveaxis(jnp.stack([z_f, z_b[:, ::-1]]), 2, 0)

    xs = (dirs(r_h, r_h), dirs(w_h[0], w_h[1]), dirs(kd[0], kd[1]),
          dirs(v_h, v_h), dirs(kk, kk), dirs(a_h[0], a_h[1]))
    S0 = jnp.zeros((2, B, RW_HEADS, RW_HEAD, RW_HEAD), f32)
    _, ys = lax.scan(rwkv_step, S0, xs)
    ys = jnp.moveaxis(ys, 0, 2)
    y = ys[0] + ys[1][:, ::-1]
    mu_y = jnp.mean(y, axis=-1, keepdims=True)
    var_y = jnp.mean(jnp.square(y - mu_y), axis=-1, keepdims=True)
    y = (y - mu_y) * lax.rsqrt(var_y + RW_GN_EPS) * heads(gn_w.astype(f32)) + heads(gn_b.astype(f32))
    bonus = jnp.sum(r_h[None] * kd * r_k.astype(f32), axis=-1, keepdims=True) * v_h[None]
    y = y + jnp.sum(bonus, axis=0)
    return y.reshape(B, L, RW_WIDTH) * g


def hybrid_layer(x, w_in, hy_conv_w, hy_conv_b, hy_filt_w1, hy_filt_b1, hy_filt_w2, hy_filt_b2,
                 hy_filt_w3, hy_filt_b3, hy_filt_w4, hy_sin_freq, hy_skip, rw_mu, rw_w0, rw_w2,
                 rw_a0, rw_a2, rw_g2, rw_k_k, rw_k_a, rw_r_k, rw_gn_w, rw_gn_b, w_hy_out, w_rw_out,
                 w_o, ln1_w, ln1_b, ffn_w_gate, ffn_w_up, ffn_w_down, ln2_w, ln2_b):
    dt = x.dtype
    proj = x @ w_in
    u_h, u_r, gates = jnp.split(proj, [HY_COLS, HY_COLS + RW_COLS], axis=-1)
    y_h = hyena_mixer(u_h, hy_conv_w, hy_conv_b, hy_filt_w1, hy_filt_b1, hy_filt_w2, hy_filt_b2,
                      hy_filt_w3, hy_filt_b3, hy_filt_w4, hy_sin_freq, hy_skip).astype(dt) @ w_hy_out
    y_r = rwkv_mixer(u_r, rw_mu, rw_w0, rw_w2, rw_a0, rw_a2, rw_g2, rw_k_k, rw_k_a, rw_r_k,
                     rw_gn_w, rw_gn_b).astype(dt) @ w_rw_out
    g_h, g_r = jnp.split(jax.nn.sigmoid(gates), 2, axis=-1)
    mix = (g_h * y_h + g_r * y_r) @ w_o
    x = layer_norm(DN_ALPHA * x + mix, ln1_w, ln1_b)
    ffn = (jax.nn.silu(x @ ffn_w_gate) * (x @ ffn_w_up)) @ ffn_w_down
    return layer_norm(DN_ALPHA * x + ffn, ln2_w, ln2_b)


def setup_inputs(seed: int = 0) -> dict:
    key = jax.random.key(seed)
    keys = iter(jax.random.split(key, 48))

    def nrm(shape, scale):
        return jax.random.normal(next(keys), shape, jnp.float32) * scale

    Ld = DEPTH
    return {
        "x": nrm((BATCH, SEQ, D_MODEL), 1.0),
        "w_in": nrm((Ld, D_MODEL, IN_COLS), D_MODEL ** -0.5),
        "hy_conv_w": nrm((Ld, 3, HY_COLS), 3 ** -0.5),
        "hy_conv_b": nrm((Ld, HY_COLS), 0.02),
        "hy_filt_w1": nrm((Ld, HY_EMB, HY_FILT_HIDDEN), HY_EMB ** -0.5),
        "hy_filt_b1": nrm((Ld, HY_FILT_HIDDEN), 0.1),
        "hy_filt_w2": nrm((Ld, HY_FILT_HIDDEN, HY_FILT_HIDDEN), HY_FILT_HIDDEN ** -0.5),
        "hy_filt_b2": nrm((Ld, HY_FILT_HIDDEN), 0.1),
        "hy_filt_w3": nrm((Ld, HY_FILT_HIDDEN, HY_FILT_HIDDEN), HY_FILT_HIDDEN ** -0.5),
        "hy_filt_b3": nrm((Ld, HY_FILT_HIDDEN), 0.1),
        "hy_filt_w4": nrm((Ld, HY_FILT_HIDDEN, HY_ORDER * 2 * HY_WIDTH), 0.1 * HY_FILT_HIDDEN ** -0.5),
        "hy_sin_freq": 1.0 + nrm((Ld, 3, HY_FILT_HIDDEN), 0.05),
        "hy_skip": nrm((Ld, HY_ORDER, HY_WIDTH), 0.5),
        "rw_mu": 0.5 + nrm((Ld, RW_COLS), 0.1),
        "rw_w0": -0.5 + nrm((Ld, 2, RW_WIDTH), 0.5),
        "rw_w2": nrm((Ld, 2, RW_LORA_W, RW_WIDTH), 0.5 * RW_LORA_W ** -0.5),
        "rw_a0": nrm((Ld, 2, RW_WIDTH), 0.1),
        "rw_a2": nrm((Ld, 2, RW_LORA_A, RW_WIDTH), 0.5 * RW_LORA_A ** -0.5),
        "rw_g2": nrm((Ld, RW_LORA_G, RW_WIDTH), RW_LORA_G ** -0.5),
        "rw_k_k": 0.85 + nrm((Ld, RW_WIDTH), 0.05),
        "rw_k_a": 1.0 + nrm((Ld, RW_WIDTH), 0.05),
        "rw_r_k": nrm((Ld, RW_HEADS, RW_HEAD), 0.1),
        "rw_gn_w": 1.0 + nrm((Ld, RW_WIDTH), 0.05),
        "rw_gn_b": nrm((Ld, RW_WIDTH), 0.02),
        "w_hy_out": nrm((Ld, HY_WIDTH, D_MODEL), HY_WIDTH ** -0.5),
        "w_rw_out": nrm((Ld, RW_WIDTH, D_MODEL), RW_WIDTH ** -0.5),
        "w_o": nrm((Ld, D_MODEL, D_MODEL), DN_BETA * D_MODEL ** -0.5),
        "ln1_w": 1.0 + nrm((Ld, D_MODEL), 0.05),
        "ln1_b": nrm((Ld, D_MODEL), 0.02),
        "ffn_w_gate": nrm((Ld, D_MODEL, FFN_HIDDEN), D_MODEL ** -0.5),
        "ffn_w_up": nrm((Ld, D_MODEL, FFN_HIDDEN), D_MODEL ** -0.5),
        "ffn_w_down": nrm((Ld, FFN_HIDDEN, D_MODEL), DN_BETA * FFN_HIDDEN ** -0.5),
        "ln2_w": 1.0 + nrm((Ld, D_MODEL), 0.05),
        "ln2_b": nrm((Ld, D_MODEL), 0.02),
    }


def reference(x, w_in, hy_conv_w, hy_conv_b, hy_filt_w1, hy_filt_b1, hy_filt_w2, hy_filt_b2,
              hy_filt_w3, hy_filt_b3, hy_filt_w4, hy_sin_freq, hy_skip, rw_mu, rw_w0, rw_w2,
              rw_a0, rw_a2, rw_g2, rw_k_k, rw_k_a, rw_r_k, rw_gn_w, rw_gn_b, w_hy_out, w_rw_out,
              w_o, ln1_w, ln1_b, ffn_w_gate, ffn_w_up, ffn_w_down, ln2_w, ln2_b):
    for l in range(DEPTH):
        x = hybrid_layer(x, w_in[l], hy_conv_w[l], hy_conv_b[l], hy_filt_w1[l], hy_filt_b1[l],
                         hy_filt_w2[l], hy_filt_b2[l], hy_filt_w3[l], hy_filt_b3[l], hy_filt_w4[l],
                         hy_sin_freq[l], hy_skip[l], rw_mu[l], rw_w0[l], rw_w2[l], rw_a0[l],
                         rw_a2[l], rw_g2[l], rw_k_k[l], rw_k_a[l], rw_r_k[l], rw_gn_w[l], rw_gn_b[l],
                         w_hy_out[l], w_rw_out[l], w_o[l], ln1_w[l], ln1_b[l], ffn_w_gate[l],
                         ffn_w_up[l], ffn_w_down[l], ln2_w[l], ln2_b[l])
    return x
```

```cpp
#include <hip/hip_runtime.h>
#include <hip/hip_cooperative_groups.h>
#include <cstdio>
#include <cstdint>
namespace cg = cooperative_groups;
namespace pg8 {
#define PG8_LAS __attribute__((address_space(3)))
typedef unsigned short bf16_t;
typedef short bf16x8 __attribute__((ext_vector_type(8)));
typedef float f32x4 __attribute__((ext_vector_type(4)));
typedef unsigned u32x4 __attribute__((ext_vector_type(4)));
constexpr int BM = 256, BK = 64, HALF = 128, HTB = HALF * BK * 2  , STAGE_BYTES = 8 * HTB, NXCD = 8, WGM = 8;

__host__ __device__ __forceinline__ int lds_byte(int r, int c) { const int st = (r >> 4) * 2 + (c >> 5), rr = r & 15, cc = c & 31, ob = rr * 64 + cc * 2; return st * 1024 + (ob ^ (((ob >> 9) & 1) << 5)); }
__host__ __device__ __forceinline__ void stage_rc(int b, int& R, int& C) { const int st = b / 1024, sb = b % 1024, swz = sb ^ (((sb >> 9) & 1) << 5); R = (st >> 1) * 16 + swz / 64; C = (st & 1) * 32 + (swz % 64) / 2; }
__host__ __device__ __forceinline__ int perm32(int rho) { const int n = rho >> 4, i = rho & 15; return 8 * (i >> 2) + 4 * n + (i & 3); }

struct Unit { int pm, pn; };
struct Gemm { const bf16_t* A; const bf16_t* Bt; int M, N, K; };

struct StaticOrder {
    int nM, nN, nwg, G, c;
    __host__ __device__ void init(int M, int N, int G_, int c_) { nM = M / BM; nN = N / BM; nwg = nM * nN; G = G_; c = c_; }
    __host__ __device__ bool next(int i, Unit& u) const {
        const long L = (long)i * G + c; if (L >= nwg) return false;
        int wgid = (int)L; { const int q = nwg / NXCD, r = nwg % NXCD, xcd = wgid % NXCD, off = wgid / NXCD; wgid = (xcd < r ? xcd * (q + 1) : r * (q + 1) + (xcd - r) * q) + off; }
        const int nig = WGM * nN, gid = wgid / nig, fm = gid * WGM, gsz = (nM - fm) < WGM ? (nM - fm) : WGM;
        u.pm = fm + ((wgid % nig) % gsz); u.pn = (wgid % nig) / gsz; return true;
    }
    __device__ __forceinline__ void a_ready(const Unit&) const {}
    __device__ __forceinline__ void done(const Unit&) const {}
};

__device__ __forceinline__ unsigned cvt_pk_bf16(float lo, float hi) { unsigned r; asm volatile("v_cvt_pk_bf16_f32 %0, %1, %2" : "=v"(r) : "v"(lo), "v"(hi)); return r; }
typedef float f32x2 __attribute__((ext_vector_type(2)));
template <class Epi, class Sched, bool ALIGN_EPI = false, bool SP2 = false>
__device__ __forceinline__ void gemm_phase(PG8_LAS unsigned char* lds, const Gemm g, const Sched& S, const Epi& E) {
    const int tid = threadIdx.x, wid = __builtin_amdgcn_readfirstlane(tid >> 6), lane = tid & 63, wr = wid >> 2, wc = wid & 3, fr = lane & 15, fq = lane >> 4;
    const int K = g.K, nt = K / BK;
    unsigned voffA[2], voffB[2];
#pragma unroll
    for (int i = 0; i < 2; ++i) { int R, C; stage_rc(tid * 16 + i * 8192, R, C); const int Rb = Epi::PERM ? ((R & ~31) + perm32(R & 31)) : R;
        voffA[i] = (unsigned)(R * K + C) * 2u; voffB[i] = (unsigned)(Rb * K + C) * 2u; }
    const size_t kstep = (size_t)(BK * 2);
    const size_t hstep = (size_t)HALF * K * 2;
    const size_t tstep = 2 * hstep;
    const unsigned ldsw = (unsigned)wid * 1024u;
    const int aoff = lds_byte(wr * 64 + fr, fq * 8), boff = lds_byte(wc * 32 + fr, fq * 8);
#define PG8_SA(b, h) (((b) * 2 + (h)) * HTB)
#define PG8_SB(b, h) ((4 + (b) * 2 + (h)) * HTB)
#define PG8_STAGE(bufoff, gbase, voff) do { _Pragma("unroll") for (int _i = 0; _i < 2; ++_i) \
        __builtin_amdgcn_global_load_lds((const unsigned*)((const char*)(gbase) + (voff)[_i]), (PG8_LAS unsigned*)(lds + (bufoff) + ldsw + _i * 8192), 16, 0, 0); } while (0)
#define PG8_LDA(dst, b, h) do { _Pragma("unroll") for (int m = 0; m < 4; ++m) _Pragma("unroll") for (int k = 0; k < 2; ++k) dst[m][k] = *(const PG8_LAS bf16x8*)(lds + PG8_SA(b, h) + aoff + m * 2048 + k * 1024); } while (0)
#define PG8_LDB(dst, b, h) do { _Pragma("unroll") for (int n = 0; n < 2; ++n) _Pragma("unroll") for (int k = 0; k < 2; ++k) dst[n][k] = *(const PG8_LAS bf16x8*)(lds + PG8_SB(b, h) + boff + n * 2048 + k * 1024); } while (0)
#define PG8_MMA(ai, bj, At, Bt) do { __builtin_amdgcn_s_setprio(1); _Pragma("unroll") for (int m = 0; m < 4; ++m) _Pragma("unroll") for (int n = 0; n < 2; ++n) _Pragma("unroll") for (int k = 0; k < 2; ++k) \
        acc[ai][bj][m][n] = __builtin_amdgcn_mfma_f32_16x16x32_bf16(Bt[n][k], At[m][k], acc[ai][bj][m][n], 0, 0, 0); __builtin_amdgcn_s_setprio(0); } while (0)
#define PG8_WAIT_V(n) asm volatile("s_waitcnt vmcnt(" #n ")" ::: "memory")
#define PG8_WAIT_L(n) asm volatile("s_waitcnt lgkmcnt(" #n ")" ::: "memory")
#define PG8_BAR __builtin_amdgcn_s_barrier()
#define PG8_SCHED __builtin_amdgcn_sched_barrier(0)
    Unit cur, nxt; int ui = 0;
    if (!S.next(0, cur)) return;
    f32x4 acc[2][2][4][2];
#pragma unroll
    for (int a = 0; a < 2; ++a)
#pragma unroll
        for (int b = 0; b < 2; ++b)
#pragma unroll
            for (int m = 0; m < 4; ++m)
#pragma unroll
                for (int n = 0; n < 2; ++n) acc[a][b][m][n] = (f32x4){0.f, 0.f, 0.f, 0.f};
    bf16x8 At[4][2], B0[2][2], B1[2][2];
    const char* cA = (const char*)g.A + (size_t)cur.pm * tstep; const char* cB = (const char*)g.Bt + (size_t)cur.pn * tstep;
    S.a_ready(cur);
    if constexpr (SP2) {
        PG8_STAGE(PG8_SB(0, 0), cB, voffB); PG8_STAGE(PG8_SB(0, 1), cB + hstep, voffB); PG8_STAGE(PG8_SA(0, 0), cA, voffA); PG8_STAGE(PG8_SA(0, 1), cA + hstep, voffA);
        if (wr == 1) PG8_BAR;
        PG8_WAIT_V(2); PG8_BAR;
        PG8_STAGE(PG8_SB(1, 0), cB + kstep, voffB); PG8_STAGE(PG8_SA(1, 0), cA + kstep, voffA); PG8_STAGE(PG8_SB(1, 1), cB + hstep + kstep, voffB);
        PG8_WAIT_V(6); PG8_BAR;
    } else {
        PG8_STAGE(PG8_SB(0, 0), cB, voffB); PG8_STAGE(PG8_SA(0, 0), cA, voffA); PG8_STAGE(PG8_SB(0, 1), cB + hstep, voffB); PG8_STAGE(PG8_SA(0, 1), cA + hstep, voffA);
        if (wr == 1) PG8_BAR;
        PG8_WAIT_V(4); PG8_BAR;
        PG8_STAGE(PG8_SB(1, 0), cB + kstep, voffB); PG8_STAGE(PG8_SA(1, 0), cA + kstep, voffA); PG8_STAGE(PG8_SB(1, 1), cB + hstep + kstep, voffB);
        PG8_WAIT_V(6); PG8_BAR;
    }
    for (;;) {
        const bool has_next = S.next(ui + 1, nxt);
        const char* nA = has_next ? (const char*)g.A + (size_t)nxt.pm * tstep : cA; const char* nB = has_next ? (const char*)g.Bt + (size_t)nxt.pn * tstep : cB;
#pragma unroll 1
        for (int t = 0; t < nt; t += 2) {
            const bool last = (t == nt - 2);
            const char* a1 = cA + (size_t)(t + 1) * kstep;
            const char* a2 = last ? nA : cA + (size_t)(t + 2) * kstep; const char* b2 = last ? nB : cB + (size_t)(t + 2) * kstep;
            const char* a3 = a2 + kstep; const char* b3 = b2 + kstep;
            if (last && has_next) S.a_ready(nxt);
            if constexpr (SP2) {
            PG8_LDB(B0, 0, 0); PG8_LDB(B1, 0, 1); PG8_SCHED; PG8_LDA(At, 0, 0); PG8_STAGE(PG8_SA(1, 1), a1 + hstep, voffA);
            PG8_WAIT_V(8); PG8_WAIT_L(0); PG8_BAR; PG8_MMA(0, 0, At, B0); PG8_MMA(0, 1, At, B1); PG8_BAR; PG8_SCHED;
            PG8_LDA(At, 0, 1); PG8_STAGE(PG8_SB(0, 0), b2, voffB); PG8_STAGE(PG8_SB(0, 1), b2 + hstep, voffB); PG8_STAGE(PG8_SA(0, 0), a2, voffA);
            PG8_WAIT_V(8); PG8_WAIT_L(0); PG8_BAR; PG8_MMA(1, 0, At, B0); PG8_MMA(1, 1, At, B1); PG8_BAR; PG8_SCHED;
            PG8_LDB(B0, 1, 0); PG8_LDB(B1, 1, 1); PG8_SCHED; PG8_LDA(At, 1, 0); PG8_STAGE(PG8_SA(0, 1), a2 + hstep, voffA);
            PG8_WAIT_V(8); PG8_WAIT_L(0); PG8_BAR; PG8_MMA(0, 0, At, B0); PG8_MMA(0, 1, At, B1); PG8_BAR; PG8_SCHED;
            PG8_LDA(At, 1, 1); PG8_STAGE(PG8_SB(1, 0), b3, voffB); PG8_STAGE(PG8_SB(1, 1), b3 + hstep, voffB); PG8_STAGE(PG8_SA(1, 0), a3, voffA);
            PG8_WAIT_V(8); PG8_WAIT_L(0); PG8_BAR; PG8_MMA(1, 0, At, B0); PG8_MMA(1, 1, At, B1); PG8_BAR; PG8_SCHED;
            } else {
            PG8_LDB(B0, 0, 0); PG8_SCHED; PG8_LDA(At, 0, 0); PG8_STAGE(PG8_SA(1, 1), a1 + hstep, voffA);
            PG8_WAIT_L(8); PG8_BAR; PG8_WAIT_L(0); PG8_MMA(0, 0, At, B0); PG8_BAR; PG8_SCHED;
            PG8_LDB(B1, 0, 1); PG8_STAGE(PG8_SB(0, 0), b2, voffB);
            PG8_BAR; PG8_WAIT_L(0); PG8_MMA(0, 1, At, B1); PG8_BAR;
            PG8_LDA(At, 0, 1); PG8_STAGE(PG8_SA(0, 0), a2, voffA);
            PG8_BAR; PG8_WAIT_L(0); PG8_MMA(1, 0, At, B0); PG8_BAR; PG8_SCHED;
            PG8_STAGE(PG8_SB(0, 1), b2 + hstep, voffB);
            PG8_WAIT_V(6); PG8_BAR; PG8_MMA(1, 1, At, B1); PG8_BAR;
            PG8_LDB(B0, 1, 0); PG8_SCHED; PG8_LDA(At, 1, 0); PG8_STAGE(PG8_SA(0, 1), a2 + hstep, voffA);
            PG8_WAIT_L(8); PG8_BAR; PG8_WAIT_L(0); PG8_MMA(0, 0, At, B0); PG8_BAR; PG8_SCHED;
            PG8_LDB(B1, 1, 1); PG8_STAGE(PG8_SB(1, 0), b3, voffB);
            PG8_BAR; PG8_WAIT_L(0); PG8_MMA(0, 1, At, B1); PG8_BAR;
            PG8_LDA(At, 1, 1); PG8_STAGE(PG8_SA(1, 0), a3, voffA);
            PG8_BAR; PG8_WAIT_L(0); PG8_MMA(1, 0, At, B0); PG8_BAR; PG8_SCHED;
            PG8_STAGE(PG8_SB(1, 1), b3 + hstep, voffB);
            PG8_WAIT_V(6); PG8_BAR; PG8_MMA(1, 1, At, B1); PG8_BAR;
            }
        }
        if constexpr (ALIGN_EPI) { if (wr == 0) PG8_BAR; }
        if constexpr (!Epi::AFTER_DRAIN) { E(acc, cur, wr, wc, fr, fq); S.done(cur); }
        if (!has_next) break;
#pragma unroll
        for (int a = 0; a < 2; ++a)
#pragma unroll
            for (int b = 0; b < 2; ++b)
#pragma unroll
                for (int m = 0; m < 4; ++m)
#pragma unroll
                    for (int n = 0; n < 2; ++n) acc[a][b][m][n] = (f32x4){0.f, 0.f, 0.f, 0.f};
        cur = nxt; cA = nA; cB = nB; ++ui;
        if constexpr (ALIGN_EPI) { if (wr == 1) PG8_BAR; }
    }
    PG8_WAIT_V(0);
    if constexpr (!ALIGN_EPI) { if (wr == 0) PG8_BAR; }
    PG8_BAR;
    if constexpr (Epi::AFTER_DRAIN) { E.fused(acc, cur, wr, wc, fr, fq, lds, wid, lane); S.done(cur); }
#undef PG8_SA
#undef PG8_SB
#undef PG8_STAGE
#undef PG8_LDA
#undef PG8_LDB
#undef PG8_MMA
#undef PG8_WAIT_V
#undef PG8_WAIT_L
#undef PG8_BAR
#undef PG8_SCHED
}
}

constexpr int NB = 8, SEQ = 4096, DM = 1024, M = NB * SEQ;
constexpr int NHEAD = 8;
constexpr int PH_P = 1536, PR_P = 1920, PG_P = 2048;
constexpr int NP = 5632;
constexpr int FFH = 2816, NGU = 5632;
constexpr int LORA_K = 384, LORA_N = 2560;
constexpr float DN_ALPHA = 1.18920711500272f;
constexpr float LN_EPS = 1e-5f, GN_EPS = 64e-5f;
constexpr float HY_MIN_DECAY = -3.07011346f, HY_MAX_DECAY = -15.3505673f;
constexpr int NWAVES = 8;

constexpr size_t MiB = 1u << 20;
constexpr size_t WS_H3T = 1 * MiB;
constexpr size_t WS_STATS = 2 * MiB;
constexpr size_t WS_BONUS = 3 * MiB;
constexpr size_t WS_WIN = 5 * MiB, WS_WGU = 16 * MiB, WS_WD = 27 * MiB, WS_WO = 33 * MiB, WS_WHY = 35 * MiB, WS_WRW = 36 * MiB, WS_WLORA = 37 * MiB;
constexpr size_t WS_FT = 39 * MiB;
constexpr size_t WS_XB = 71 * MiB;
constexpr size_t WS_LW = 71 * MiB;
constexpr size_t WS_PH = 135 * MiB, WS_PR = 231 * MiB, WS_PG = 351 * MiB;
constexpr size_t WS_TOP = 479 * MiB;
constexpr size_t WS_ZH = 71 * MiB, WS_T = 103 * MiB, WS_MIXIN = 167 * MiB;
constexpr size_t WS_H1 = 351 * MiB, WS_X1B = 71 * MiB, WS_HID = 135 * MiB;
constexpr size_t WS_NEED = 511 * MiB;
constexpr size_t DO_HT = 0, DO_YSF = 96 * MiB;

#define GAS __attribute__((address_space(1)))
#define LAS __attribute__((address_space(3)))
typedef unsigned short bf16;
typedef unsigned v4u __attribute__((ext_vector_type(4)));
typedef unsigned v2u __attribute__((ext_vector_type(2)));
typedef float f32x4 __attribute__((ext_vector_type(4)));
typedef float f32x16 __attribute__((ext_vector_type(16)));
typedef short bf16x8 __attribute__((ext_vector_type(8)));

__device__ __forceinline__ float bf2f(unsigned b) { return __uint_as_float(b << 16); }
__device__ __forceinline__ float bflo(unsigned w) { return __uint_as_float(w << 16); }
__device__ __forceinline__ float bfhi(unsigned w) { return __uint_as_float(w & 0xffff0000u); }
__device__ __forceinline__ unsigned f2bf(float f) { unsigned u = __float_as_uint(f); return (u + 0x7fffu + ((u >> 16) & 1u)) >> 16; }
__device__ __forceinline__ unsigned pk2(float lo, float hi) { return f2bf(lo) | (f2bf(hi) << 16); }
__device__ __forceinline__ float sigmoidf_(float x) { return 1.0f / (1.0f + __expf(-x)); }
__device__ __forceinline__ float wave_sum(float v) {
#pragma unroll
    for (int o = 1; o < 64; o <<= 1) v += __shfl_xor(v, o);
    return v;
}

struct Frame {
    LAS unsigned char* lds;
    int tid, lane, wave, G, bid;
    float* out; unsigned char* ws;
};
struct Args { const float* in[34]; float* out; unsigned char* ws; int ph_lo, ph_hi; };

using pg8::Unit; using pg8::cvt_pk_bf16; constexpr int HALF = 128, BM = 256;

__device__ __forceinline__ v4u pack8(f32x4 v0, f32x4 v1) { v4u w; w.x = cvt_pk_bf16(v0[0], v0[1]); w.y = cvt_pk_bf16(v0[2], v0[3]); w.z = cvt_pk_bf16(v1[0], v1[1]); w.w = cvt_pk_bf16(v1[2], v1[3]); return w; }

struct EpiProj {
    static constexpr bool PERM = true, AFTER_DRAIN = false;
    bf16 *PH, *PR, *PG;
    __device__ __forceinline__ void operator()(const f32x4 (&acc)[2][2][4][2], const Unit& u, int wr, int wc, int fr, int fq) const {
        const int row0 = u.pm * BM + wr * 64 + fr;
#pragma unroll
        for (int bj = 0; bj < 2; ++bj) {
            const int hb = 2 * u.pn + bj; bf16* base; int pitch, col;
            if (hb < 12) { base = PH; pitch = PH_P; col = 128 * hb; }
            else if (hb < 27) { base = PR; pitch = PR_P; col = 128 * (hb - 12); }
            else if (hb < 43) { base = PG; pitch = PG_P; col = 128 * (hb - 27); }
            else continue;
            col += wc * 32 + 8 * fq;
#pragma unroll
            for (int ai = 0; ai < 2; ++ai)
#pragma unroll
                for (int m = 0; m < 4; ++m)
                    *(v4u*)(base + (size_t)(row0 + ai * HALF + m * 16) * pitch + col) = pack8(acc[ai][bj][m][0], acc[ai][bj][m][1]);
        }
    }
};

struct EpiLora {
    static constexpr bool PERM = true, AFTER_DRAIN = false;
    bf16* LW;
    __device__ __forceinline__ void operator()(const f32x4 (&acc)[2][2][4][2], const Unit& u, int wr, int wc, int fr, int fq) const {
        const int row0 = u.pm * BM + wr * 64 + fr;
        bf16* base = LW + (size_t)(u.pn >> 1) * ((size_t)M * 512) + (u.pn & 1) * 256 + wc * 32 + 8 * fq;
#pragma unroll
        for (int ai = 0; ai < 2; ++ai)
#pragma unroll
            for (int m = 0; m < 4; ++m) { bf16* rowp = base + (size_t)(row0 + ai * HALF + m * 16) * 512;
#pragma unroll
                for (int bj = 0; bj < 2; ++bj) *(v4u*)(rowp + bj * HALF) = pack8(acc[ai][bj][m][0], acc[ai][bj][m][1]); }
    }
};

template <int STAGE> struct EpiGate {
    static constexpr bool PERM = true, AFTER_DRAIN = false;
    const bf16* PG; bf16* T; bf16* O;
    __device__ __forceinline__ void operator()(const f32x4 (&acc)[2][2][4][2], const Unit& u, int wr, int wc, int fr, int fq) const {
        const int row0 = u.pm * BM + wr * 64 + fr;
#pragma unroll
        for (int bj = 0; bj < 2; ++bj) {
            const int col = u.pn * BM + bj * HALF + wc * 32 + 8 * fq;
#pragma unroll
            for (int ai = 0; ai < 2; ++ai)
#pragma unroll
                for (int m = 0; m < 4; ++m) {
                    const size_t row = (size_t)(row0 + ai * HALF + m * 16);
                    const v4u g = *(const v4u*)(PG + row * PG_P + STAGE * 1024 + col);
                    f32x4 v0 = acc[ai][bj][m][0], v1 = acc[ai][bj][m][1];
                    v0[0] *= sigmoidf_(bflo(g.x)); v0[1] *= sigmoidf_(bfhi(g.x)); v0[2] *= sigmoidf_(bflo(g.y)); v0[3] *= sigmoidf_(bfhi(g.y));
                    v1[0] *= sigmoidf_(bflo(g.z)); v1[1] *= sigmoidf_(bfhi(g.z)); v1[2] *= sigmoidf_(bflo(g.w)); v1[3] *= sigmoidf_(bfhi(g.w));
                    if (STAGE == 1) {
                        const v4u t = *(const v4u*)(T + row * 1024 + col);
                        v0[0] += bflo(t.x); v0[1] += bfhi(t.x); v0[2] += bflo(t.y); v0[3] += bfhi(t.y);
                        v1[0] += bflo(t.z); v1[1] += bfhi(t.z); v1[2] += bflo(t.w); v1[3] += bfhi(t.w);
                        *(v4u*)(O + row * 1024 + col) = pack8(v0, v1);
                    } else {
                        *(v4u*)(T + row * 1024 + col) = pack8(v0, v1);
                    }
                }
        }
    }
};

struct EpiWo {
    static constexpr bool PERM = false, AFTER_DRAIN = false;
    const float* X; float* H1;
    __device__ __forceinline__ void operator()(const f32x4 (&acc)[2][2][4][2], const Unit& u, int wr, int wc, int fr, int fq) const {
        const int row0 = u.pm * BM + wr * 64 + fr, col0 = u.pn * BM + wc * 32 + 4 * fq;
#pragma unroll
        for (int ai = 0; ai < 2; ++ai)
#pragma unroll
            for (int m = 0; m < 4; ++m) {
                const size_t off = (size_t)(row0 + ai * HALF + m * 16) * DM + col0;
#pragma unroll
                for (int bj = 0; bj < 2; ++bj)
#pragma unroll
                    for (int n = 0; n < 2; ++n) {
                        const f32x4 xv = *(const f32x4*)(X + off + bj * HALF + n * 16);
                        *(f32x4*)(H1 + off + bj * HALF + n * 16) = xv * DN_ALPHA + acc[ai][bj][m][n];
                    }
            }
    }
};

struct EpiSwiGLU {
    static constexpr bool PERM = true, AFTER_DRAIN = false;
    bf16* HID;
    __device__ __forceinline__ void operator()(const f32x4 (&acc)[2][2][4][2], const Unit& u, int wr, int wc, int fr, int fq) const {
        const int row0 = u.pm * BM + wr * 64 + fr, col = u.pn * HALF + wc * 32 + 8 * fq;
#pragma unroll
        for (int ai = 0; ai < 2; ++ai)
#pragma unroll
            for (int m = 0; m < 4; ++m) {
                f32x4 g0 = acc[ai][0][m][0], g1 = acc[ai][0][m][1]; const f32x4 u0 = acc[ai][1][m][0], u1 = acc[ai][1][m][1];
#pragma unroll
                for (int j = 0; j < 4; ++j) { g0[j] = g0[j] * sigmoidf_(g0[j]) * u0[j]; g1[j] = g1[j] * sigmoidf_(g1[j]) * u1[j]; }
                *(v4u*)(HID + (size_t)(row0 + ai * HALF + m * 16) * FFH + col) = pack8(g0, g1);
            }
    }
};

struct EpiDown {
    static constexpr bool PERM = false, AFTER_DRAIN = false;
    const float* H1; const float* STATS; const float* lnw; const float* lnb; float* O;
    __device__ __forceinline__ void operator()(const f32x4 (&acc)[2][2][4][2], const Unit& u, int wr, int wc, int fr, int fq) const {
        const int row0 = u.pm * BM + wr * 64 + fr, col0 = u.pn * BM + wc * 32 + 4 * fq;
#pragma unroll
        for (int ai = 0; ai < 2; ++ai)
#pragma unroll
            for (int m = 0; m < 4; ++m) {
                const int row = row0 + ai * HALF + m * 16; const size_t off = (size_t)row * DM + col0;
                const float mean = STATS[2 * row], rstd = STATS[2 * row + 1];
#pragma unroll
                for (int bj = 0; bj < 2; ++bj)
#pragma unroll
                    for (int n = 0; n < 2; ++n) {
                        const f32x4 hv = *(const f32x4*)(H1 + off + bj * HALF + n * 16);
                        const f32x4 wv = *(const f32x4*)(lnw + col0 + bj * HALF + n * 16), bv = *(const f32x4*)(lnb + col0 + bj * HALF + n * 16);
                        const f32x4 x1 = (hv - mean) * rstd * wv + bv;
                        *(f32x4*)(O + off + bj * HALF + n * 16) = x1 * DN_ALPHA + acc[ai][bj][m][n];
                    }
            }
    }
};

__device__ __forceinline__ void p0_transpose_item(const float* W, int K, int N, bf16* WT, int dst_row0, int k0, int n0, LAS float* scr, int lane) {
#pragma unroll 8
    for (int i = 0; i < 32; ++i) { const int kk = 2 * i + (lane >> 5); scr[kk * 33 + (lane & 31)] = W[(size_t)(k0 + kk) * N + n0 + (lane & 31)]; }
    asm volatile("s_waitcnt lgkmcnt(0)" ::: "memory");
    const int c = lane & 7;
#pragma unroll
    for (int j = 0; j < 4; ++j) { const int n = (lane >> 3) + 8 * j; const LAS float* s = scr + (8 * c) * 33 + n;
        v4u o; o.x = pk2(s[0 * 33], s[1 * 33]); o.y = pk2(s[2 * 33], s[3 * 33]); o.z = pk2(s[4 * 33], s[5 * 33]); o.w = pk2(s[6 * 33], s[7 * 33]);
        *(v4u*)(WT + (size_t)(dst_row0 + n) * K + k0 + 8 * c) = o; }
    asm volatile("s_waitcnt lgkmcnt(0)" ::: "memory");
}

__device__ __forceinline__ void p0_prologue(Frame& F, const Args& AR) {
    LAS float* scr = (LAS float*)(F.lds + F.wave * 16384);
    const int gw = F.bid * NWAVES + F.wave, NGW = F.G * NWAVES, lane = F.lane;
    unsigned char* ws = F.ws;
    constexpr int I_IN = (1024 / 64) * (5504 / 32), I_GU = (1024 / 64) * (2816 / 32), I_D = (2816 / 64) * (1024 / 32), I_O = 16 * 32, I_HY = 8 * 32;
    constexpr int NITEMS = I_IN + 2 * I_GU + I_D + I_O + 2 * I_HY;
    for (int it = gw; it < NITEMS; it += NGW) {
        int r = it;
        if (r < I_IN) { const int nblk = 5504 / 32, kb = r / nblk, nb = r % nblk; p0_transpose_item(AR.in[1], 1024, 5504, (bf16*)(ws + WS_WIN), 32 * nb, 64 * kb, 32 * nb, scr, lane); continue; } r -= I_IN;
        if (r < 2 * I_GU) { const int up = r >= I_GU; if (up) r -= I_GU; const int nblk = 2816 / 32, kb = r / nblk, nb = r % nblk, n0 = 32 * nb;
            p0_transpose_item(AR.in[up ? 30 : 29], 1024, 2816, (bf16*)(ws + WS_WGU), (n0 >> 7) * 256 + (n0 & 127) + (up ? 128 : 0), 64 * kb, n0, scr, lane); continue; } r -= 2 * I_GU;
        if (r < I_D) { const int nblk = 32, kb = r / nblk, nb = r % nblk; p0_transpose_item(AR.in[31], 2816, 1024, (bf16*)(ws + WS_WD), 32 * nb, 64 * kb, 32 * nb, scr, lane); continue; } r -= I_D;
        if (r < I_O) { const int kb = r / 32, nb = r % 32; p0_transpose_item(AR.in[26], 1024, 1024, (bf16*)(ws + WS_WO), 32 * nb, 64 * kb, 32 * nb, scr, lane); continue; } r -= I_O;
        if (r < I_HY) { const int kb = r / 32, nb = r % 32; p0_transpose_item(AR.in[24], 512, 1024, (bf16*)(ws + WS_WHY), 32 * nb, 64 * kb, 32 * nb, scr, lane); continue; } r -= I_HY;
        { const int kb = r / 32, nb = r % 32; p0_transpose_item(AR.in[25], 512, 1024, (bf16*)(ws + WS_WRW), 32 * nb, 64 * kb, 32 * nb, scr, lane); }
    }
    const size_t gt = (size_t)F.bid * 512 + F.tid, NT = (size_t)F.G * 512;
    { v4u z = {0u, 0u, 0u, 0u}; v4u* p = (v4u*)((bf16*)(ws + WS_WIN) + (size_t)5504 * 1024); for (size_t i = gt; i < (size_t)128 * 1024 / 8; i += NT) p[i] = z; }
    { bf16* WL = (bf16*)(ws + WS_WLORA);
      for (size_t i = gt; i < (size_t)LORA_N * LORA_K; i += NT) {
          const int n = (int)(i / LORA_K), k = (int)(i % LORA_K), blk = n >> 9, c = n & 511; float v = 0.f;
          if (blk < 2) { if ((k >> 6) == blk) v = AR.in[15][((size_t)blk * 64 + (k & 63)) * 512 + c]; }
          else if (blk < 4) { if ((k >> 6) == blk) v = AR.in[17][((size_t)(blk - 2) * 64 + (k & 63)) * 512 + c]; }
          else { if (k >= 256) v = AR.in[18][(size_t)(k - 256) * 512 + c]; }
          WL[i] = (bf16)f2bf(v);
      } }
    { const f32x4* x4 = (const f32x4*)AR.in[0]; v4u* xb = (v4u*)(ws + WS_XB);
      for (size_t i = gt; i < (size_t)M * DM / 8; i += NT) { const f32x4 a = x4[2 * i], b = x4[2 * i + 1]; xb[i] = pack8(a, b); } }
    { float* H3T = (float*)(ws + WS_H3T);
      const float* fw1 = AR.in[4]; const float* fb1 = AR.in[5]; const float* fw2 = AR.in[6]; const float* fb2 = AR.in[7]; const float* fw3 = AR.in[8]; const float* fb3 = AR.in[9]; const float* sf = AR.in[11];
      for (int pos = gw; pos < SEQ; pos += NGW) {
          const float t = (float)pos / 4095.0f, wv = 6.283185307179586f * (float)pos / 4096.0f;
          float feat = 0.f;
          if (lane == 0) feat = t;
          else if (lane <= 32) { const int j = (lane - 1) & 15; const float f = 1e-4f + (float)j * ((15.0f - 1e-4f) / 15.0f); const float ang = wv * f; feat = (lane <= 16) ? cosf(ang) : -sinf(ang); }
          float z = fb1[lane];
#pragma unroll
          for (int f = 0; f < 33; ++f) z += __shfl(feat, f) * fw1[f * 64 + lane];
          float h = sinf(sf[lane] * z);
          z = fb2[lane];
#pragma unroll 8
          for (int j = 0; j < 64; ++j) z += __shfl(h, j) * fw2[j * 64 + lane];
          h = sinf(sf[64 + lane] * z);
          z = fb3[lane];
#pragma unroll 8
          for (int j = 0; j < 64; ++j) z += __shfl(h, j) * fw3[j * 64 + lane];
          h = sinf(sf[128 + lane] * z);
          H3T[lane * SEQ + pos] = h;
      } }
}

__device__ __forceinline__ void p2_prep(Frame& F, const Args& AR) {
    unsigned char* ws = F.ws; const int tid = F.tid, lane = F.lane;
    { const bf16* PH = (const bf16*)(ws + WS_PH); bf16* HT = (bf16*)((unsigned char*)F.out + DO_HT);
      const float* cw = AR.in[2]; const float* cb = AR.in[3];
      LAS bf16* raw = (LAS bf16*)F.lds;
      constexpr int NIT = NB * (SEQ / 64) * (PH_P / 64);
      for (int it = F.bid; it < NIT; it += F.G) {
          const int cbk = it % 24, tb = (it / 24) % 64, b = it / (24 * 64); const int t0 = tb * 64, c0 = cbk * 64;
          __syncthreads();
          for (int e = tid; e < 66 * 8; e += 512) {
              const int row = e >> 3, ch = e & 7; const int t = t0 - 1 + row; v4u v = {0u, 0u, 0u, 0u};
              if (t >= 0 && t < SEQ) v = *(const v4u*)(PH + ((size_t)b * SEQ + t) * PH_P + c0 + 8 * ch);
              LAS unsigned* d = (LAS unsigned*)(raw + row * 66 + 8 * ch); d[0] = v.x; d[1] = v.y; d[2] = v.z; d[3] = v.w;
          }
          __syncthreads();
          const int cl = tid & 63, tg = tid >> 6, col = c0 + cl;
          const float w0 = cw[col], w1 = cw[PH_P + col], w2 = cw[2 * PH_P + col], bb = cb[col];
          float r[10];
#pragma unroll
          for (int i = 0; i < 10; ++i) r[i] = bf2f(raw[(8 * tg + i) * 66 + cl]);
          float o[8];
#pragma unroll
          for (int i = 0; i < 8; ++i) o[i] = w0 * r[i] + w1 * r[i + 1] + w2 * r[i + 2] + bb;
          v4u w; w.x = pk2(o[0], o[1]); w.y = pk2(o[2], o[3]); w.z = pk2(o[4], o[5]); w.w = pk2(o[6], o[7]);
          const int which = col >> 9, c = col & 511;
          *(v4u*)(HT + (((size_t)which * 512 + c) * NB + b) * SEQ + t0 + 8 * tg) = w;
      }
      __syncthreads();
    }
    const size_t gt = (size_t)F.bid * 512 + tid, NT = (size_t)F.G * 512;
    { const bf16* PR = (const bf16*)(ws + WS_PR); bf16* LIN = (bf16*)(ws + WS_TOP); const float* mu = AR.in[13];
      for (size_t i = gt; i < (size_t)M * 96; i += NT) {
          const int m = (int)(i / 96), cg4 = (int)(i % 96), t = m & (SEQ - 1); const int col = 1536 + 4 * cg4;
          const bf16* p = PR + (size_t)m * PR_P + col;
          const v2u c = *(const v2u*)p; v2u pv = {0u, 0u}, nv = {0u, 0u};
          if (t > 0) pv = *(const v2u*)(p - PR_P);
          if (t < SEQ - 1) nv = *(const v2u*)(p + PR_P);
          const f32x4 muv = *(const f32x4*)(mu + col);
          float u[4], pr[4], nx[4];
          u[0] = bflo(c.x); u[1] = bfhi(c.x); u[2] = bflo(c.y); u[3] = bfhi(c.y);
          pr[0] = bflo(pv.x); pr[1] = bfhi(pv.x); pr[2] = bflo(pv.y); pr[3] = bfhi(pv.y);
          nx[0] = bflo(nv.x); nx[1] = bfhi(nv.x); nx[2] = bflo(nv.y); nx[3] = bfhi(nv.y);
#pragma unroll
          for (int j = 0; j < 4; ++j) { float s = u[j] + muv[j] * (0.5f * (pr[j] + nx[j]) - u[j]);
              if (cg4 < 32) s = tanhf(s); else if (cg4 >= 64) s = sigmoidf_(s); u[j] = s; }
          v2u o; o.x = pk2(u[0], u[1]); o.y = pk2(u[2], u[3]);
          *(v2u*)(LIN + (size_t)m * LORA_K + 4 * cg4) = o;
      } }
    { const float* H3T = (const float*)(ws + WS_H3T); const float* fw4 = AR.in[10]; const float* skip = AR.in[12];
      bf16* FT = (bf16*)(ws + WS_FT);
      const int gw = F.bid * NWAVES + F.wave, NGW = F.G * NWAVES;
      for (int it = gw; it < 1024; it += NGW) {
          const int o = it >> 9, c = it & 511;
          const float wf = fw4[(size_t)lane * 2048 + o * 1024 + c], wb = fw4[(size_t)lane * 2048 + o * 1024 + 512 + c];
          const float delta = fabsf(HY_MIN_DECAY + (float)c * ((HY_MAX_DECAY - HY_MIN_DECAY) / 511.0f));
          const float sk = skip[o * 512 + c];
          bf16* TE = FT + (size_t)it * 16384; bf16* TO = TE + 8192;
          if (lane == 0) { TE[0] = 0; TE[1] = 0; TO[1] = 0; }
          for (int pi = 0; pi < 64; ++pi) {
              const int pos = pi * 64 + lane; float hf = 0.f, hb = 0.f;
#pragma unroll 8
              for (int j = 0; j < 64; ++j) { const float hv = H3T[j * SEQ + pos]; hf += hv * __shfl(wf, j); hb += hv * __shfl(wb, j); }
              const float win = expf(-((float)pos / 4095.0f) * delta);
              if (pos == 0) { const bf16 v = (bf16)f2bf(hf + hb + sk); TE[2 * 2048] = v; TO[2 * 2048 + 1] = v; }
              else {
                  const bf16 vf = (bf16)f2bf(hf * win), vb = (bf16)f2bf(hb * win);
                  { const int d = pos, n = d >> 1;
                    if (d & 1) { TO[2 * (n + 2048)] = vf; if (n + 1 + 2048 < 4096) TE[2 * (n + 1 + 2048) + 1] = vf; }
                    else { TE[2 * (n + 2048)] = vf; TO[2 * (n + 2048) + 1] = vf; } }
                  { const int d = -pos, n = d >> 1;
                    if (d & 1) { TO[2 * (n + 2048)] = vb; TE[2 * (n + 1 + 2048) + 1] = vb; }
                    else { TE[2 * (n + 2048)] = vb; TO[2 * (n + 2048) + 1] = vb; } }
              }
          }
      } }
}

constexpr int HL_TE = 0, HL_TO = 16384 + 64, HL_Z = 32896, HZ_ROW = 80, HZ_PAD = 24;

__device__ __forceinline__ void hyena_item(Frame& F, const Args& AR, int c) {
    LAS unsigned char* lds = F.lds; const int tid = F.tid, lane = F.lane, wave = F.wave;
    bf16* HT = (bf16*)((unsigned char*)F.out + DO_HT);
    const bf16* FT = (const bf16*)(F.ws + WS_FT);
    const int r = lane & 31, h = lane >> 5, par = r & 1;
    __syncthreads();
    if (tid < 240) { const int rr = tid / 5, ch = tid % 5; const int row = rr < 24 ? rr : 1024 + rr; v4u z = {0u, 0u, 0u, 0u}; *(LAS v4u*)(lds + HL_Z + row * HZ_ROW + 16 * ch) = z; }
    { const v4u* src = (const v4u*)(HT + ((size_t)0 * 512 + c) * NB * SEQ);
#pragma unroll
      for (int it = 0; it < 8; ++it) { const int rem = tid; const v4u v = src[it * 512 + rem];
          *(LAS v4u*)(lds + HL_Z + (((rem >> 2) * 8 + it) + HZ_PAD) * HZ_ROW + (rem & 3) * 16) = v; } }
#pragma unroll 1
    for (int o = 0; o < 2; ++o) {
        { const v4u* src = (const v4u*)(FT + ((size_t)o * 512 + c) * 16384);
#pragma unroll
          for (int it = 0; it < 4; ++it) { const int e = it * 512 + tid; const v4u v = src[e]; *(LAS v4u*)(lds + (e < 1024 ? HL_TE + e * 16 : HL_TO + (e - 1024) * 16)) = v; } }
        __syncthreads();
        f32x16 acc[4];
#pragma unroll
        for (int nn = 0; nn < 4; ++nn)
#pragma unroll
            for (int j = 0; j < 16; ++j) acc[nn][j] = 0.f;
        const LAS unsigned* T = (const LAS unsigned*)(lds + (par ? HL_TO : HL_TE));
        const int nb0 = 4 * wave;
#pragma unroll 1
        for (int q = 16 * wave - 127; q <= 16 * wave + 15; ++q) {
#pragma unroll
            for (int jh = 0; jh < 2; ++jh) {
                const int base = 32 * q + r - 16 * jh - 8 * h;
                const int n0 = ((base - par) >> 1) + 2048;
                v4u av; av.x = T[n0]; av.y = T[n0 - 1]; av.z = T[n0 - 2]; av.w = T[n0 - 3];
                const bf16x8 A = __builtin_bit_cast(bf16x8, av);
#pragma unroll
                for (int nn = 0; nn < 4; ++nn) {
                    const int n = nb0 + nn;
                    if (q >= 4 * n - 127 && q <= 4 * n + 3) {
                        const int row = 32 * n + r - 8 * q + HZ_PAD;
                        const bf16x8 Bf = *(const LAS bf16x8*)(lds + HL_Z + row * HZ_ROW + 32 * jh + 16 * h);
                        acc[nn] = __builtin_amdgcn_mfma_f32_32x32x16_bf16(A, Bf, acc[nn], 0, 0, 0);
                    }
                }
            }
        }
        __syncthreads();
        const bf16* XG = HT + ((size_t)(1 + o) * 512 + c) * NB * SEQ;
#pragma unroll
        for (int nn = 0; nn < 4; ++nn) {
            const int colg = 32 * (nb0 + nn) + r, tb = colg >> 3, b = colg & 7;
#pragma unroll
            for (int g = 0; g < 4; ++g) {
                const int i0 = 8 * g + 4 * h;
                const v2u xv = *(const v2u*)(XG + (size_t)b * SEQ + 32 * tb + i0);
                v2u w; w.x = pk2(acc[nn][4 * g + 0] * bflo(xv.x), acc[nn][4 * g + 1] * bfhi(xv.x)); w.y = pk2(acc[nn][4 * g + 2] * bflo(xv.y), acc[nn][4 * g + 3] * bfhi(xv.y));
                *(LAS v2u*)(lds + HL_Z + (colg + HZ_PAD) * HZ_ROW + i0 * 2) = w;
            }
        }
        __syncthreads();
    }
    { v4u* dst = (v4u*)(HT + ((size_t)0 * 512 + c) * NB * SEQ);
#pragma unroll
      for (int it = 0; it < 8; ++it) { const int rem = tid; dst[it * 512 + rem] = *(const LAS v4u*)(lds + HL_Z + (((rem >> 2) * 8 + it) + HZ_PAD) * HZ_ROW + (rem & 3) * 16); } }
}

constexpr int SC_SLOT = 400;
__device__ __forceinline__ void rwkv_scan(Frame& F, const Args& AR, int seq) {
    const int dir = seq >> 6, b = (seq >> 3) & 7, h = seq & 7, lane = F.lane, wave = F.wave;
    LAS float* ring = (LAS float*)F.lds;
    const int ch = h * 64 + lane;
    const float* mu = AR.in[13];
    const float mu_r = mu[ch], mu_k = mu[512 + ch], mu_v = mu[1024 + ch];
    const float kk_c = AR.in[19][ch], ka_c = AR.in[20][ch], rk_c = AR.in[21][ch];
    const float w0_c = AR.in[14][dir * 512 + ch], a0_c = AR.in[16][dir * 512 + ch];
    const bf16* PRb = (const bf16*)(F.ws + WS_PR) + (size_t)b * SEQ * PR_P;
    const bf16* Wd = (const bf16*)(F.ws + WS_LW) + (size_t)dir * ((size_t)M * 512) + (size_t)b * SEQ * 512;
    const bf16* Ad = (const bf16*)(F.ws + WS_LW) + (size_t)(2 + dir) * ((size_t)M * 512) + (size_t)b * SEQ * 512;
    bf16* YS = dir ? (bf16*)(F.ws + WS_TOP) : (bf16*)((unsigned char*)F.out + DO_YSF);
    YS += (size_t)b * SEQ * 512;
    float* BON = (float*)(F.ws + WS_BONUS) + ((size_t)dir * M + (size_t)b * SEQ) * 8;
    float S[8];
#pragma unroll
    for (int i = 0; i < 8; ++i) S[i] = 0.f;
    const bool b5 = (lane & 32) != 0, b4 = (lane & 16) != 0, b3 = (lane & 8) != 0;
    __syncthreads();
#pragma unroll 1
    for (int j = 0; j < SEQ / 8; ++j) {
        {
            const int s = 8 * j + wave, tau = dir ? SEQ - 1 - s : s;
            const bf16* row = PRb + (size_t)tau * PR_P;
            const float rc = bf2f(row[ch]), kc = bf2f(row[512 + ch]), vc = bf2f(row[1024 + ch]);
            float rp = 0.f, kp = 0.f, vp = 0.f, rn = 0.f, kn = 0.f, vn = 0.f;
            if (tau > 0) { rp = bf2f(row[ch - PR_P]); kp = bf2f(row[512 + ch - PR_P]); vp = bf2f(row[1024 + ch - PR_P]); }
            if (tau < SEQ - 1) { rn = bf2f(row[ch + PR_P]); kn = bf2f(row[512 + ch + PR_P]); vn = bf2f(row[1024 + ch + PR_P]); }
            const float rr = rc + mu_r * (0.5f * (rp + rn) - rc), kx = kc + mu_k * (0.5f * (kp + kn) - kc), vx = vc + mu_v * (0.5f * (vp + vn) - vc);
            const float wv = __expf(-0.60653065971f * sigmoidf_(w0_c + bf2f(Wd[(size_t)tau * 512 + ch]))), av = sigmoidf_(a0_c + bf2f(Ad[(size_t)tau * 512 + ch]));
            const float kkr = kx * kk_c; const float ss = wave_sum(kkr * kkr); const float kk = kkr / fmaxf(sqrtf(ss), 1e-12f);
            const float kd = kx * (1.0f + (av - 1.0f) * ka_c);
            const float bon = wave_sum(rr * kd * rk_c);
            LAS float* sl = ring + ((j & 1) * 8 + wave) * SC_SLOT;
            sl[lane] = -kk; sl[64 + lane] = wv; sl[128 + lane] = kk * av; sl[192 + lane] = kd; sl[256 + lane] = rr; sl[320 + lane] = vx;
            if (lane == 0) BON[(size_t)tau * 8 + h] = bon;
        }
        __syncthreads();
#pragma unroll 1
        for (int u = 0; u < 8; ++u) {
            const LAS float* sl = ring + ((j & 1) * 8 + u) * SC_SLOT;
            const float nkk = sl[lane], w = sl[64 + lane], kka = sl[128 + lane], kd = sl[192 + lane], rr = sl[256 + lane];
            const f32x4 va = *(const LAS f32x4*)(sl + 320 + 8 * wave), vb = *(const LAS f32x4*)(sl + 324 + 8 * wave);
            float v[8] = {va[0], va[1], va[2], va[3], vb[0], vb[1], vb[2], vb[3]};
            float p[8];
#pragma unroll
            for (int i = 0; i < 8; ++i) p[i] = S[i] * nkk;
            float q1[4], q2[2], q3;
#pragma unroll
            for (int i = 0; i < 4; ++i) { const float mine = b5 ? p[4 + i] : p[i], give = b5 ? p[i] : p[4 + i]; q1[i] = mine + __shfl_xor(give, 32); }
#pragma unroll
            for (int i = 0; i < 2; ++i) { const float mine = b4 ? q1[2 + i] : q1[i], give = b4 ? q1[i] : q1[2 + i]; q2[i] = mine + __shfl_xor(give, 16); }
            { const float mine = b3 ? q2[1] : q2[0], give = b3 ? q2[0] : q2[1]; q3 = mine + __shfl_xor(give, 8); }
            q3 += __shfl_xor(q3, 4); q3 += __shfl_xor(q3, 2); q3 += __shfl_xor(q3, 1);
            float sa[8];
#pragma unroll
            for (int i = 0; i < 8; ++i) sa[i] = __shfl(q3, 8 * i);
#pragma unroll
            for (int i = 0; i < 8; ++i) { S[i] = S[i] * w + (sa[i] * kka + v[i] * kd); p[i] = S[i] * rr; }
#pragma unroll
            for (int i = 0; i < 4; ++i) { const float mine = b5 ? p[4 + i] : p[i], give = b5 ? p[i] : p[4 + i]; q1[i] = mine + __shfl_xor(give, 32); }
#pragma unroll
            for (int i = 0; i < 2; ++i) { const float mine = b4 ? q1[2 + i] : q1[i], give = b4 ? q1[i] : q1[2 + i]; q2[i] = mine + __shfl_xor(give, 16); }
            { const float mine = b3 ? q2[1] : q2[0], give = b3 ? q2[0] : q2[1]; q3 = mine + __shfl_xor(give, 8); }
            q3 += __shfl_xor(q3, 4); q3 += __shfl_xor(q3, 2); q3 += __shfl_xor(q3, 1);
            const int s = 8 * j + u, tau = dir ? SEQ - 1 - s : s;
            if ((lane & 7) == 0) YS[(size_t)tau * 512 + h * 64 + 8 * wave + (lane >> 3)] = (bf16)f2bf(q3);
        }
    }
}

__device__ __forceinline__ void p4_mixers(Frame& F, const Args& AR) {
    if (F.bid < 128) rwkv_scan(F, AR, F.bid);
    else { for (int c = F.bid - 128; c < 512; c += F.G - 128) hyena_item(F, AR, c); }
}

__device__ __forceinline__ void p5_combine(Frame& F, const Args& AR) {
    unsigned char* ws = F.ws; const int lane = F.lane, tid = F.tid;
    { const int gw = F.bid * NWAVES + F.wave, NGW = F.G * NWAVES;
      bf16* YSF = (bf16*)((unsigned char*)F.out + DO_YSF); const bf16* YSB = (const bf16*)(ws + WS_TOP);
      const bf16* PR = (const bf16*)(ws + WS_PR); const bf16* Gt = (const bf16*)(ws + WS_LW) + (size_t)4 * ((size_t)M * 512);
      const float* BON = (const float*)(ws + WS_BONUS); const float* mu = AR.in[13]; const float* gnw = AR.in[22]; const float* gnb = AR.in[23];
      for (int it = gw; it < M * NHEAD; it += NGW) {
          const int m = it >> 3, h = it & 7, ch = h * 64 + lane, t = m & (SEQ - 1);
          const float y = bf2f(YSF[(size_t)m * 512 + ch]) + bf2f(YSB[(size_t)m * 512 + ch]);
          const float mean = wave_sum(y) * (1.0f / 64.0f); const float d = y - mean; const float var = wave_sum(d * d) * (1.0f / 64.0f);
          const float yn = d * rsqrtf(var + GN_EPS) * gnw[ch] + gnb[ch];
          const bf16* p = PR + (size_t)m * PR_P + 1024 + ch;
          const float vc = bf2f(p[0]); float vp = 0.f, vn = 0.f;
          if (t > 0) vp = bf2f(p[-PR_P]);
          if (t < SEQ - 1) vn = bf2f(p[PR_P]);
          const float vx = vc + mu[1024 + ch] * (0.5f * (vp + vn) - vc);
          const float bon = BON[(size_t)m * 8 + h] + BON[((size_t)M + m) * 8 + h];
          YSF[(size_t)m * 512 + ch] = (bf16)f2bf((yn + bon * vx) * bf2f(Gt[(size_t)m * 512 + ch]));
      } }
    { const bf16* ZHT = (const bf16*)((unsigned char*)F.out + DO_HT); bf16* ZH = (bf16*)(ws + WS_ZH);
      LAS bf16* tile = (LAS bf16*)F.lds;
      for (int it = F.bid; it < 8 * NB * 64; it += F.G) {
          const int tb = it & 63, b = (it >> 6) & 7, cbk = it >> 9; const int t0 = tb * 64, c0 = cbk * 64;
          __syncthreads();
          { const int cl = tid >> 3, chk = tid & 7; const v4u v = *(const v4u*)(ZHT + ((size_t)(c0 + cl) * NB + b) * SEQ + t0 + 8 * chk);
            *(LAS v4u*)(tile + cl * 72 + 8 * chk) = v; }
          __syncthreads();
          { const int tl = tid >> 3, chk = tid & 7; unsigned e[8];
#pragma unroll
            for (int i = 0; i < 8; ++i) e[i] = tile[(8 * chk + i) * 72 + tl];
            v4u w; w.x = e[0] | (e[1] << 16); w.y = e[2] | (e[3] << 16); w.z = e[4] | (e[5] << 16); w.w = e[6] | (e[7] << 16);
            *(v4u*)(ZH + ((size_t)b * SEQ + t0 + tl) * 512 + c0 + 8 * chk) = w; }
      }
      __syncthreads();
    }
}

__device__ __forceinline__ void ln1_pass(Frame& F, const Args& AR) {
    const int gw = F.bid * NWAVES + F.wave, NGW = F.G * NWAVES, lane = F.lane;
    const float* H1 = (const float*)(F.ws + WS_H1); float* ST = (float*)(F.ws + WS_STATS); bf16* X1B = (bf16*)(F.ws + WS_X1B);
    const f32x4* w4 = (const f32x4*)AR.in[27]; const f32x4* b4 = (const f32x4*)AR.in[28];
    for (int m = gw; m < M; m += NGW) {
        const f32x4* xr = (const f32x4*)(H1 + (size_t)m * DM) + lane;
        f32x4 v[4]; float s = 0.f;
#pragma unroll
        for (int j = 0; j < 4; ++j) { v[j] = xr[64 * j]; s += (v[j].x + v[j].y) + (v[j].z + v[j].w); }
        const float mean = wave_sum(s) * (1.f / DM); float s2 = 0.f;
#pragma unroll
        for (int j = 0; j < 4; ++j) { v[j] = v[j] - mean; s2 += (v[j].x * v[j].x + v[j].y * v[j].y) + (v[j].z * v[j].z + v[j].w * v[j].w); }
        const float rstd = 1.f / sqrtf(wave_sum(s2) * (1.f / DM) + LN_EPS);
        if (lane == 0) { ST[2 * m] = mean; ST[2 * m + 1] = rstd; }
        v2u* o8 = (v2u*)(X1B + (size_t)m * DM) + lane;
#pragma unroll
        for (int j = 0; j < 4; ++j) { const f32x4 y = v[j] * rstd * w4[64 * j + lane] + b4[64 * j + lane]; v2u o; o.x = pk2(y.x, y.y); o.y = pk2(y.z, y.w); o8[64 * j] = o; }
    }
}
__device__ __forceinline__ void ln2_pass(Frame& F, const Args& AR) {
    const int gw = F.bid * NWAVES + F.wave, NGW = F.G * NWAVES, lane = F.lane;
    const f32x4* w4 = (const f32x4*)AR.in[32]; const f32x4* b4 = (const f32x4*)AR.in[33];
    for (int m = gw; m < M; m += NGW) {
        f32x4* xr = (f32x4*)(F.out + (size_t)m * DM) + lane;
        f32x4 v[4]; float s = 0.f;
#pragma unroll
        for (int j = 0; j < 4; ++j) { v[j] = xr[64 * j]; s += (v[j].x + v[j].y) + (v[j].z + v[j].w); }
        const float mean = wave_sum(s) * (1.f / DM); float s2 = 0.f;
#pragma unroll
        for (int j = 0; j < 4; ++j) { v[j] = v[j] - mean; s2 += (v[j].x * v[j].x + v[j].y * v[j].y) + (v[j].z * v[j].z + v[j].w * v[j].w); }
        const float rstd = 1.f / sqrtf(wave_sum(s2) * (1.f / DM) + LN_EPS);
#pragma unroll
        for (int j = 0; j < 4; ++j) xr[64 * j] = v[j] * rstd * w4[64 * j + lane] + b4[64 * j + lane];
    }
}

constexpr int LDS_BYTES = 147456;
constexpr int N_PHASES = 13;

__global__ void __launch_bounds__(512, 2) hybrid_fwd(Args args) {
    extern __shared__ __attribute__((aligned(16))) unsigned char lds_raw[];
    cg::grid_group grid = cg::this_grid();
    Frame F;
    F.lds = (LAS unsigned char*)lds_raw;
    F.tid = threadIdx.x; F.lane = F.tid & 63; F.wave = __builtin_amdgcn_readfirstlane(F.tid >> 6);
    F.G = gridDim.x; F.bid = blockIdx.x;
    F.out = args.out; F.ws = args.ws;
    unsigned char* ws = args.ws;
    const int lo = args.ph_lo, hi = args.ph_hi;
#define IN(k) (lo <= (k) && (k) < hi)
#define SEAM(k) do { if (IN(k) && IN((k) + 1)) grid.sync(); } while (0)
    using pg8::Gemm; using pg8::StaticOrder; using pg8::gemm_phase;

    if (IN(0)) { p0_prologue(F, args); } SEAM(0);
    if (IN(1)) {
        Gemm g{(const bf16*)(ws + WS_XB), (const bf16*)(ws + WS_WIN), M, NP, DM}; StaticOrder S; S.init(M, NP, F.G, F.bid);
        EpiProj E{(bf16*)(ws + WS_PH), (bf16*)(ws + WS_PR), (bf16*)(ws + WS_PG)};
        gemm_phase<EpiProj, StaticOrder, true, true>(F.lds, g, S, E);
    } SEAM(1);
    if (IN(2)) { p2_prep(F, args); } SEAM(2);
    if (IN(3)) {
        Gemm g{(const bf16*)(ws + WS_TOP), (const bf16*)(ws + WS_WLORA), M, LORA_N, LORA_K}; StaticOrder S; S.init(M, LORA_N, F.G, F.bid);
        EpiLora E{(bf16*)(ws + WS_LW)};
        gemm_phase<EpiLora, StaticOrder, true, true>(F.lds, g, S, E);
    } SEAM(3);
    if (IN(4)) { p4_mixers(F, args); } SEAM(4);
    if (IN(5)) { p5_combine(F, args); } SEAM(5);
    if (IN(6)) {
        Gemm g{(const bf16*)(ws + WS_ZH), (const bf16*)(ws + WS_WHY), M, DM, 512}; StaticOrder S; S.init(M, DM, F.G, F.bid);
        EpiGate<0> E{(const bf16*)(ws + WS_PG), (bf16*)(ws + WS_T), nullptr};
        gemm_phase<EpiGate<0>, StaticOrder, true, true>(F.lds, g, S, E);
    } SEAM(6);
    if (IN(7)) {
        Gemm g{(const bf16*)((unsigned char*)F.out + DO_YSF), (const bf16*)(ws + WS_WRW), M, DM, 512}; StaticOrder S; S.init(M, DM, F.G, F.bid);
        EpiGate<1> E{(const bf16*)(ws + WS_PG), (bf16*)(ws + WS_T), (bf16*)(ws + WS_MIXIN)};
        gemm_phase<EpiGate<1>, StaticOrder, true, true>(F.lds, g, S, E);
    } SEAM(7);
    if (IN(8)) {
        Gemm g{(const bf16*)(ws + WS_MIXIN), (const bf16*)(ws + WS_WO), M, DM, DM}; StaticOrder S; S.init(M, DM, F.G, F.bid);
        EpiWo E{args.in[0], (float*)(ws + WS_H1)};
        gemm_phase<EpiWo, StaticOrder, true, true>(F.lds, g, S, E);
    } SEAM(8);
    if (IN(9)) { ln1_pass(F, args); } SEAM(9);
    if (IN(10)) {
        Gemm g{(const bf16*)(ws + WS_X1B), (const bf16*)(ws + WS_WGU), M, NGU, DM}; StaticOrder S; S.init(M, NGU, F.G, F.bid);
        EpiSwiGLU E{(bf16*)(ws + WS_HID)};
        gemm_phase<EpiSwiGLU, StaticOrder, true, true>(F.lds, g, S, E);
    } SEAM(10);
    if (IN(11)) {
        Gemm g{(const bf16*)(ws + WS_HID), (const bf16*)(ws + WS_WD), M, DM, FFH}; StaticOrder S; S.init(M, DM, F.G, F.bid);
        EpiDown E{(const float*)(ws + WS_H1), (const float*)(ws + WS_STATS), args.in[27], args.in[28], F.out};
        gemm_phase<EpiDown, StaticOrder, true, true>(F.lds, g, S, E);
    } SEAM(11);
    if (IN(12)) { ln2_pass(F, args); }
#undef IN
#undef SEAM
}

extern "C" void kernel_launch(void* const* d_in, const int* in_sizes, int n_in, void* d_out, int out_size, void* d_ws, size_t ws_size, hipStream_t stream) {
    static int grid = 0;
    if (grid == 0) {
        if (n_in != 34 || out_size != M * DM || ws_size < WS_NEED) { fprintf(stderr, "kernel_launch: unexpected shapes (n_in %d out %d ws %zu)\n", n_in, out_size, ws_size); grid = -1; return; }
        int dev = 0, cus = 0, per_cu = 0;
        if (hipGetDevice(&dev) != hipSuccess || hipDeviceGetAttribute(&cus, hipDeviceAttributeMultiprocessorCount, dev) != hipSuccess) { grid = -1; return; }
        if (hipFuncSetAttribute((const void*)hybrid_fwd, hipFuncAttributeMaxDynamicSharedMemorySize, LDS_BYTES) != hipSuccess) { fprintf(stderr, "kernel_launch: hipFuncSetAttribute failed\n"); grid = -1; return; }
        if (hipOccupancyMaxActiveBlocksPerMultiprocessor(&per_cu, (const void*)hybrid_fwd, 512, LDS_BYTES) != hipSuccess || per_cu < 1) { fprintf(stderr, "kernel_launch: occupancy query says %d\n", per_cu); per_cu = 1; }
        (void)hipGetLastError();
        grid = cus;
        if (grid != 256) fprintf(stderr, "kernel_launch: %d CUs (built for 256)\n", grid);
    }
    if (grid < 0) return;
    Args a{};
    for (int i = 0; i < 34; ++i) a.in[i] = (const float*)d_in[i];
    a.out = (float*)d_out; a.ws = (unsigned char*)d_ws; a.ph_lo = 0; a.ph_hi = N_PHASES;
    void* kargs[] = {&a};
    hipError_t e = hipLaunchCooperativeKernel((void*)hybrid_fwd, dim3(grid), dim3(512), kargs, LDS_BYTES, stream);
    if (e != hipSuccess) fprintf(stderr, "kernel_launch: cooperative launch failed: %s\n", hipGetErrorString(e));
}
```

```cpp
#include <hip/hip_runtime.h>
#include <hip/hip_cooperative_groups.h>
#include <cstdio>
#include <cstdint>
namespace cg = cooperative_groups;
namespace pg8 {
#define PG8_LAS __attribute__((address_space(3)))
typedef unsigned short bf16_t;
typedef short bf16x8 __attribute__((ext_vector_type(8)));
typedef float f32x4 __attribute__((ext_vector_type(4)));
typedef unsigned u32x4 __attribute__((ext_vector_type(4)));
constexpr int BM = 256, BK = 64, HALF = 128, HTB = HALF * BK * 2  , STAGE_BYTES = 8 * HTB, NXCD = 8, WGM = 8;

__host__ __device__ __forceinline__ int lds_byte(int r, int c) { const int st = (r >> 4) * 2 + (c >> 5), rr = r & 15, cc = c & 31, ob = rr * 64 + cc * 2; return st * 1024 + (ob ^ (((ob >> 9) & 1) << 5)); }
__host__ __device__ __forceinline__ void stage_rc(int b, int& R, int& C) { const int st = b / 1024, sb = b % 1024, swz = sb ^ (((sb >> 9) & 1) << 5); R = (st >> 1) * 16 + swz / 64; C = (st & 1) * 32 + (swz % 64) / 2; }
__host__ __device__ __forceinline__ int perm32(int rho) { const int n = rho >> 4, i = rho & 15; return 8 * (i >> 2) + 4 * n + (i & 3); }

struct Unit { int pm, pn; };
struct Gemm { const bf16_t* A; const bf16_t* Bt; int M, N, K; };

struct StaticOrder {
    int nM, nN, nwg, G, c;
    __host__ __device__ void init(int M, int N, int G_, int c_) { nM = M / BM; nN = N / BM; nwg = nM * nN; G = G_; c = c_; }
    __host__ __device__ bool next(int i, Unit& u) const {
        const long L = (long)i * G + c; if (L >= nwg) return false;
        int wgid = (int)L; { const int q = nwg / NXCD, r = nwg % NXCD, xcd = wgid % NXCD, off = wgid / NXCD; wgid = (xcd < r ? xcd * (q + 1) : r * (q + 1) + (xcd - r) * q) + off; }
        const int nig = WGM * nN, gid = wgid / nig, fm = gid * WGM, gsz = (nM - fm) < WGM ? (nM - fm) : WGM;
        u.pm = fm + ((wgid % nig) % gsz); u.pn = (wgid % nig) / gsz; return true;
    }
    __device__ __forceinline__ void a_ready(const Unit&) const {}
    __device__ __forceinline__ void done(const Unit&) const {}
};

__device__ __forceinline__ unsigned cvt_pk_bf16(float lo, float hi) { unsigned r; asm volatile("v_cvt_pk_bf16_f32 %0, %1, %2" : "=v"(r) : "v"(lo), "v"(hi)); return r; }
typedef float f32x2 __attribute__((ext_vector_type(2)));
template <class Epi, class Sched, bool ALIGN_EPI = false, bool SP2 = false>
__device__ __forceinline__ void gemm_phase(PG8_LAS unsigned char* lds, const Gemm g, const Sched& S, const Epi& E) {
    const int tid = threadIdx.x, wid = __builtin_amdgcn_readfirstlane(tid >> 6), lane = tid & 63, wr = wid >> 2, wc = wid & 3, fr = lane & 15, fq = lane >> 4;
    const int K = g.K, nt = K / BK;
    unsigned voffA[2], voffB[2];
#pragma unroll
    for (int i = 0; i < 2; ++i) { int R, C; stage_rc(tid * 16 + i * 8192, R, C); const int Rb = Epi::PERM ? ((R & ~31) + perm32(R & 31)) : R;
        voffA[i] = (unsigned)(R * K + C) * 2u; voffB[i] = (unsigned)(Rb * K + C) * 2u; }
    const size_t kstep = (size_t)(BK * 2);
    const size_t hstep = (size_t)HALF * K * 2;
    const size_t tstep = 2 * hstep;
    const unsigned ldsw = (unsigned)wid * 1024u;
    const int aoff = lds_byte(wr * 64 + fr, fq * 8), boff = lds_byte(wc * 32 + fr, fq * 8);
#define PG8_SA(b, h) (((b) * 2 + (h)) * HTB)
#define PG8_SB(b, h) ((4 + (b) * 2 + (h)) * HTB)
#define PG8_STAGE(bufoff, gbase, voff) do { _Pragma("unroll") for (int _i = 0; _i < 2; ++_i) \
        __builtin_amdgcn_global_load_lds((const unsigned*)((const char*)(gbase) + (voff)[_i]), (PG8_LAS unsigned*)(lds + (bufoff) + ldsw + _i * 8192), 16, 0, 0); } while (0)
#define PG8_LDA(dst, b, h) do { _Pragma("unroll") for (int m = 0; m < 4; ++m) _Pragma("unroll") for (int k = 0; k < 2; ++k) dst[m][k] = *(const PG8_LAS bf16x8*)(lds + PG8_SA(b, h) + aoff + m * 2048 + k * 1024); } while (0)
#define PG8_LDB(dst, b, h) do { _Pragma("unroll") for (int n = 0; n < 2; ++n) _Pragma("unroll") for (int k = 0; k < 2; ++k) dst[n][k] = *(const PG8_LAS bf16x8*)(lds + PG8_SB(b, h) + boff + n * 2048 + k * 1024); } while (0)
#define PG8_MMA(ai, bj, At, Bt) do { __builtin_amdgcn_s_setprio(1); _Pragma("unroll") for (int m = 0; m < 4; ++m) _Pragma("unroll") for (int n = 0; n < 2; ++n) _Pragma("unroll") for (int k = 0; k < 2; ++k) \
        acc[ai][bj][m][n] = __builtin_amdgcn_mfma_f32_16x16x32_bf16(Bt[n][k], At[m][k], acc[ai][bj][m][n], 0, 0, 0); __builtin_amdgcn_s_setprio(0); } while (0)
#define PG8_WAIT_V(n) asm volatile("s_waitcnt vmcnt(" #n ")" ::: "memory")
#define PG8_WAIT_L(n) asm volatile("s_waitcnt lgkmcnt(" #n ")" ::: "memory")
#define PG8_BAR __builtin_amdgcn_s_barrier()
#define PG8_SCHED __builtin_amdgcn_sched_barrier(0)
    Unit cur, nxt; int ui = 0;
    if (!S.next(0, cur)) return;
    f32x4 acc[2][2][4][2];
#pragma unroll
    for (int a = 0; a < 2; ++a)
#pragma unroll
        for (int b = 0; b < 2; ++b)
#pragma unroll
            for (int m = 0; m < 4; ++m)
#pragma unroll
                for (int n = 0; n < 2; ++n) acc[a][b][m][n] = (f32x4){0.f, 0.f, 0.f, 0.f};
    bf16x8 At[4][2], B0[2][2], B1[2][2];
    const char* cA = (const char*)g.A + (size_t)cur.pm * tstep; const char* cB = (const char*)g.Bt + (size_t)cur.pn * tstep;
    S.a_ready(cur);
    if constexpr (SP2) {
        PG8_STAGE(PG8_SB(0, 0), cB, voffB); PG8_STAGE(PG8_SB(0, 1), cB + hstep, voffB); PG8_STAGE(PG8_SA(0, 0), cA, voffA); PG8_STAGE(PG8_SA(0, 1), cA + hstep, voffA);
        if (wr == 1) PG8_BAR;
        PG8_WAIT_V(2); PG8_BAR;
        PG8_STAGE(PG8_SB(1, 0), cB + kstep, voffB); PG8_STAGE(PG8_SA(1, 0), cA + kstep, voffA); PG8_STAGE(PG8_SB(1, 1), cB + hstep + kstep, voffB);
        PG8_WAIT_V(6); PG8_BAR;
    } else {
        PG8_STAGE(PG8_SB(0, 0), cB, voffB); PG8_STAGE(PG8_SA(0, 0), cA, voffA); PG8_STAGE(PG8_SB(0, 1), cB + hstep, voffB); PG8_STAGE(PG8_SA(0, 1), cA + hstep, voffA);
        if (wr == 1) PG8_BAR;
        PG8_WAIT_V(4); PG8_BAR;
        PG8_STAGE(PG8_SB(1, 0), cB + kstep, voffB); PG8_STAGE(PG8_SA(1, 0), cA + kstep, voffA); PG8_STAGE(PG8_SB(1, 1), cB + hstep + kstep, voffB);
        PG8_WAIT_V(6); PG8_BAR;
    }
    for (;;) {
        const bool has_next = S.next(ui + 1, nxt);
        const char* nA = has_next ? (const char*)g.A + (size_t)nxt.pm * tstep : cA; const char* nB = has_next ? (const char*)g.Bt + (size_t)nxt.pn * tstep : cB;
#pragma unroll 1
        for (int t = 0; t < nt; t += 2) {
            const bool last = (t == nt - 2);
            const char* a1 = cA + (size_t)(t + 1) * kstep;
            const char* a2 = last ? nA : cA + (size_t)(t + 2) * kstep; const char* b2 = last ? nB : cB + (size_t)(t + 2) * kstep;
            const char* a3 = a2 + kstep; const char* b3 = b2 + kstep;
            if (last && has_next) S.a_ready(nxt);
            if constexpr (SP2) {
            PG8_LDB(B0, 0, 0); PG8_LDB(B1, 0, 1); PG8_SCHED; PG8_LDA(At, 0, 0); PG8_STAGE(PG8_SA(1, 1), a1 + hstep, voffA);
            PG8_WAIT_V(8); PG8_WAIT_L(0); PG8_BAR; PG8_MMA(0, 0, At, B0); PG8_MMA(0, 1, At, B1); PG8_BAR; PG8_SCHED;
            PG8_LDA(At, 0, 1); PG8_STAGE(PG8_SB(0, 0), b2, voffB); PG8_STAGE(PG8_SB(0, 1), b2 + hstep, voffB); PG8_STAGE(PG8_SA(0, 0), a2, voffA);
            PG8_WAIT_V(8); PG8_WAIT_L(0); PG8_BAR; PG8_MMA(1, 0, At, B0); PG8_MMA(1, 1, At, B1); PG8_BAR; PG8_SCHED;
            PG8_LDB(B0, 1, 0); PG8_LDB(B1, 1, 1); PG8_SCHED; PG8_LDA(At, 1, 0); PG8_STAGE(PG8_SA(0, 1), a2 + hstep, voffA);
            PG8_WAIT_V(8); PG8_WAIT_L(0); PG8_BAR; PG8_MMA(0, 0, At, B0); PG8_MMA(0, 1, At, B1); PG8_BAR; PG8_SCHED;
            PG8_LDA(At, 1, 1); PG8_STAGE(PG8_SB(1, 0), b3, voffB); PG8_STAGE(PG8_SB(1, 1), b3 + hstep, voffB); PG8_STAGE(PG8_SA(1, 0), a3, voffA);
            PG8_WAIT_V(8); PG8_WAIT_L(0); PG8_BAR; PG8_MMA(1, 0, At, B0); PG8_MMA(1, 1, At, B1); PG8_BAR; PG8_SCHED;
            } else {
            PG8_LDB(B0, 0, 0); PG8_SCHED; PG8_LDA(At, 0, 0); PG8_STAGE(PG8_SA(1, 1), a1 + hstep, voffA);
            PG8_WAIT_L(8); PG8_BAR; PG8_WAIT_L(0); PG8_MMA(0, 0, At, B0); PG8_BAR; PG8_SCHED;
            PG8_LDB(B1, 0, 1); PG8_STAGE(PG8_SB(0, 0), b2, voffB);
            PG8_BAR; PG8_WAIT_L(0); PG8_MMA(0, 1, At, B1); PG8_BAR;
            PG8_LDA(At, 0, 1); PG8_STAGE(PG8_SA(0, 0), a2, voffA);
            PG8_BAR; PG8_WAIT_L(0); PG8_MMA(1, 0, At, B0); PG8_BAR; PG8_SCHED;
            PG8_STAGE(PG8_SB(0, 1), b2 + hstep, voffB);
            PG8_WAIT_V(6); PG8_BAR; PG8_MMA(1, 1, At, B1); PG8_BAR;
            PG8_LDB(B0, 1, 0); PG8_SCHED; PG8_LDA(At, 1, 0); PG8_STAGE(PG8_SA(0, 1), a2 + hstep, voffA);
            PG8_WAIT_L(8); PG8_BAR; PG8_WAIT_L(0); PG8_MMA(0, 0, At, B0); PG8_BAR; PG8_SCHED;
            PG8_LDB(B1, 1, 1); PG8_STAGE(PG8_SB(1, 0), b3, voffB);
            PG8_BAR; PG8_WAIT_L(0); PG8_MMA(0, 1, At, B1); PG8_BAR;
            PG8_LDA(At, 1, 1); PG8_STAGE(PG8_SA(1, 0), a3, voffA);
            PG8_BAR; PG8_WAIT_L(0); PG8_MMA(1, 0, At, B0); PG8_BAR; PG8_SCHED;
            PG8_STAGE(PG8_SB(1, 1), b3 + hstep, voffB);
            PG8_WAIT_V(6); PG8_BAR; PG8_MMA(1, 1, At, B1); PG8_BAR;
            }
        }
        if constexpr (ALIGN_EPI) { if (wr == 0) PG8_BAR; }
        if constexpr (!Epi::AFTER_DRAIN) { E(acc, cur, wr, wc, fr, fq); S.done(cur); }
        if (!has_next) break;
#pragma unroll
        for (int a = 0; a < 2; ++a)
#pragma unroll
            for (int b = 0; b < 2; ++b)
#pragma unroll
                for (int m = 0; m < 4; ++m)
#pragma unroll
                    for (int n = 0; n < 2; ++n) acc[a][b][m][n] = (f32x4){0.f, 0.f, 0.f, 0.f};
        cur = nxt; cA = nA; cB = nB; ++ui;
        if constexpr (ALIGN_EPI) { if (wr == 1) PG8_BAR; }
    }
    PG8_WAIT_V(0);
    if constexpr (!ALIGN_EPI) { if (wr == 0) PG8_BAR; }
    PG8_BAR;
    if constexpr (Epi::AFTER_DRAIN) { E.fused(acc, cur, wr, wc, fr, fq, lds, wid, lane); S.done(cur); }
#undef PG8_SA
#undef PG8_SB
#undef PG8_STAGE
#undef PG8_LDA
#undef PG8_LDB
#undef PG8_MMA
#undef PG8_WAIT_V
#undef PG8_WAIT_L
#undef PG8_BAR
#undef PG8_SCHED
}
}

constexpr int NB = 8, SEQ = 4096, DM = 1024, M = NB * SEQ;
constexpr int NHEAD = 8;
constexpr int PH_P = 1536, PR_P = 1920, PG_P = 2048;
constexpr int NP = 5632;
constexpr int FFH = 2816, NGU = 5632;
constexpr int LORA_K = 384, LORA_N = 2560;
constexpr float DN_ALPHA = 1.18920711500272f;
constexpr float LN_EPS = 1e-5f, GN_EPS = 64e-5f;
constexpr float HY_MIN_DECAY = -3.07011346f, HY_MAX_DECAY = -15.3505673f;
constexpr int NWAVES = 8;

constexpr size_t MiB = 1u << 20;
constexpr size_t WS_H3T = 1 * MiB;
constexpr size_t WS_STATS = 2 * MiB;
constexpr size_t WS_BONUS = 3 * MiB;
constexpr size_t WS_WIN = 5 * MiB, WS_WGU = 16 * MiB, WS_WD = 27 * MiB, WS_WO = 33 * MiB, WS_WHY = 35 * MiB, WS_WRW = 36 * MiB, WS_WLORA = 37 * MiB;
constexpr size_t WS_FT = 39 * MiB;
constexpr size_t WS_XB = 71 * MiB;
constexpr size_t WS_LW = 71 * MiB;
constexpr size_t WS_PH = 135 * MiB, WS_PR = 231 * MiB, WS_PG = 351 * MiB;
constexpr size_t WS_TOP = 479 * MiB;
constexpr size_t WS_ZH = 71 * MiB, WS_T = 103 * MiB, WS_MIXIN = 167 * MiB;
constexpr size_t WS_H1 = 351 * MiB, WS_X1B = 71 * MiB, WS_HID = 135 * MiB;
constexpr size_t WS_NEED = 511 * MiB;
constexpr size_t DO_HT = 0, DO_YSF = 96 * MiB;

#define GAS __attribute__((address_space(1)))
#define LAS __attribute__((address_space(3)))
typedef unsigned short bf16;
typedef unsigned v4u __attribute__((ext_vector_type(4)));
typedef unsigned v2u __attribute__((ext_vector_type(2)));
typedef float f32x4 __attribute__((ext_vector_type(4)));
typedef float f32x16 __attribute__((ext_vector_type(16)));
typedef short bf16x8 __attribute__((ext_vector_type(8)));

__device__ __forceinline__ float bf2f(unsigned b) { return __uint_as_float(b << 16); }
__device__ __forceinline__ float bflo(unsigned w) { return __uint_as_float(w << 16); }
__device__ __forceinline__ float bfhi(unsigned w) { return __uint_as_float(w & 0xffff0000u); }
__device__ __forceinline__ unsigned f2bf(float f) { unsigned u = __float_as_uint(f); return (u + 0x7fffu + ((u >> 16) & 1u)) >> 16; }
__device__ __forceinline__ unsigned pk2(float lo, float hi) { return f2bf(lo) | (f2bf(hi) << 16); }
__device__ __forceinline__ float sigmoidf_(float x) { return 1.0f / (1.0f + __expf(-x)); }
__device__ __forceinline__ float wave_sum(float v) {
#pragma unroll
    for (int o = 1; o < 64; o <<= 1) v += __shfl_xor(v, o);
    return v;
}

struct Frame {
    LAS unsigned char* lds;
    int tid, lane, wave, G, bid;
    float* out; unsigned char* ws;
};
struct Args { const float* in[34]; float* out; unsigned char* ws; int ph_lo, ph_hi; };

using pg8::Unit; using pg8::cvt_pk_bf16; constexpr int HALF = 128, BM = 256;

__device__ __forceinline__ v4u pack8(f32x4 v0, f32x4 v1) { v4u w; w.x = cvt_pk_bf16(v0[0], v0[1]); w.y = cvt_pk_bf16(v0[2], v0[3]); w.z = cvt_pk_bf16(v1[0], v1[1]); w.w = cvt_pk_bf16(v1[2], v1[3]); return w; }

struct EpiProj {
    static constexpr bool PERM = true, AFTER_DRAIN = false;
    bf16 *PH, *PR, *PG;
    __device__ __forceinline__ void operator()(const f32x4 (&acc)[2][2][4][2], const Unit& u, int wr, int wc, int fr, int fq) const {
        const int row0 = u.pm * BM + wr * 64 + fr;
#pragma unroll
        for (int bj = 0; bj < 2; ++bj) {
            const int hb = 2 * u.pn + bj; bf16* base; int pitch, col;
            if (hb < 12) { base = PH; pitch = PH_P; col = 128 * hb; }
            else if (hb < 27) { base = PR; pitch = PR_P; col = 128 * (hb - 12); }
            else if (hb < 43) { base = PG; pitch = PG_P; col = 128 * (hb - 27); }
            else continue;
            col += wc * 32 + 8 * fq;
#pragma unroll
            for (int ai = 0; ai < 2; ++ai)
#pragma unroll
                for (int m = 0; m < 4; ++m)
                    *(v4u*)(base + (size_t)(row0 + ai * HALF + m * 16) * pitch + col) = pack8(acc[ai][bj][m][0], acc[ai][bj][m][1]);
        }
    }
};

struct EpiLora {
    static constexpr bool PERM = true, AFTER_DRAIN = false;
    bf16* LW;
    __device__ __forceinline__ void operator()(const f32x4 (&acc)[2][2][4][2], const Unit& u, int wr, int wc, int fr, int fq) const {
        const int row0 = u.pm * BM + wr * 64 + fr;
        bf16* base = LW + (size_t)(u.pn >> 1) * ((size_t)M * 512) + (u.pn & 1) * 256 + wc * 32 + 8 * fq;
#pragma unroll
        for (int ai = 0; ai < 2; ++ai)
#pragma unroll
            for (int m = 0; m < 4; ++m) { bf16* rowp = base + (size_t)(row0 + ai * HALF + m * 16) * 512;
#pragma unroll
                for (int bj = 0; bj < 2; ++bj) *(v4u*)(rowp + bj * HALF) = pack8(acc[ai][bj][m][0], acc[ai][bj][m][1]); }
    }
};

template <int STAGE> struct EpiGate {
    static constexpr bool PERM = true, AFTER_DRAIN = false;
    const bf16* PG; bf16* T; bf16* O;
    __device__ __forceinline__ void operator()(const f32x4 (&acc)[2][2][4][2], const Unit& u, int wr, int wc, int fr, int fq) const {
        const int row0 = u.pm * BM + wr * 64 + fr;
#pragma unroll
        for (int bj = 0; bj < 2; ++bj) {
            const int col = u.pn * BM + bj * HALF + wc * 32 + 8 * fq;
#pragma unroll
            for (int ai = 0; ai < 2; ++ai)
#pragma unroll
                for (int m = 0; m < 4; ++m) {
                    const size_t row = (size_t)(row0 + ai * HALF + m * 16);
                    const v4u g = *(const v4u*)(PG + row * PG_P + STAGE * 1024 + col);
                    f32x4 v0 = acc[ai][bj][m][0], v1 = acc[ai][bj][m][1];
                    v0[0] *= sigmoidf_(bflo(g.x)); v0[1] *= sigmoidf_(bfhi(g.x)); v0[2] *= sigmoidf_(bflo(g.y)); v0[3] *= sigmoidf_(bfhi(g.y));
                    v1[0] *= sigmoidf_(bflo(g.z)); v1[1] *= sigmoidf_(bfhi(g.z)); v1[2] *= sigmoidf_(bflo(g.w)); v1[3] *= sigmoidf_(bfhi(g.w));
                    if (STAGE == 1) {
                        const v4u t = *(const v4u*)(T + row * 1024 + col);
                        v0[0] += bflo(t.x); v0[1] += bfhi(t.x); v0[2] += bflo(t.y); v0[3] += bfhi(t.y);
                        v1[0] += bflo(t.z); v1[1] += bfhi(t.z); v1[2] += bflo(t.w); v1[3] += bfhi(t.w);
                        *(v4u*)(O + row * 1024 + col) = pack8(v0, v1);
                    } else {
                        *(v4u*)(T + row * 1024 + col) = pack8(v0, v1);
                    }
                }
        }
    }
};

struct EpiWo {
    static constexpr bool PERM = false, AFTER_DRAIN = false;
    const float* X; float* H1;
    __device__ __forceinline__ void operator()(const f32x4 (&acc)[2][2][4][2], const Unit& u, int wr, int wc, int fr, int fq) const {
        const int row0 = u.pm * BM + wr * 64 + fr, col0 = u.pn * BM + wc * 32 + 4 * fq;
#pragma unroll
        for (int ai = 0; ai < 2; ++ai)
#pragma unroll
            for (int m = 0; m < 4; ++m) {
                const size_t off = (size_t)(row0 + ai * HALF + m * 16) * DM + col0;
#pragma unroll
                for (int bj = 0; bj < 2; ++bj)
#pragma unroll
                    for (int n = 0; n < 2; ++n) {
                        const f32x4 xv = *(const f32x4*)(X + off + bj * HALF + n * 16);
                        *(f32x4*)(H1 + off + bj * HALF + n * 16) = xv * DN_ALPHA + acc[ai][bj][m][n];
                    }
            }
    }
};

struct EpiSwiGLU {
    static constexpr bool PERM = true, AFTER_DRAIN = false;
    bf16* HID;
    __device__ __forceinline__ void operator()(const f32x4 (&acc)[2][2][4][2], const Unit& u, int wr, int wc, int fr, int fq) const {
        const int row0 = u.pm * BM + wr * 64 + fr, col = u.pn * HALF + wc * 32 + 8 * fq;
#pragma unroll
        for (int ai = 0; ai < 2; ++ai)
#pragma unroll
            for (int m = 0; m < 4; ++m) {
                f32x4 g0 = acc[ai][0][m][0], g1 = acc[ai][0][m][1]; const f32x4 u0 = acc[ai][1][m][0], u1 = acc[ai][1][m][1];
#pragma unroll
                for (int j = 0; j < 4; ++j) { g0[j] = g0[j] * sigmoidf_(g0[j]) * u0[j]; g1[j] = g1[j] * sigmoidf_(g1[j]) * u1[j]; }
                *(v4u*)(HID + (size_t)(row0 + ai * HALF + m * 16) * FFH + col) = pack8(g0, g1);
            }
    }
};

struct EpiDown {
    static constexpr bool PERM = false, AFTER_DRAIN = false;
    const float* H1; const float* STATS; const float* lnw; const float* lnb; float* O;
    __device__ __forceinline__ void operator()(const f32x4 (&acc)[2][2][4][2], const Unit& u, int wr, int wc, int fr, int fq) const {
        const int row0 = u.pm * BM + wr * 64 + fr, col0 = u.pn * BM + wc * 32 + 4 * fq;
#pragma unroll
        for (int ai = 0; ai < 2; ++ai)
#pragma unroll
            for (int m = 0; m < 4; ++m) {
                const int row = row0 + ai * HALF + m * 16; const size_t off = (size_t)row * DM + col0;
                const float mean = STATS[2 * row], rstd = STATS[2 * row + 1];
#pragma unroll
                for (int bj = 0; bj < 2; ++bj)
#pragma unroll
                    for (int n = 0; n < 2; ++n) {
                        const f32x4 hv = *(const f32x4*)(H1 + off + bj * HALF + n * 16);
                        const f32x4 wv = *(const f32x4*)(lnw + col0 + bj * HALF + n * 16), bv = *(const f32x4*)(lnb + col0 + bj * HALF + n * 16);
                        const f32x4 x1 = (hv - mean) * rstd * wv + bv;
                        *(f32x4*)(O + off + bj * HALF + n * 16) = x1 * DN_ALPHA + acc[ai][bj][m][n];
                    }
            }
    }
};

__device__ __forceinline__ void p0_transpose_item(const float* W, int K, int N, bf16* WT, int dst_row0, int k0, int n0, LAS float* scr, int lane) {
#pragma unroll 8
    for (int i = 0; i < 32; ++i) { const int kk = 2 * i + (lane >> 5); scr[kk * 33 + (lane & 31)] = W[(size_t)(k0 + kk) * N + n0 + (lane & 31)]; }
    asm volatile("s_waitcnt lgkmcnt(0)" ::: "memory");
    const int c = lane & 7;
#pragma unroll
    for (int j = 0; j < 4; ++j) { const int n = (lane >> 3) + 8 * j; const LAS float* s = scr + (8 * c) * 33 + n;
        v4u o; o.x = pk2(s[0 * 33], s[1 * 33]); o.y = pk2(s[2 * 33], s[3 * 33]); o.z = pk2(s[4 * 33], s[5 * 33]); o.w = pk2(s[6 * 33], s[7 * 33]);
        *(v4u*)(WT + (size_t)(dst_row0 + n) * K + k0 + 8 * c) = o; }
    asm volatile("s_waitcnt lgkmcnt(0)" ::: "memory");
}

__device__ __forceinline__ void p0_prologue(Frame& F, const Args& AR) {
    LAS float* scr = (LAS float*)(F.lds + F.wave * 16384);
    const int gw = F.bid * NWAVES + F.wave, NGW = F.G * NWAVES, lane = F.lane;
    unsigned char* ws = F.ws;
    constexpr int I_IN = (1024 / 64) * (5504 / 32), I_GU = (1024 / 64) * (2816 / 32), I_D = (2816 / 64) * (1024 / 32), I_O = 16 * 32, I_HY = 8 * 32;
    constexpr int NITEMS = I_IN + 2 * I_GU + I_D + I_O + 2 * I_HY;
    for (int it = gw; it < NITEMS; it += NGW) {
        int r = it;
        if (r < I_IN) { const int nblk = 5504 / 32, kb = r / nblk, nb = r % nblk; p0_transpose_item(AR.in[1], 1024, 5504, (bf16*)(ws + WS_WIN), 32 * nb, 64 * kb, 32 * nb, scr, lane); continue; } r -= I_IN;
        if (r < 2 * I_GU) { const int up = r >= I_GU; if (up) r -= I_GU; const int nblk = 2816 / 32, kb = r / nblk, nb = r % nblk, n0 = 32 * nb;
            p0_transpose_item(AR.in[up ? 30 : 29], 1024, 2816, (bf16*)(ws + WS_WGU), (n0 >> 7) * 256 + (n0 & 127) + (up ? 128 : 0), 64 * kb, n0, scr, lane); continue; } r -= 2 * I_GU;
        if (r < I_D) { const int nblk = 32, kb = r / nblk, nb = r % nblk; p0_transpose_item(AR.in[31], 2816, 1024, (bf16*)(ws + WS_WD), 32 * nb, 64 * kb, 32 * nb, scr, lane); continue; } r -= I_D;
        if (r < I_O) { const int kb = r / 32, nb = r % 32; p0_transpose_item(AR.in[26], 1024, 1024, (bf16*)(ws + WS_WO), 32 * nb, 64 * kb, 32 * nb, scr, lane); continue; } r -= I_O;
        if (r < I_HY) { const int kb = r / 32, nb = r % 32; p0_transpose_item(AR.in[24], 512, 1024, (bf16*)(ws + WS_WHY), 32 * nb, 64 * kb, 32 * nb, scr, lane); continue; } r -= I_HY;
        { const int kb = r / 32, nb = r % 32; p0_transpose_item(AR.in[25], 512, 1024, (bf16*)(ws + WS_WRW), 32 * nb, 64 * kb, 32 * nb, scr, lane); }
    }
    const size_t gt = (size_t)F.bid * 512 + F.tid, NT = (size_t)F.G * 512;
    { v4u z = {0u, 0u, 0u, 0u}; v4u* p = (v4u*)((bf16*)(ws + WS_WIN) + (size_t)5504 * 1024); for (size_t i = gt; i < (size_t)128 * 1024 / 8; i += NT) p[i] = z; }
    { bf16* WL = (bf16*)(ws + WS_WLORA);
      for (size_t i = gt; i < (size_t)LORA_N * LORA_K; i += NT) {
          const int n = (int)(i / LORA_K), k = (int)(i % LORA_K), blk = n >> 9, c = n & 511; float v = 0.f;
          if (blk < 2) { if ((k >> 6) == blk) v = AR.in[15][((size_t)blk * 64 + (k & 63)) * 512 + c]; }
          else if (blk < 4) { if ((k >> 6) == blk) v = AR.in[17][((size_t)(blk - 2) * 64 + (k & 63)) * 512 + c]; }
          else { if (k >= 256) v = AR.in[18][(size_t)(k - 256) * 512 + c]; }
          WL[i] = (bf16)f2bf(v);
      } }
    { const f32x4* x4 = (const f32x4*)AR.in[0]; v4u* xb = (v4u*)(ws + WS_XB);
      for (size_t i = gt; i < (size_t)M * DM / 8; i += NT) { const f32x4 a = x4[2 * i], b = x4[2 * i + 1]; xb[i] = pack8(a, b); } }
    { float* H3T = (float*)(ws + WS_H3T);
      const float* fw1 = AR.in[4]; const float* fb1 = AR.in[5]; const float* fw2 = AR.in[6]; const float* fb2 = AR.in[7]; const float* fw3 = AR.in[8]; const float* fb3 = AR.in[9]; const float* sf = AR.in[11];
      for (int pos = gw; pos < SEQ; pos += NGW) {
          const float t = (float)pos / 4095.0f, wv = 6.283185307179586f * (float)pos / 4096.0f;
          float feat = 0.f;
          if (lane == 0) feat = t;
          else if (lane <= 32) { const int j = (lane - 1) & 15; const float f = 1e-4f + (float)j * ((15.0f - 1e-4f) / 15.0f); const float ang = wv * f; feat = (lane <= 16) ? cosf(ang) : -sinf(ang); }
          float z = fb1[lane];
#pragma unroll
          for (int f = 0; f < 33; ++f) z += __shfl(feat, f) * fw1[f * 64 + lane];
          float h = sinf(sf[lane] * z);
          z = fb2[lane];
#pragma unroll 8
          for (int j = 0; j < 64; ++j) z += __shfl(h, j) * fw2[j * 64 + lane];
          h = sinf(sf[64 + lane] * z);
          z = fb3[lane];
#pragma unroll 8
          for (int j = 0; j < 64; ++j) z += __shfl(h, j) * fw3[j * 64 + lane];
          h = sinf(sf[128 + lane] * z);
          H3T[lane * SEQ + pos] = h;
      } }
}

__device__ __forceinline__ void p2_prep(Frame& F, const Args& AR) {
    unsigned char* ws = F.ws; const int tid = F.tid, lane = F.lane;
    { const bf16* PH = (const bf16*)(ws + WS_PH); bf16* HT = (bf16*)((unsigned char*)F.out + DO_HT);
      const float* cw = AR.in[2]; const float* cb = AR.in[3];
      LAS bf16* raw = (LAS bf16*)F.lds;
      constexpr int NIT = NB * (SEQ / 64) * (PH_P / 64);
      for (int it = F.bid; it < NIT; it += F.G) {
          const int cbk = it % 24, tb = (it / 24) % 64, b = it / (24 * 64); const int t0 = tb * 64, c0 = cbk * 64;
          __syncthreads();
          for (int e = tid; e < 66 * 8; e += 512) {
              const int row = e >> 3, ch = e & 7; const int t = t0 - 1 + row; v4u v = {0u, 0u, 0u, 0u};
              if (t >= 0 && t < SEQ) v = *(const v4u*)(PH + ((size_t)b * SEQ + t) * PH_P + c0 + 8 * ch);
              LAS unsigned* d = (LAS unsigned*)(raw + row * 66 + 8 * ch); d[0] = v.x; d[1] = v.y; d[2] = v.z; d[3] = v.w;
          }
          __syncthreads();
          const int cl = tid & 63, tg = tid >> 6, col = c0 + cl;
          const float w0 = cw[col], w1 = cw[PH_P + col], w2 = cw[2 * PH_P + col], bb = cb[col];
          float r[10];
#pragma unroll
          for (int i = 0; i < 10; ++i) r[i] = bf2f(raw[(8 * tg + i) * 66 + cl]);
          float o[8];
#pragma unroll
          for (int i = 0; i < 8; ++i) o[i] = w0 * r[i] + w1 * r[i + 1] + w2 * r[i + 2] + bb;
          v4u w; w.x = pk2(o[0], o[1]); w.y = pk2(o[2], o[3]); w.z = pk2(o[4], o[5]); w.w = pk2(o[6], o[7]);
          const int which = col >> 9, c = col & 511;
          *(v4u*)(HT + (((size_t)which * 512 + c) * NB + b) * SEQ + t0 + 8 * tg) = w;
      }
      __syncthreads();
    }
    const size_t gt = (size_t)F.bid * 512 + tid, NT = (size_t)F.G * 512;
    { const bf16* PR = (const bf16*)(ws + WS_PR); bf16* LIN = (bf16*)(ws + WS_TOP); const float* mu = AR.in[13];
      for (size_t i = gt; i < (size_t)M * 96; i += NT) {
          const int m = (int)(i / 96), cg4 = (int)(i % 96), t = m & (SEQ - 1); const int col = 1536 + 4 * cg4;
          const bf16* p = PR + (size_t)m * PR_P + col;
          const v2u c = *(const v2u*)p; v2u pv = {0u, 0u}, nv = {0u, 0u};
          if (t > 0) pv = *(const v2u*)(p - PR_P);
          if (t < SEQ - 1) nv = *(const v2u*)(p + PR_P);
          const f32x4 muv = *(const f32x4*)(mu + col);
          float u[4], pr[4], nx[4];
          u[0] = bflo(c.x); u[1] = bfhi(c.x); u[2] = bflo(c.y); u[3] = bfhi(c.y);
          pr[0] = bflo(pv.x); pr[1] = bfhi(pv.x); pr[2] = bflo(pv.y); pr[3] = bfhi(pv.y);
          nx[0] = bflo(nv.x); nx[1] = bfhi(nv.x); nx[2] = bflo(nv.y); nx[3] = bfhi(nv.y);
#pragma unroll
          for (int j = 0; j < 4; ++j) { float s = u[j] + muv[j] * (0.5f * (pr[j] + nx[j]) - u[j]);
              if (cg4 < 32) s = tanhf(s); else if (cg4 >= 64) s = sigmoidf_(s); u[j] = s; }
          v2u o; o.x = pk2(u[0], u[1]); o.y = pk2(u[2], u[3]);
          *(v2u*)(LIN + (size_t)m * LORA_K + 4 * cg4) = o;
      } }
    { const float* H3T = (const float*)(ws + WS_H3T); const float* fw4 = AR.in[10]; const float* skip = AR.in[12];
      bf16* FT = (bf16*)(ws + WS_FT);
      const int gw = F.bid * NWAVES + F.wave, NGW = F.G * NWAVES;
      for (int it = gw; it < 1024; it += NGW) {
          const int o = it >> 9, c = it & 511;
          const float wf = fw4[(size_t)lane * 2048 + o * 1024 + c], wb = fw4[(size_t)lane * 2048 + o * 1024 + 512 + c];
          const float delta = fabsf(HY_MIN_DECAY + (float)c * ((HY_MAX_DECAY - HY_MIN_DECAY) / 511.0f));
          const float sk = skip[o * 512 + c];
          bf16* TE = FT + (size_t)it * 16384; bf16* TO = TE + 8192;
          if (lane == 0) { TE[0] = 0; TE[1] = 0; TO[1] = 0; }
          for (int pi = 0; pi < 64; ++pi) {
              const int pos = pi * 64 + lane; float hf = 0.f, hb = 0.f;
#pragma unroll 8
              for (int j = 0; j < 64; ++j) { const float hv = H3T[j * SEQ + pos]; hf += hv * __shfl(wf, j); hb += hv * __shfl(wb, j); }
              const float win = expf(-((float)pos / 4095.0f) * delta);
              if (pos == 0) { const bf16 v = (bf16)f2bf(hf + hb + sk); TE[2 * 2048] = v; TO[2 * 2048 + 1] = v; }
              else {
                  const bf16 vf = (bf16)f2bf(hf * win), vb = (bf16)f2bf(hb * win);
                  { const int d = pos, n = d >> 1;
                    if (d & 1) { TO[2 * (n + 2048)] = vf; if (n + 1 + 2048 < 4096) TE[2 * (n + 1 + 2048) + 1] = vf; }
                    else { TE[2 * (n + 2048)] = vf; TO[2 * (n + 2048) + 1] = vf; } }
                  { const int d = -pos, n = d >> 1;
                    if (d & 1) { TO[2 * (n + 2048)] = vb; TE[2 * (n + 1 + 2048) + 1] = vb; }
                    else { TE[2 * (n + 2048)] = vb; TO[2 * (n + 2048) + 1] = vb; } }
              }
          }
      } }
}

constexpr int HL_TE = 0, HL_TO = 16384 + 64, HL_Z = 32896, HZ_ROW = 80, HZ_PAD = 24;

__device__ __forceinline__ void hyena_item(Frame& F, const Args& AR, int c, bool dry) {
    LAS unsigned char* lds = F.lds; const int tid = F.tid, lane = F.lane, wave = F.wave;
    bf16* HT = (bf16*)((unsigned char*)F.out + DO_HT);
    const bf16* FT = (const bf16*)(F.ws + WS_FT);
    const int r = lane & 31, h = lane >> 5, par = r & 1;
    __syncthreads();
    if (tid < 240) { const int rr = tid / 5, ch = tid % 5; const int row = rr < 24 ? rr : 1024 + rr; v4u z = {0u, 0u, 0u, 0u}; *(LAS v4u*)(lds + HL_Z + row * HZ_ROW + 16 * ch) = z; }
    { const v4u* src = (const v4u*)(HT + ((size_t)0 * 512 + c) * NB * SEQ);
#pragma unroll
      for (int it = 0; it < 8; ++it) { const int rem = tid; const v4u v = src[it * 512 + rem];
          *(LAS v4u*)(lds + HL_Z + (((rem >> 2) * 8 + it) + HZ_PAD) * HZ_ROW + (rem & 3) * 16) = v; } }
#pragma unroll 1
    for (int o = 0; o < 2; ++o) {
        { const v4u* src = (const v4u*)(FT + ((size_t)o * 512 + c) * 16384);
#pragma unroll
          for (int it = 0; it < 4; ++it) { const int e = it * 512 + tid; const v4u v = src[e]; *(LAS v4u*)(lds + (e < 1024 ? HL_TE + e * 16 : HL_TO + (e - 1024) * 16)) = v; } }
        __syncthreads();
        f32x16 acc[4];
#pragma unroll
        for (int nn = 0; nn < 4; ++nn)
#pragma unroll
            for (int j = 0; j < 16; ++j) acc[nn][j] = 0.f;
        const LAS unsigned* T = (const LAS unsigned*)(lds + (par ? HL_TO : HL_TE));
        const int nb0 = 4 * wave;
#pragma unroll 1
        for (int q = 16 * wave - 127; q <= 16 * wave + 15; ++q) {
#pragma unroll
            for (int jh = 0; jh < 2; ++jh) {
                const int base = 32 * q + r - 16 * jh - 8 * h;
                const int n0 = ((base - par) >> 1) + 2048;
                v4u av; av.x = T[n0]; av.y = T[n0 - 1]; av.z = T[n0 - 2]; av.w = T[n0 - 3];
                const bf16x8 A = __builtin_bit_cast(bf16x8, av);
#pragma unroll
                for (int nn = 0; nn < 4; ++nn) {
                    const int n = nb0 + nn;
                    if (q >= 4 * n - 127 && q <= 4 * n + 3) {
                        const int row = 32 * n + r - 8 * q + HZ_PAD;
                        const bf16x8 Bf = *(const LAS bf16x8*)(lds + HL_Z + row * HZ_ROW + 32 * jh + 16 * h);
                        acc[nn] = __builtin_amdgcn_mfma_f32_32x32x16_bf16(A, Bf, acc[nn], 0, 0, 0);
                    }
                }
            }
        }
        __syncthreads();
        const bf16* XG = HT + ((size_t)(1 + o) * 512 + c) * NB * SEQ;
#pragma unroll
        for (int nn = 0; nn < 4; ++nn) {
            const int colg = 32 * (nb0 + nn) + r, tb = colg >> 3, b = colg & 7;
#pragma unroll
            for (int g = 0; g < 4; ++g) {
                const int i0 = 8 * g + 4 * h;
                const v2u xv = *(const v2u*)(XG + (size_t)b * SEQ + 32 * tb + i0);
                v2u w; w.x = pk2(acc[nn][4 * g + 0] * bflo(xv.x), acc[nn][4 * g + 1] * bfhi(xv.x)); w.y = pk2(acc[nn][4 * g + 2] * bflo(xv.y), acc[nn][4 * g + 3] * bfhi(xv.y));
                *(LAS v2u*)(lds + HL_Z + (colg + HZ_PAD) * HZ_ROW + i0 * 2) = w;
            }
        }
        __syncthreads();
    }
    if (!dry) { v4u* dst = (v4u*)(HT + ((size_t)0 * 512 + c) * NB * SEQ);
#pragma unroll
      for (int it = 0; it < 8; ++it) { const int rem = tid; dst[it * 512 + rem] = *(const LAS v4u*)(lds + HL_Z + (((rem >> 2) * 8 + it) + HZ_PAD) * HZ_ROW + (rem & 3) * 16); } }
}

constexpr int SC_SLOT = 464;
template <int CTRL> __device__ __forceinline__ float dppf(float x) { return __builtin_bit_cast(float, __builtin_amdgcn_update_dpp(0, __builtin_bit_cast(int, x), CTRL, 0xf, 0xf, true)); }
__device__ __forceinline__ float xsum16(float x) { float a = x, b = x; asm volatile("s_nop 1\n\tv_permlane16_swap_b32 %0, %1" : "+v"(a), "+v"(b)); return a + b; }
__device__ __forceinline__ float xsum32(float x) { float a = x, b = x; asm volatile("s_nop 1\n\tv_permlane32_swap_b32 %0, %1" : "+v"(a), "+v"(b)); return a + b; }
__device__ __forceinline__ float allsum4(const float (&p)[4], bool b0, bool b1) {
    const float m0 = b0 ? p[1] : p[0], g0 = b0 ? p[0] : p[1], m1 = b0 ? p[3] : p[2], g1 = b0 ? p[2] : p[3];
    const float q0 = m0 + dppf<0xB1>(g0), q1 = m1 + dppf<0xB1>(g1);
    const float mm = b1 ? q1 : q0, gg = b1 ? q0 : q1;
    float q = mm + dppf<0x4E>(gg);
    q += dppf<0x124>(q);
    q += dppf<0x128>(q);
    q = xsum16(q);
    q = xsum32(q);
    return q;
}
__device__ __forceinline__ float wave_allsum(float q) {
    q += dppf<0xB1>(q); q += dppf<0x4E>(q); q += dppf<0x124>(q); q += dppf<0x128>(q); q = xsum16(q); q = xsum32(q); return q;
}
constexpr int SC_YOFF = 16 * SC_SLOT;
struct ScanRaw { unsigned rc, kc, vc, rp, kp, vp, rn, kn, vn, wd, ad; };
__device__ __forceinline__ void rwkv_scan(Frame& F, const Args& AR, int bid) {
    const int seq = (bid & 7) + 8 * (bid >> 4), half = (bid >> 3) & 1;
    const int dir = seq >> 6, b = (seq >> 3) & 7, h = seq & 7, lane = F.lane, wave = F.wave, tid = F.tid;
    LAS float* ring = (LAS float*)F.lds;
    const int ch = h * 64 + lane, rbase = 32 * half + 4 * wave;
    const float* mu = AR.in[13];
    const float mu_r = mu[ch], mu_k = mu[512 + ch], mu_v = mu[1024 + ch];
    const float kk_c = AR.in[19][ch], ka_c = AR.in[20][ch], rk_c = AR.in[21][ch];
    const float w0_c = AR.in[14][dir * 512 + ch], a0_c = AR.in[16][dir * 512 + ch];
    const bf16* PRb = (const bf16*)(F.ws + WS_PR) + (size_t)b * SEQ * PR_P + ch;
    const bf16* Wd = (const bf16*)(F.ws + WS_LW) + (size_t)dir * ((size_t)M * 512) + (size_t)b * SEQ * 512 + ch;
    const bf16* Ad = (const bf16*)(F.ws + WS_LW) + (size_t)(2 + dir) * ((size_t)M * 512) + (size_t)b * SEQ * 512 + ch;
    bf16* YS = dir ? (bf16*)(F.ws + WS_TOP) : (bf16*)((unsigned char*)F.out + DO_YSF);
    YS += (size_t)b * SEQ * 512 + h * 64 + 32 * half;
    float* BON = (float*)(F.ws + WS_BONUS) + ((size_t)dir * M + (size_t)b * SEQ) * 8;
    float S[4];
#pragma unroll
    for (int i = 0; i < 4; ++i) S[i] = 0.f;
    const bool b0 = (lane & 1) != 0, b1 = (lane & 2) != 0;
    ScanRaw R;
#define SC_LOAD(jj) do { const int s_ = 8 * (jj) + wave, tau_ = dir ? SEQ - 1 - s_ : s_; const bf16* row_ = PRb + (size_t)tau_ * PR_P; \
        const int up_ = tau_ > 0 ? -PR_P : 0, dn_ = tau_ < SEQ - 1 ? PR_P : 0; \
        R.rc = row_[0]; R.kc = row_[512]; R.vc = row_[1024]; R.rp = row_[up_]; R.kp = row_[512 + up_]; R.vp = row_[1024 + up_]; \
        R.rn = row_[dn_]; R.kn = row_[512 + dn_]; R.vn = row_[1024 + dn_]; R.wd = Wd[(size_t)tau_ * 512]; R.ad = Ad[(size_t)tau_ * 512]; } while (0)
    SC_LOAD(0);
    __syncthreads();
#pragma unroll 1
    for (int j = 0; j < SEQ / 8; ++j) {
        {
            const int s = 8 * j + wave, tau = dir ? SEQ - 1 - s : s;
            const float rc = bf2f(R.rc), kc = bf2f(R.kc), vc = bf2f(R.vc);
            const float pm = tau > 0 ? 1.f : 0.f, nm = tau < SEQ - 1 ? 1.f : 0.f;
            const float rp = pm * bf2f(R.rp), kp = pm * bf2f(R.kp), vp = pm * bf2f(R.vp), rn = nm * bf2f(R.rn), kn = nm * bf2f(R.kn), vn = nm * bf2f(R.vn);
            const float rr = rc + mu_r * (0.5f * (rp + rn) - rc), kx = kc + mu_k * (0.5f * (kp + kn) - kc), vx = vc + mu_v * (0.5f * (vp + vn) - vc);
            const float wv = __expf(-0.60653065971f * sigmoidf_(w0_c + bf2f(R.wd))), av = sigmoidf_(a0_c + bf2f(R.ad));
            const float kkr = kx * kk_c; const float ss = wave_allsum(kkr * kkr); const float kk = kkr / fmaxf(sqrtf(ss), 1e-12f);
            const float kd = kx * (1.0f + (av - 1.0f) * ka_c), kka = kk * av;
            const float c2 = wave_allsum(rr * kd), c1 = wave_allsum(rr * kka);
            const float bon = wave_allsum(rr * kd * rk_c);
            LAS float* sl = ring + ((j & 1) * 8 + wave) * SC_SLOT;
            sl[lane] = -kk; sl[64 + lane] = wv; sl[128 + lane] = kka; sl[192 + lane] = kd; sl[256 + lane] = wv * rr; sl[320 + lane] = vx; sl[384 + lane] = vx * c2;
            if (lane == 0) sl[448] = c1;
            if (lane == 0 && half == 0) BON[(size_t)tau * 8 + h] = bon;
        }
        if (j + 1 < SEQ / 8) SC_LOAD(j + 1);
        __syncthreads();
        if (j > 0 && tid < 256) {
            const int u = tid >> 5, rrow = tid & 31, s = 8 * (j - 1) + u, tau = dir ? SEQ - 1 - s : s;
            YS[(size_t)tau * 512 + rrow] = (bf16)f2bf(ring[SC_YOFF + (((j - 1) & 1) * 8 + u) * 32 + rrow]);
        }
        {
            const LAS float* sl0 = ring + ((j & 1) * 8) * SC_SLOT;
            float nkk = sl0[lane], w = sl0[64 + lane], kka = sl0[128 + lane], kd = sl0[192 + lane], wr = sl0[256 + lane], vc2 = sl0[384 + rbase + (lane & 3)], c1 = sl0[448];
            f32x4 va = *(const LAS f32x4*)(sl0 + 320 + rbase);
#pragma unroll
            for (int u = 0; u < 8; ++u) {
                float nkk_n = 0.f, w_n = 0.f, kka_n = 0.f, kd_n = 0.f, wr_n = 0.f, vc2_n = 0.f, c1_n = 0.f; f32x4 va_n = {0.f, 0.f, 0.f, 0.f};
                if (u < 7) { const LAS float* sl = sl0 + (u + 1) * SC_SLOT;
                    nkk_n = sl[lane]; w_n = sl[64 + lane]; kka_n = sl[128 + lane]; kd_n = sl[192 + lane]; wr_n = sl[256 + lane]; vc2_n = sl[384 + rbase + (lane & 3)]; c1_n = sl[448];
                    va_n = *(const LAS f32x4*)(sl + 320 + rbase); }
                float p[4], pp[4];
#pragma unroll
                for (int i = 0; i < 4; ++i) { p[i] = S[i] * nkk; pp[i] = S[i] * wr; }
                const float q = allsum4(p, b0, b1);
                const float qy = allsum4(pp, b0, b1);
                const float sa[4] = {dppf<0x00>(q), dppf<0x55>(q), dppf<0xAA>(q), dppf<0xFF>(q)};
#pragma unroll
                for (int i = 0; i < 4; ++i) S[i] = S[i] * w + (sa[i] * kka + va[i] * kd);
                const float y = qy + (q * c1 + vc2);
                if (lane < 4) ring[SC_YOFF + ((j & 1) * 8 + u) * 32 + 4 * wave + lane] = y;
                nkk = nkk_n; w = w_n; kka = kka_n; kd = kd_n; wr = wr_n; vc2 = vc2_n; c1 = c1_n; va = va_n;
            }
        }
    }
    __syncthreads();
    if (tid < 256) { const int j = SEQ / 8; const int u = tid >> 5, rrow = tid & 31, s = 8 * (j - 1) + u, tau = dir ? SEQ - 1 - s : s;
        YS[(size_t)tau * 512 + rrow] = (bf16)f2bf(ring[SC_YOFF + (((j - 1) & 1) * 8 + u) * 32 + rrow]); }
#undef SC_LOAD
}

constexpr int S2_W = 0, S2_KKA = 64, S2_KD = 128, S2_VX = 192, S2_C = 256, S2_NKKB = 260, S2_WRB = 292, S2_ZB = 324, S2_SLOT = 368;
constexpr int S2_YOFF = 16 * S2_SLOT;
__device__ __forceinline__ void rwkv_scan2(Frame& F, const Args& AR, int seq) {
    const int dir = seq >> 6, b = (seq >> 3) & 7, h = seq & 7, lane = F.lane, wave = F.wave, tid = F.tid;
    LAS float* ring = (LAS float*)F.lds;
    bf16* YS = dir ? (bf16*)(F.ws + WS_TOP) : (bf16*)((unsigned char*)F.out + DO_YSF);
    YS += (size_t)b * SEQ * 512 + h * 64;
    __syncthreads();
    for (int i = tid; i < 16 * 32; i += 512) ring[(i >> 5) * S2_SLOT + S2_ZB + (i & 31)] = 0.f;
    constexpr int NBLK = SEQ / 8;
    if (wave >= 4) {
        const int p = wave - 4, ch = h * 64 + lane;
        const float* mu = AR.in[13];
        const float mu_r = mu[ch], mu_k = mu[512 + ch], mu_v = mu[1024 + ch];
        const float kk_c = AR.in[19][ch], ka_c = AR.in[20][ch], rk_c = AR.in[21][ch];
        const float w0_c = AR.in[14][dir * 512 + ch], a0_c = AR.in[16][dir * 512 + ch];
        const bf16* PRb = (const bf16*)(F.ws + WS_PR) + (size_t)b * SEQ * PR_P + ch;
        const bf16* Wd = (const bf16*)(F.ws + WS_LW) + (size_t)dir * ((size_t)M * 512) + (size_t)b * SEQ * 512 + ch;
        const bf16* Ad = (const bf16*)(F.ws + WS_LW) + (size_t)(2 + dir) * ((size_t)M * 512) + (size_t)b * SEQ * 512 + ch;
        float* BON = (float*)(F.ws + WS_BONUS) + ((size_t)dir * M + (size_t)b * SEQ) * 8;
        ScanRaw R[2];
#define S2_LOAD(jj) do { _Pragma("unroll") for (int e_ = 0; e_ < 2; ++e_) { const int s_ = 8 * (jj) + p + 4 * e_, tau_ = dir ? SEQ - 1 - s_ : s_; const bf16* row_ = PRb + (size_t)tau_ * PR_P; \
            const int up_ = tau_ > 0 ? -PR_P : 0, dn_ = tau_ < SEQ - 1 ? PR_P : 0; \
            R[e_].rc = row_[0]; R[e_].kc = row_[512]; R[e_].vc = row_[1024]; R[e_].rp = row_[up_]; R[e_].kp = row_[512 + up_]; R[e_].vp = row_[1024 + up_]; \
            R[e_].rn = row_[dn_]; R[e_].kn = row_[512 + dn_]; R[e_].vn = row_[1024 + dn_]; R[e_].wd = Wd[(size_t)tau_ * 512]; R[e_].ad = Ad[(size_t)tau_ * 512]; } } while (0)
#define S2_PRODUCE(jj) do { _Pragma("unroll") for (int e_ = 0; e_ < 2; ++e_) { const int u_ = p + 4 * e_, s_ = 8 * (jj) + u_, tau_ = dir ? SEQ - 1 - s_ : s_; \
            const float rc = bf2f(R[e_].rc), kc = bf2f(R[e_].kc), vc = bf2f(R[e_].vc); \
            const float pm = tau_ > 0 ? 1.f : 0.f, nm = tau_ < SEQ - 1 ? 1.f : 0.f; \
            const float rp = pm * bf2f(R[e_].rp), kp = pm * bf2f(R[e_].kp), vp = pm * bf2f(R[e_].vp), rn = nm * bf2f(R[e_].rn), kn = nm * bf2f(R[e_].kn), vn = nm * bf2f(R[e_].vn); \
            const float rr = rc + mu_r * (0.5f * (rp + rn) - rc), kx = kc + mu_k * (0.5f * (kp + kn) - kc), vx = vc + mu_v * (0.5f * (vp + vn) - vc); \
            const float wv = __expf(-0.60653065971f * sigmoidf_(w0_c + bf2f(R[e_].wd))), av = sigmoidf_(a0_c + bf2f(R[e_].ad)); \
            const float kkr = kx * kk_c; const float ss = wave_allsum(kkr * kkr); const float kk = kkr / fmaxf(sqrtf(ss), 1e-12f); \
            const float kd = kx * (1.0f + (av - 1.0f) * ka_c), kka = kk * av; \
            const float c2 = wave_allsum(rr * kd), c1 = wave_allsum(rr * kka), bon = wave_allsum(rr * kd * rk_c); \
            LAS float* sl = ring + (((jj) & 1) * 8 + u_) * S2_SLOT; \
            sl[S2_W + lane] = wv; sl[S2_KKA + lane] = kka; sl[S2_KD + lane] = kd; sl[S2_VX + lane] = vx; \
            ((LAS bf16*)(sl + S2_NKKB))[lane] = (bf16)f2bf(-kk); ((LAS bf16*)(sl + S2_WRB))[lane] = (bf16)f2bf(wv * rr); \
            if (lane == 0) { sl[S2_C] = c1; sl[S2_C + 1] = c2; BON[(size_t)tau_ * 8 + h] = bon; } } } while (0)
        S2_LOAD(0); S2_PRODUCE(0); S2_LOAD(1);
        __syncthreads();
#pragma unroll 1
        for (int j = 0; j < NBLK; ++j) {
            if (j + 1 < NBLK) { S2_PRODUCE(j + 1); if (j + 2 < NBLK) S2_LOAD(j + 2); }
            if (j > 0) {
                const int pt = tid - 256;
#pragma unroll
                for (int e = 0; e < 2; ++e) { const int idx = pt + 256 * e, u = idx >> 6, rrow = idx & 63, s = 8 * (j - 1) + u, tau = dir ? SEQ - 1 - s : s;
                    YS[(size_t)tau * 512 + rrow] = (bf16)f2bf(ring[S2_YOFF + (((j - 1) & 1) * 8 + u) * 64 + rrow]); }
            }
            __syncthreads();
        }
        { const int j = NBLK; const int pt = tid - 256;
#pragma unroll
          for (int e = 0; e < 2; ++e) { const int idx = pt + 256 * e, u = idx >> 6, rrow = idx & 63, s = 8 * (j - 1) + u, tau = dir ? SEQ - 1 - s : s;
              YS[(size_t)tau * 512 + rrow] = (bf16)f2bf(ring[S2_YOFF + (((j - 1) & 1) * 8 + u) * 64 + rrow]); } }
#undef S2_LOAD
#undef S2_PRODUCE
    } else {
        const int c = lane & 15, g = lane >> 4, row = 16 * wave + c;
        const int aoff = (((c & 3) == 0) ? S2_NKKB : ((c & 3) == 1) ? S2_WRB : S2_ZB) * 4 + (((c & 3) < 2) ? 16 * g : 0);
        const int aoff1 = aoff + (((c & 3) < 2) ? 64 : 0);
        float S[16];
#pragma unroll
        for (int i = 0; i < 16; ++i) S[i] = 0.f;
        __syncthreads();
#pragma unroll 1
        for (int j = 0; j < NBLK; ++j) {
            const LAS float* sl0 = ring + ((j & 1) * 8) * S2_SLOT;
            f32x4 w4[4], ka4[4], kd4[4]; bf16x8 A0, A1; float vv, c1, c2;
#define S2_CLOAD(sl) do { const LAS float* sl_ = (sl); \
            w4[0] = *(const LAS f32x4*)(sl_ + S2_W + 8 * g); w4[1] = *(const LAS f32x4*)(sl_ + S2_W + 8 * g + 4); w4[2] = *(const LAS f32x4*)(sl_ + S2_W + 32 + 8 * g); w4[3] = *(const LAS f32x4*)(sl_ + S2_W + 36 + 8 * g); \
            ka4[0] = *(const LAS f32x4*)(sl_ + S2_KKA + 8 * g); ka4[1] = *(const LAS f32x4*)(sl_ + S2_KKA + 8 * g + 4); ka4[2] = *(const LAS f32x4*)(sl_ + S2_KKA + 32 + 8 * g); ka4[3] = *(const LAS f32x4*)(sl_ + S2_KKA + 36 + 8 * g); \
            kd4[0] = *(const LAS f32x4*)(sl_ + S2_KD + 8 * g); kd4[1] = *(const LAS f32x4*)(sl_ + S2_KD + 8 * g + 4); kd4[2] = *(const LAS f32x4*)(sl_ + S2_KD + 32 + 8 * g); kd4[3] = *(const LAS f32x4*)(sl_ + S2_KD + 36 + 8 * g); \
            A0 = *(const LAS bf16x8*)((const LAS unsigned char*)sl_ + aoff); A1 = *(const LAS bf16x8*)((const LAS unsigned char*)sl_ + aoff1); \
            vv = sl_[S2_VX + row]; c1 = sl_[S2_C]; c2 = sl_[S2_C + 1]; } while (0)
            S2_CLOAD(sl0);
#pragma unroll
            for (int u = 0; u < 8; ++u) {
                const f32x4 cw0 = w4[0], cw1 = w4[1], cw2 = w4[2], cw3 = w4[3], ca0 = ka4[0], ca1 = ka4[1], ca2 = ka4[2], ca3 = ka4[3], cd0 = kd4[0], cd1 = kd4[1], cd2 = kd4[2], cd3 = kd4[3];
                const bf16x8 cA0 = A0, cA1 = A1; const float cvv = vv, cc1 = c1, cc2 = c2;
                if (u < 7) S2_CLOAD(sl0 + (u + 1) * S2_SLOT);
                v4u b0v, b1v;
                b0v.x = cvt_pk_bf16(S[0], S[1]); b0v.y = cvt_pk_bf16(S[2], S[3]); b0v.z = cvt_pk_bf16(S[4], S[5]); b0v.w = cvt_pk_bf16(S[6], S[7]);
                b1v.x = cvt_pk_bf16(S[8], S[9]); b1v.y = cvt_pk_bf16(S[10], S[11]); b1v.z = cvt_pk_bf16(S[12], S[13]); b1v.w = cvt_pk_bf16(S[14], S[15]);
                f32x4 acc = {0.f, 0.f, 0.f, 0.f};
                acc = __builtin_amdgcn_mfma_f32_16x16x32_bf16(cA0, __builtin_bit_cast(bf16x8, b0v), acc, 0, 0, 0);
                acc = __builtin_amdgcn_mfma_f32_16x16x32_bf16(cA1, __builtin_bit_cast(bf16x8, b1v), acc, 0, 0, 0);
                const float sa = acc[0], yp = acc[1];
#pragma unroll
                for (int i = 0; i < 4; ++i) {
                    S[i] = S[i] * cw0[i] + (sa * ca0[i] + cvv * cd0[i]); S[4 + i] = S[4 + i] * cw1[i] + (sa * ca1[i] + cvv * cd1[i]);
                    S[8 + i] = S[8 + i] * cw2[i] + (sa * ca2[i] + cvv * cd2[i]); S[12 + i] = S[12 + i] * cw3[i] + (sa * ca3[i] + cvv * cd3[i]);
                }
                const float y = yp + (sa * cc1 + cvv * cc2);
                if (g == 0) ring[S2_YOFF + ((j & 1) * 8 + u) * 64 + row] = y;
            }
            __syncthreads();
        }
#undef S2_CLOAD
    }
    __syncthreads();
}

__device__ __forceinline__ void p4_mixers(Frame& F, const Args& AR, bool do_scan, bool do_hy, bool dry) {
    if (F.bid < 128) { if (do_scan) rwkv_scan2(F, AR, F.bid); }
    else if (do_hy) { for (int c = F.bid - 128; c < 512; c += F.G - 128) hyena_item(F, AR, c, dry); }
}

__device__ __forceinline__ void p5_combine(Frame& F, const Args& AR, bool dry) {
    unsigned char* ws = F.ws; const int lane = F.lane, tid = F.tid;
    { const int gw = F.bid * NWAVES + F.wave, NGW = F.G * NWAVES;
      bf16* YSF = (bf16*)((unsigned char*)F.out + DO_YSF); const bf16* YSB = (const bf16*)(ws + WS_TOP);
      const bf16* PR = (const bf16*)(ws + WS_PR); const bf16* Gt = (const bf16*)(ws + WS_LW) + (size_t)4 * ((size_t)M * 512);
      const float* BON = (const float*)(ws + WS_BONUS); const float* mu = AR.in[13]; const float* gnw = AR.in[22]; const float* gnb = AR.in[23];
      for (int it = gw; it < M * NHEAD; it += NGW) {
          const int m = it >> 3, h = it & 7, ch = h * 64 + lane, t = m & (SEQ - 1);
          const float y = bf2f(YSF[(size_t)m * 512 + ch]) + bf2f(YSB[(size_t)m * 512 + ch]);
          const float mean = wave_sum(y) * (1.0f / 64.0f); const float d = y - mean; const float var = wave_sum(d * d) * (1.0f / 64.0f);
          const float yn = d * rsqrtf(var + GN_EPS) * gnw[ch] + gnb[ch];
          const bf16* p = PR + (size_t)m * PR_P + 1024 + ch;
          const float vc = bf2f(p[0]); float vp = 0.f, vn = 0.f;
          if (t > 0) vp = bf2f(p[-PR_P]);
          if (t < SEQ - 1) vn = bf2f(p[PR_P]);
          const float vx = vc + mu[1024 + ch] * (0.5f * (vp + vn) - vc);
          const float bon = BON[(size_t)m * 8 + h] + BON[((size_t)M + m) * 8 + h];
          const float res = (yn + bon * vx) * bf2f(Gt[(size_t)m * 512 + ch]);
          if (!dry) YSF[(size_t)m * 512 + ch] = (bf16)f2bf(res);
      } }
    { const bf16* ZHT = (const bf16*)((unsigned char*)F.out + DO_HT); bf16* ZH = (bf16*)(ws + WS_ZH);
      LAS bf16* tile = (LAS bf16*)F.lds;
      for (int it = F.bid; it < 8 * NB * 64; it += F.G) {
          const int tb = it & 63, b = (it >> 6) & 7, cbk = it >> 9; const int t0 = tb * 64, c0 = cbk * 64;
          __syncthreads();
          { const int cl = tid >> 3, chk = tid & 7; const v4u v = *(const v4u*)(ZHT + ((size_t)(c0 + cl) * NB + b) * SEQ + t0 + 8 * chk);
            *(LAS v4u*)(tile + cl * 72 + 8 * chk) = v; }
          __syncthreads();
          { const int tl = tid >> 3, chk = tid & 7; unsigned e[8];
#pragma unroll
            for (int i = 0; i < 8; ++i) e[i] = tile[(8 * chk + i) * 72 + tl];
            v4u w; w.x = e[0] | (e[1] << 16); w.y = e[2] | (e[3] << 16); w.z = e[4] | (e[5] << 16); w.w = e[6] | (e[7] << 16);
            *(v4u*)(ZH + ((size_t)b * SEQ + t0 + tl) * 512 + c0 + 8 * chk) = w; }
      }
      __syncthreads();
    }
}

__device__ __forceinline__ void ln1_pass(Frame& F, const Args& AR) {
    const int gw = F.bid * NWAVES + F.wave, NGW = F.G * NWAVES, lane = F.lane;
    const float* H1 = (const float*)(F.ws + WS_H1); float* ST = (float*)(F.ws + WS_STATS); bf16* X1B = (bf16*)(F.ws + WS_X1B);
    const f32x4* w4 = (const f32x4*)AR.in[27]; const f32x4* b4 = (const f32x4*)AR.in[28];
    for (int m = gw; m < M; m += NGW) {
        const f32x4* xr = (const f32x4*)(H1 + (size_t)m * DM) + lane;
        f32x4 v[4]; float s = 0.f;
#pragma unroll
        for (int j = 0; j < 4; ++j) { v[j] = xr[64 * j]; s += (v[j].x + v[j].y) + (v[j].z + v[j].w); }
        const float mean = wave_sum(s) * (1.f / DM); float s2 = 0.f;
#pragma unroll
        for (int j = 0; j < 4; ++j) { v[j] = v[j] - mean; s2 += (v[j].x * v[j].x + v[j].y * v[j].y) + (v[j].z * v[j].z + v[j].w * v[j].w); }
        const float rstd = 1.f / sqrtf(wave_sum(s2) * (1.f / DM) + LN_EPS);
        if (lane == 0) { ST[2 * m] = mean; ST[2 * m + 1] = rstd; }
        v2u* o8 = (v2u*)(X1B + (size_t)m * DM) + lane;
#pragma unroll
        for (int j = 0; j < 4; ++j) { const f32x4 y = v[j] * rstd * w4[64 * j + lane] + b4[64 * j + lane]; v2u o; o.x = pk2(y.x, y.y); o.y = pk2(y.z, y.w); o8[64 * j] = o; }
    }
}
__device__ __forceinline__ void ln2_pass(Frame& F, const Args& AR, bool dry) {
    const int gw = F.bid * NWAVES + F.wave, NGW = F.G * NWAVES, lane = F.lane;
    const f32x4* w4 = (const f32x4*)AR.in[32]; const f32x4* b4 = (const f32x4*)AR.in[33];
    for (int m = gw; m < M; m += NGW) {
        f32x4* xr = (f32x4*)(F.out + (size_t)m * DM) + lane;
        f32x4 v[4]; float s = 0.f;
#pragma unroll
        for (int j = 0; j < 4; ++j) { v[j] = xr[64 * j]; s += (v[j].x + v[j].y) + (v[j].z + v[j].w); }
        const float mean = wave_sum(s) * (1.f / DM); float s2 = 0.f;
#pragma unroll
        for (int j = 0; j < 4; ++j) { v[j] = v[j] - mean; s2 += (v[j].x * v[j].x + v[j].y * v[j].y) + (v[j].z * v[j].z + v[j].w * v[j].w); }
        const float rstd = 1.f / sqrtf(wave_sum(s2) * (1.f / DM) + LN_EPS);
#pragma unroll
        for (int j = 0; j < 4; ++j) { const f32x4 y = v[j] * rstd * w4[64 * j + lane] + b4[64 * j + lane]; if (!dry) xr[64 * j] = y; }
    }
}

constexpr int LDS_BYTES = 147456;
constexpr int N_PHASES = 13;
#ifndef PROBE_DUP
#define PROBE_DUP -1
#endif
#ifndef PROBE_SUB
#define PROBE_SUB 0
#endif

__global__ void __launch_bounds__(512, 2) hybrid_fwd(Args args) {
    extern __shared__ __attribute__((aligned(16))) unsigned char lds_raw[];
    cg::grid_group grid = cg::this_grid();
    Frame F;
    F.lds = (LAS unsigned char*)lds_raw;
    F.tid = threadIdx.x; F.lane = F.tid & 63; F.wave = __builtin_amdgcn_readfirstlane(F.tid >> 6);
    F.G = gridDim.x; F.bid = blockIdx.x;
    F.out = args.out; F.ws = args.ws;
    unsigned char* ws = args.ws;
    const int lo = args.ph_lo, hi = args.ph_hi;
#define IN(k) (lo <= (k) && (k) < hi)
#define SEAM(k) do { if (IN(k) && IN((k) + 1)) grid.sync(); } while (0)
    using pg8::Gemm; using pg8::StaticOrder; using pg8::gemm_phase;

#define REP(k) for (int rep = 0; rep < ((PROBE_DUP == (k)) ? 2 : 1); ++rep, ((PROBE_DUP == (k)) ? grid.sync() : (void)0))
    if (IN(0)) REP(0) { p0_prologue(F, args); } SEAM(0);
    if (IN(1)) REP(1) {
        Gemm g{(const bf16*)(ws + WS_XB), (const bf16*)(ws + WS_WIN), M, NP, DM}; StaticOrder S; S.init(M, NP, F.G, F.bid);
        EpiProj E{(bf16*)(ws + WS_PH), (bf16*)(ws + WS_PR), (bf16*)(ws + WS_PG)};
        gemm_phase<EpiProj, StaticOrder, true, true>(F.lds, g, S, E);
    } SEAM(1);
    if (IN(2)) REP(2) { p2_prep(F, args); } SEAM(2);
    if (IN(3)) REP(3) {
        Gemm g{(const bf16*)(ws + WS_TOP), (const bf16*)(ws + WS_WLORA), M, LORA_N, LORA_K}; StaticOrder S; S.init(M, LORA_N, F.G, F.bid);
        EpiLora E{(bf16*)(ws + WS_LW)};
        gemm_phase<EpiLora, StaticOrder, true, true>(F.lds, g, S, E);
    } SEAM(3);
    if (IN(4)) REP(4) { const bool first = (PROBE_DUP == 4) && rep == 0; p4_mixers(F, args, !first || PROBE_SUB != 2, !first || PROBE_SUB != 1, first); } SEAM(4);
    if (IN(5)) REP(5) { p5_combine(F, args, (PROBE_DUP == 5) && rep == 0); } SEAM(5);
    if (IN(6)) REP(6) {
        Gemm g{(const bf16*)(ws + WS_ZH), (const bf16*)(ws + WS_WHY), M, DM, 512}; StaticOrder S; S.init(M, DM, F.G, F.bid);
        EpiGate<0> E{(const bf16*)(ws + WS_PG), (bf16*)(ws + WS_T), nullptr};
        gemm_phase<EpiGate<0>, StaticOrder, true, true>(F.lds, g, S, E);
    } SEAM(6);
    if (IN(7)) REP(7) {
        Gemm g{(const bf16*)((unsigned char*)F.out + DO_YSF), (const bf16*)(ws + WS_WRW), M, DM, 512}; StaticOrder S; S.init(M, DM, F.G, F.bid);
        EpiGate<1> E{(const bf16*)(ws + WS_PG), (bf16*)(ws + WS_T), (bf16*)(ws + WS_MIXIN)};
        gemm_phase<EpiGate<1>, StaticOrder, true, true>(F.lds, g, S, E);
    } SEAM(7);
    if (IN(8)) REP(8) {
        Gemm g{(const bf16*)(ws + WS_MIXIN), (const bf16*)(ws + WS_WO), M, DM, DM}; StaticOrder S; S.init(M, DM, F.G, F.bid);
        EpiWo E{args.in[0], (float*)(ws + WS_H1)};
        gemm_phase<EpiWo, StaticOrder, true, true>(F.lds, g, S, E);
    } SEAM(8);
    if (IN(9)) REP(9) { ln1_pass(F, args); } SEAM(9);
    if (IN(10)) REP(10) {
        Gemm g{(const bf16*)(ws + WS_X1B), (const bf16*)(ws + WS_WGU), M, NGU, DM}; StaticOrder S; S.init(M, NGU, F.G, F.bid);
        EpiSwiGLU E{(bf16*)(ws + WS_HID)};
        gemm_phase<EpiSwiGLU, StaticOrder, true, true>(F.lds, g, S, E);
    } SEAM(10);
    if (IN(11)) REP(11) {
        Gemm g{(const bf16*)(ws + WS_HID), (const bf16*)(ws + WS_WD), M, DM, FFH}; StaticOrder S; S.init(M, DM, F.G, F.bid);
        EpiDown E{(const float*)(ws + WS_H1), (const float*)(ws + WS_STATS), args.in[27], args.in[28], F.out};
        gemm_phase<EpiDown, StaticOrder, true, true>(F.lds, g, S, E);
    } SEAM(11);
    if (IN(12)) REP(12) { ln2_pass(F, args, (PROBE_DUP == 12) && rep == 0); }
#undef IN
#undef SEAM
}

extern "C" void kernel_launch(void* const* d_in, const int* in_sizes, int n_in, void* d_out, int out_size, void* d_ws, size_t ws_size, hipStream_t stream) {
    static int grid = 0;
    if (grid == 0) {
        if (n_in != 34 || out_size != M * DM || ws_size < WS_NEED) { fprintf(stderr, "kernel_launch: unexpected shapes (n_in %d out %d ws %zu)\n", n_in, out_size, ws_size); grid = -1; return; }
        int dev = 0, cus = 0, per_cu = 0;
        if (hipGetDevice(&dev) != hipSuccess || hipDeviceGetAttribute(&cus, hipDeviceAttributeMultiprocessorCount, dev) != hipSuccess) { grid = -1; return; }
        if (hipFuncSetAttribute((const void*)hybrid_fwd, hipFuncAttributeMaxDynamicSharedMemorySize, LDS_BYTES) != hipSuccess) { fprintf(stderr, "kernel_launch: hipFuncSetAttribute failed\n"); grid = -1; return; }
        if (hipOccupancyMaxActiveBlocksPerMultiprocessor(&per_cu, (const void*)hybrid_fwd, 512, LDS_BYTES) != hipSuccess || per_cu < 1) { fprintf(stderr, "kernel_launch: occupancy query says %d\n", per_cu); per_cu = 1; }
        (void)hipGetLastError();
        grid = cus;
        if (grid != 256) fprintf(stderr, "kernel_launch: %d CUs (built for 256)\n", grid);
    }
    if (grid < 0) return;
    Args a{};
    for (int i = 0; i < 34; ++i) a.in[i] = (const float*)d_in[i];
    a.out = (float*)d_out; a.ws = (unsigned char*)d_ws; a.ph_lo = 0; a.ph_hi = N_PHASES;
    void* kargs[] = {&a};
    hipError_t e = hipLaunchCooperativeKernel((void*)hybrid_fwd, dim3(grid), dim3(512), kargs, LDS_BYTES, stream);
    if (e != hipSuccess) fprintf(stderr, "kernel_launch: cooperative launch failed: %s\n", hipGetErrorString(e));
}
```

```cpp
#include <hip/hip_runtime.h>
#include <hip/hip_cooperative_groups.h>
#include <cstdio>
#include <cstdint>
namespace cg = cooperative_groups;
namespace pg8 {
#define PG8_LAS __attribute__((address_space(3)))
typedef unsigned short bf16_t;
typedef short bf16x8 __attribute__((ext_vector_type(8)));
typedef float f32x4 __attribute__((ext_vector_type(4)));
typedef unsigned u32x4 __attribute__((ext_vector_type(4)));
constexpr int BM = 256, BK = 64, HALF = 128, HTB = HALF * BK * 2  , STAGE_BYTES = 8 * HTB, NXCD = 8, WGM = 8;

__host__ __device__ __forceinline__ int lds_byte(int r, int c) { const int st = (r >> 4) * 2 + (c >> 5), rr = r & 15, cc = c & 31, ob = rr * 64 + cc * 2; return st * 1024 + (ob ^ (((ob >> 9) & 1) << 5)); }
__host__ __device__ __forceinline__ void stage_rc(int b, int& R, int& C) { const int st = b / 1024, sb = b % 1024, swz = sb ^ (((sb >> 9) & 1) << 5); R = (st >> 1) * 16 + swz / 64; C = (st & 1) * 32 + (swz % 64) / 2; }
__host__ __device__ __forceinline__ int perm32(int rho) { const int n = rho >> 4, i = rho & 15; return 8 * (i >> 2) + 4 * n + (i & 3); }

struct Unit { int pm, pn; };
struct Gemm { const bf16_t* A; const bf16_t* Bt; int M, N, K; };

struct StaticOrder {
    int nM, nN, nwg, G, c;
    __host__ __device__ void init(int M, int N, int G_, int c_) { nM = M / BM; nN = N / BM; nwg = nM * nN; G = G_; c = c_; }
    __host__ __device__ bool next(int i, Unit& u) const {
        const long L = (long)i * G + c; if (L >= nwg) return false;
        int wgid = (int)L; { const int q = nwg / NXCD, r = nwg % NXCD, xcd = wgid % NXCD, off = wgid / NXCD; wgid = (xcd < r ? xcd * (q + 1) : r * (q + 1) + (xcd - r) * q) + off; }
        const int nig = WGM * nN, gid = wgid / nig, fm = gid * WGM, gsz = (nM - fm) < WGM ? (nM - fm) : WGM;
        u.pm = fm + ((wgid % nig) % gsz); u.pn = (wgid % nig) / gsz; return true;
    }
    __device__ __forceinline__ void a_ready(const Unit&) const {}
    __device__ __forceinline__ void done(const Unit&) const {}
};

__device__ __forceinline__ unsigned cvt_pk_bf16(float lo, float hi) { unsigned r; asm volatile("v_cvt_pk_bf16_f32 %0, %1, %2" : "=v"(r) : "v"(lo), "v"(hi)); return r; }
typedef float f32x2 __attribute__((ext_vector_type(2)));
template <class Epi, class Sched, bool ALIGN_EPI = false, bool SP2 = false>
__device__ __forceinline__ void gemm_phase(PG8_LAS unsigned char* lds, const Gemm g, const Sched& S, const Epi& E) {
    const int tid = threadIdx.x, wid = __builtin_amdgcn_readfirstlane(tid >> 6), lane = tid & 63, wr = wid >> 2, wc = wid & 3, fr = lane & 15, fq = lane >> 4;
    const int K = g.K, nt = K / BK;
    unsigned voffA[2], voffB[2];
#pragma unroll
    for (int i = 0; i < 2; ++i) { int R, C; stage_rc(tid * 16 + i * 8192, R, C); const int Rb = Epi::PERM ? ((R & ~31) + perm32(R & 31)) : R;
        voffA[i] = (unsigned)(R * K + C) * 2u; voffB[i] = (unsigned)(Rb * K + C) * 2u; }
    const size_t kstep = (size_t)(BK * 2);
    const size_t hstep = (size_t)HALF * K * 2;
    const size_t tstep = 2 * hstep;
    const unsigned ldsw = (unsigned)wid * 1024u;
    const int aoff = lds_byte(wr * 64 + fr, fq * 8), boff = lds_byte(wc * 32 + fr, fq * 8);
#define PG8_SA(b, h) (((b) * 2 + (h)) * HTB)
#define PG8_SB(b, h) ((4 + (b) * 2 + (h)) * HTB)
#define PG8_STAGE(bufoff, gbase, voff) do { _Pragma("unroll") for (int _i = 0; _i < 2; ++_i) \
        __builtin_amdgcn_global_load_lds((const unsigned*)((const char*)(gbase) + (voff)[_i]), (PG8_LAS unsigned*)(lds + (bufoff) + ldsw + _i * 8192), 16, 0, 0); } while (0)
#define PG8_LDA(dst, b, h) do { _Pragma("unroll") for (int m = 0; m < 4; ++m) _Pragma("unroll") for (int k = 0; k < 2; ++k) dst[m][k] = *(const PG8_LAS bf16x8*)(lds + PG8_SA(b, h) + aoff + m * 2048 + k * 1024); } while (0)
#define PG8_LDB(dst, b, h) do { _Pragma("unroll") for (int n = 0; n < 2; ++n) _Pragma("unroll") for (int k = 0; k < 2; ++k) dst[n][k] = *(const PG8_LAS bf16x8*)(lds + PG8_SB(b, h) + boff + n * 2048 + k * 1024); } while (0)
#define PG8_MMA(ai, bj, At, Bt) do { __builtin_amdgcn_s_setprio(1); _Pragma("unroll") for (int m = 0; m < 4; ++m) _Pragma("unroll") for (int n = 0; n < 2; ++n) _Pragma("unroll") for (int k = 0; k < 2; ++k) \
        acc[ai][bj][m][n] = __builtin_amdgcn_mfma_f32_16x16x32_bf16(Bt[n][k], At[m][k], acc[ai][bj][m][n], 0, 0, 0); __builtin_amdgcn_s_setprio(0); } while (0)
#define PG8_WAIT_V(n) asm volatile("s_waitcnt vmcnt(" #n ")" ::: "memory")
#define PG8_WAIT_L(n) asm volatile("s_waitcnt lgkmcnt(" #n ")" ::: "memory")
#define PG8_BAR __builtin_amdgcn_s_barrier()
#define PG8_SCHED __builtin_amdgcn_sched_barrier(0)
    Unit cur, nxt; int ui = 0;
    if (!S.next(0, cur)) return;
    f32x4 acc[2][2][4][2];
#pragma unroll
    for (int a = 0; a < 2; ++a)
#pragma unroll
        for (int b = 0; b < 2; ++b)
#pragma unroll
            for (int m = 0; m < 4; ++m)
#pragma unroll
                for (int n = 0; n < 2; ++n) acc[a][b][m][n] = (f32x4){0.f, 0.f, 0.f, 0.f};
    bf16x8 At[4][2], B0[2][2], B1[2][2];
    const char* cA = (const char*)g.A + (size_t)cur.pm * tstep; const char* cB = (const char*)g.Bt + (size_t)cur.pn * tstep;
    S.a_ready(cur);
    if constexpr (SP2) {
        PG8_STAGE(PG8_SB(0, 0), cB, voffB); PG8_STAGE(PG8_SB(0, 1), cB + hstep, voffB); PG8_STAGE(PG8_SA(0, 0), cA, voffA); PG8_STAGE(PG8_SA(0, 1), cA + hstep, voffA);
        if (wr == 1) PG8_BAR;
        PG8_WAIT_V(2); PG8_BAR;
        PG8_STAGE(PG8_SB(1, 0), cB + kstep, voffB); PG8_STAGE(PG8_SA(1, 0), cA + kstep, voffA); PG8_STAGE(PG8_SB(1, 1), cB + hstep + kstep, voffB);
        PG8_WAIT_V(6); PG8_BAR;
    } else {
        PG8_STAGE(PG8_SB(0, 0), cB, voffB); PG8_STAGE(PG8_SA(0, 0), cA, voffA); PG8_STAGE(PG8_SB(0, 1), cB + hstep, voffB); PG8_STAGE(PG8_SA(0, 1), cA + hstep, voffA);
        if (wr == 1) PG8_BAR;
        PG8_WAIT_V(4); PG8_BAR;
        PG8_STAGE(PG8_SB(1, 0), cB + kstep, voffB); PG8_STAGE(PG8_SA(1, 0), cA + kstep, voffA); PG8_STAGE(PG8_SB(1, 1), cB + hstep + kstep, voffB);
        PG8_WAIT_V(6); PG8_BAR;
    }
    for (;;) {
        const bool has_next = S.next(ui + 1, nxt);
        const char* nA = has_next ? (const char*)g.A + (size_t)nxt.pm * tstep : cA; const char* nB = has_next ? (const char*)g.Bt + (size_t)nxt.pn * tstep : cB;
#pragma unroll 1
        for (int t = 0; t < nt; t += 2) {
            const bool last = (t == nt - 2);
            const char* a1 = cA + (size_t)(t + 1) * kstep;
            const char* a2 = last ? nA : cA + (size_t)(t + 2) * kstep; const char* b2 = last ? nB : cB + (size_t)(t + 2) * kstep;
            const char* a3 = a2 + kstep; const char* b3 = b2 + kstep;
            if (last && has_next) S.a_ready(nxt);
            if constexpr (SP2) {
            PG8_LDB(B0, 0, 0); PG8_LDB(B1, 0, 1); PG8_SCHED; PG8_LDA(At, 0, 0); PG8_STAGE(PG8_SA(1, 1), a1 + hstep, voffA);
            PG8_WAIT_V(8); PG8_WAIT_L(0); PG8_BAR; PG8_MMA(0, 0, At, B0); PG8_MMA(0, 1, At, B1); PG8_BAR; PG8_SCHED;
            PG8_LDA(At, 0, 1); PG8_STAGE(PG8_SB(0, 0), b2, voffB); PG8_STAGE(PG8_SB(0, 1), b2 + hstep, voffB); PG8_STAGE(PG8_SA(0, 0), a2, voffA);
            PG8_WAIT_V(8); PG8_WAIT_L(0); PG8_BAR; PG8_MMA(1, 0, At, B0); PG8_MMA(1, 1, At, B1); PG8_BAR; PG8_SCHED;
            PG8_LDB(B0, 1, 0); PG8_LDB(B1, 1, 1); PG8_SCHED; PG8_LDA(At, 1, 0); PG8_STAGE(PG8_SA(0, 1), a2 + hstep, voffA);
            PG8_WAIT_V(8); PG8_WAIT_L(0); PG8_BAR; PG8_MMA(0, 0, At, B0); PG8_MMA(0, 1, At, B1); PG8_BAR; PG8_SCHED;
            PG8_LDA(At, 1, 1); PG8_STAGE(PG8_SB(1, 0), b3, voffB); PG8_STAGE(PG8_SB(1, 1), b3 + hstep, voffB); PG8_STAGE(PG8_SA(1, 0), a3, voffA);
            PG8_WAIT_V(8); PG8_WAIT_L(0); PG8_BAR; PG8_MMA(1, 0, At, B0); PG8_MMA(1, 1, At, B1); PG8_BAR; PG8_SCHED;
            } else {
            PG8_LDB(B0, 0, 0); PG8_SCHED; PG8_LDA(At, 0, 0); PG8_STAGE(PG8_SA(1, 1), a1 + hstep, voffA);
            PG8_WAIT_L(8); PG8_BAR; PG8_WAIT_L(0); PG8_MMA(0, 0, At, B0); PG8_BAR; PG8_SCHED;
            PG8_LDB(B1, 0, 1); PG8_STAGE(PG8_SB(0, 0), b2, voffB);
            PG8_BAR; PG8_WAIT_L(0); PG8_MMA(0, 1, At, B1); PG8_BAR;
            PG8_LDA(At, 0, 1); PG8_STAGE(PG8_SA(0, 0), a2, voffA);
            PG8_BAR; PG8_WAIT_L(0); PG8_MMA(1, 0, At, B0); PG8_BAR; PG8_SCHED;
            PG8_STAGE(PG8_SB(0, 1), b2 + hstep, voffB);
            PG8_WAIT_V(6); PG8_BAR; PG8_MMA(1, 1, At, B1); PG8_BAR;
            PG8_LDB(B0, 1, 0); PG8_SCHED; PG8_LDA(At, 1, 0); PG8_STAGE(PG8_SA(0, 1), a2 + hstep, voffA);
            PG8_WAIT_L(8); PG8_BAR; PG8_WAIT_L(0); PG8_MMA(0, 0, At, B0); PG8_BAR; PG8_SCHED;
            PG8_LDB(B1, 1, 1); PG8_STAGE(PG8_SB(1, 0), b3, voffB);
            PG8_BAR; PG8_WAIT_L(0); PG8_MMA(0, 1, At, B1); PG8_BAR;
            PG8_LDA(At, 1, 1); PG8_STAGE(PG8_SA(1, 0), a3, voffA);
            PG8_BAR; PG8_WAIT_L(0); PG8_MMA(1, 0, At, B0); PG8_BAR; PG8_SCHED;
            PG8_STAGE(PG8_SB(1, 1), b3 + hstep, voffB);
            PG8_WAIT_V(6); PG8_BAR; PG8_MMA(1, 1, At, B1); PG8_BAR;
            }
        }
        if constexpr (ALIGN_EPI) { if (wr == 0) PG8_BAR; }
        if constexpr (!Epi::AFTER_DRAIN) { E(acc, cur, wr, wc, fr, fq); S.done(cur); }
        if (!has_next) break;
#pragma unroll
        for (int a = 0; a < 2; ++a)
#pragma unroll
            for (int b = 0; b < 2; ++b)
#pragma unroll
                for (int m = 0; m < 4; ++m)
#pragma unroll
                    for (int n = 0; n < 2; ++n) acc[a][b][m][n] = (f32x4){0.f, 0.f, 0.f, 0.f};
        cur = nxt; cA = nA; cB = nB; ++ui;
        if constexpr (ALIGN_EPI) { if (wr == 1) PG8_BAR; }
    }
    PG8_WAIT_V(0);
    if constexpr (!ALIGN_EPI) { if (wr == 0) PG8_BAR; }
    PG8_BAR;
    if constexpr (Epi::AFTER_DRAIN) { E.fused(acc, cur, wr, wc, fr, fq, lds, wid, lane); S.done(cur); }
#undef PG8_SA
#undef PG8_SB
#undef PG8_STAGE
#undef PG8_LDA
#undef PG8_LDB
#undef PG8_MMA
#undef PG8_WAIT_V
#undef PG8_WAIT_L
#undef PG8_BAR
#undef PG8_SCHED
}
}

constexpr int NB = 8, SEQ = 4096, DM = 1024, M = NB * SEQ;
constexpr int NHEAD = 8;
constexpr int PH_P = 1536, PR_P = 1920, PG_P = 2048;
constexpr int NP = 5632;
constexpr int FFH = 2816, NGU = 5632;
constexpr int LORA_K = 384, LORA_N = 2560;
constexpr float DN_ALPHA = 1.18920711500272f;
constexpr float LN_EPS = 1e-5f, GN_EPS = 64e-5f;
constexpr float HY_MIN_DECAY = -3.07011346f, HY_MAX_DECAY = -15.3505673f;
constexpr int NWAVES = 8;

constexpr size_t MiB = 1u << 20;
constexpr size_t WS_H3T = 1 * MiB;
constexpr size_t WS_STATS = 2 * MiB;
constexpr size_t WS_BONUS = 3 * MiB;
constexpr size_t WS_WIN = 5 * MiB, WS_WGU = 16 * MiB, WS_WD = 27 * MiB, WS_WO = 33 * MiB, WS_WHY = 35 * MiB, WS_WRW = 36 * MiB, WS_WLORA = 37 * MiB;
constexpr size_t WS_FT = 39 * MiB;
constexpr size_t WS_XB = 71 * MiB;
constexpr size_t WS_LW = 71 * MiB;
constexpr size_t WS_PH = 135 * MiB, WS_PR = 231 * MiB, WS_PG = 351 * MiB;
constexpr size_t WS_TOP = 479 * MiB;
constexpr size_t WS_ZH = 71 * MiB, WS_T = 103 * MiB, WS_MIXIN = 167 * MiB;
constexpr size_t WS_H1 = 351 * MiB, WS_X1B = 71 * MiB, WS_HID = 135 * MiB;
constexpr size_t WS_NEED = 511 * MiB;
constexpr size_t DO_HT = 0, DO_YSF = 96 * MiB;

#define GAS __attribute__((address_space(1)))
#define LAS __attribute__((address_space(3)))
typedef unsigned short bf16;
typedef unsigned v4u __attribute__((ext_vector_type(4)));
typedef unsigned v2u __attribute__((ext_vector_type(2)));
typedef float f32x4 __attribute__((ext_vector_type(4)));
typedef float f32x16 __attribute__((ext_vector_type(16)));
typedef short bf16x8 __attribute__((ext_vector_type(8)));

__device__ __forceinline__ float bf2f(unsigned b) { return __uint_as_float(b << 16); }
__device__ __forceinline__ float bflo(unsigned w) { return __uint_as_float(w << 16); }
__device__ __forceinline__ float bfhi(unsigned w) { return __uint_as_float(w & 0xffff0000u); }
__device__ __forceinline__ unsigned f2bf(float f) { unsigned u = __float_as_uint(f); return (u + 0x7fffu + ((u >> 16) & 1u)) >> 16; }
__device__ __forceinline__ unsigned pk2(float lo, float hi) { return f2bf(lo) | (f2bf(hi) << 16); }
__device__ __forceinline__ float sigmoidf_(float x) { return 1.0f / (1.0f + __expf(-x)); }
__device__ __forceinline__ float fsig(float x) { return __builtin_amdgcn_rcpf(1.0f + __expf(-x)); }
__device__ __forceinline__ float wave_sum(float v) {
#pragma unroll
    for (int o = 1; o < 64; o <<= 1) v += __shfl_xor(v, o);
    return v;
}

struct Frame {
    LAS unsigned char* lds;
    int tid, lane, wave, G, bid;
    float* out; unsigned char* ws;
};
struct Args { const float* in[34]; float* out; unsigned char* ws; int ph_lo, ph_hi; };

using pg8::Unit; using pg8::cvt_pk_bf16; constexpr int HALF = 128, BM = 256;

__device__ __forceinline__ v4u pack8(f32x4 v0, f32x4 v1) { v4u w; w.x = cvt_pk_bf16(v0[0], v0[1]); w.y = cvt_pk_bf16(v0[2], v0[3]); w.z = cvt_pk_bf16(v1[0], v1[1]); w.w = cvt_pk_bf16(v1[2], v1[3]); return w; }

struct EpiProj {
    static constexpr bool PERM = true, AFTER_DRAIN = false;
    bf16 *PH, *PR, *PG;
    __device__ __forceinline__ void operator()(const f32x4 (&acc)[2][2][4][2], const Unit& u, int wr, int wc, int fr, int fq) const {
        const int row0 = u.pm * BM + wr * 64 + fr;
#pragma unroll
        for (int bj = 0; bj < 2; ++bj) {
            const int hb = 2 * u.pn + bj; bf16* base; int pitch, col;
            if (hb < 12) { base = PH; pitch = PH_P; col = 128 * hb; }
            else if (hb < 27) { base = PR; pitch = PR_P; col = 128 * (hb - 12); }
            else if (hb < 43) { base = PG; pitch = PG_P; col = 128 * (hb - 27); }
            else continue;
            col += wc * 32 + 8 * fq;
#pragma unroll
            for (int ai = 0; ai < 2; ++ai)
#pragma unroll
                for (int m = 0; m < 4; ++m)
                    *(v4u*)(base + (size_t)(row0 + ai * HALF + m * 16) * pitch + col) = pack8(acc[ai][bj][m][0], acc[ai][bj][m][1]);
        }
    }
};

struct EpiLora {
    static constexpr bool PERM = true, AFTER_DRAIN = false;
    bf16* LW;
    __device__ __forceinline__ void operator()(const f32x4 (&acc)[2][2][4][2], const Unit& u, int wr, int wc, int fr, int fq) const {
        const int row0 = u.pm * BM + wr * 64 + fr;
        bf16* base = LW + (size_t)(u.pn >> 1) * ((size_t)M * 512) + (u.pn & 1) * 256 + wc * 32 + 8 * fq;
#pragma unroll
        for (int ai = 0; ai < 2; ++ai)
#pragma unroll
            for (int m = 0; m < 4; ++m) { bf16* rowp = base + (size_t)(row0 + ai * HALF + m * 16) * 512;
#pragma unroll
                for (int bj = 0; bj < 2; ++bj) *(v4u*)(rowp + bj * HALF) = pack8(acc[ai][bj][m][0], acc[ai][bj][m][1]); }
    }
};

template <int STAGE> struct EpiGate {
    static constexpr bool PERM = true, AFTER_DRAIN = false;
    const bf16* PG; bf16* T; bf16* O;
    __device__ __forceinline__ void operator()(const f32x4 (&acc)[2][2][4][2], const Unit& u, int wr, int wc, int fr, int fq) const {
        const int row0 = u.pm * BM + wr * 64 + fr;
#pragma unroll
        for (int bj = 0; bj < 2; ++bj) {
            const int col = u.pn * BM + bj * HALF + wc * 32 + 8 * fq;
#pragma unroll
            for (int ai = 0; ai < 2; ++ai)
#pragma unroll
                for (int m = 0; m < 4; ++m) {
                    const size_t row = (size_t)(row0 + ai * HALF + m * 16);
                    const v4u g = *(const v4u*)(PG + row * PG_P + STAGE * 1024 + col);
                    f32x4 v0 = acc[ai][bj][m][0], v1 = acc[ai][bj][m][1];
                    v0[0] *= sigmoidf_(bflo(g.x)); v0[1] *= sigmoidf_(bfhi(g.x)); v0[2] *= sigmoidf_(bflo(g.y)); v0[3] *= sigmoidf_(bfhi(g.y));
                    v1[0] *= sigmoidf_(bflo(g.z)); v1[1] *= sigmoidf_(bfhi(g.z)); v1[2] *= sigmoidf_(bflo(g.w)); v1[3] *= sigmoidf_(bfhi(g.w));
                    if (STAGE == 1) {
                        const v4u t = *(const v4u*)(T + row * 1024 + col);
                        v0[0] += bflo(t.x); v0[1] += bfhi(t.x); v0[2] += bflo(t.y); v0[3] += bfhi(t.y);
                        v1[0] += bflo(t.z); v1[1] += bfhi(t.z); v1[2] += bflo(t.w); v1[3] += bfhi(t.w);
                        *(v4u*)(O + row * 1024 + col) = pack8(v0, v1);
                    } else {
                        *(v4u*)(T + row * 1024 + col) = pack8(v0, v1);
                    }
                }
        }
    }
};

struct EpiWo {
    static constexpr bool PERM = false, AFTER_DRAIN = false;
    const float* X; float* H1;
    __device__ __forceinline__ void operator()(const f32x4 (&acc)[2][2][4][2], const Unit& u, int wr, int wc, int fr, int fq) const {
        const int row0 = u.pm * BM + wr * 64 + fr, col0 = u.pn * BM + wc * 32 + 4 * fq;
#pragma unroll
        for (int ai = 0; ai < 2; ++ai)
#pragma unroll
            for (int m = 0; m < 4; ++m) {
                const size_t off = (size_t)(row0 + ai * HALF + m * 16) * DM + col0;
#pragma unroll
                for (int bj = 0; bj < 2; ++bj)
#pragma unroll
                    for (int n = 0; n < 2; ++n) {
                        const f32x4 xv = *(const f32x4*)(X + off + bj * HALF + n * 16);
                        *(f32x4*)(H1 + off + bj * HALF + n * 16) = xv * DN_ALPHA + acc[ai][bj][m][n];
                    }
            }
    }
};

struct EpiSwiGLU {
    static constexpr bool PERM = true, AFTER_DRAIN = false;
    bf16* HID;
    __device__ __forceinline__ void operator()(const f32x4 (&acc)[2][2][4][2], const Unit& u, int wr, int wc, int fr, int fq) const {
        const int row0 = u.pm * BM + wr * 64 + fr, col = u.pn * HALF + wc * 32 + 8 * fq;
#pragma unroll
        for (int ai = 0; ai < 2; ++ai)
#pragma unroll
            for (int m = 0; m < 4; ++m) {
                f32x4 g0 = acc[ai][0][m][0], g1 = acc[ai][0][m][1]; const f32x4 u0 = acc[ai][1][m][0], u1 = acc[ai][1][m][1];
#pragma unroll
                for (int j = 0; j < 4; ++j) { g0[j] = g0[j] * sigmoidf_(g0[j]) * u0[j]; g1[j] = g1[j] * sigmoidf_(g1[j]) * u1[j]; }
                *(v4u*)(HID + (size_t)(row0 + ai * HALF + m * 16) * FFH + col) = pack8(g0, g1);
            }
    }
};

struct EpiDown {
    static constexpr bool PERM = false, AFTER_DRAIN = false;
    const float* H1; const float* STATS; const float* lnw; const float* lnb; float* O;
    __device__ __forceinline__ void operator()(const f32x4 (&acc)[2][2][4][2], const Unit& u, int wr, int wc, int fr, int fq) const {
        const int row0 = u.pm * BM + wr * 64 + fr, col0 = u.pn * BM + wc * 32 + 4 * fq;
#pragma unroll
        for (int ai = 0; ai < 2; ++ai)
#pragma unroll
            for (int m = 0; m < 4; ++m) {
                const int row = row0 + ai * HALF + m * 16; const size_t off = (size_t)row * DM + col0;
                const float mean = STATS[2 * row], rstd = STATS[2 * row + 1];
#pragma unroll
                for (int bj = 0; bj < 2; ++bj)
#pragma unroll
                    for (int n = 0; n < 2; ++n) {
                        const f32x4 hv = *(const f32x4*)(H1 + off + bj * HALF + n * 16);
                        const f32x4 wv = *(const f32x4*)(lnw + col0 + bj * HALF + n * 16), bv = *(const f32x4*)(lnb + col0 + bj * HALF + n * 16);
                        const f32x4 x1 = (hv - mean) * rstd * wv + bv;
                        *(f32x4*)(O + off + bj * HALF + n * 16) = x1 * DN_ALPHA + acc[ai][bj][m][n];
                    }
            }
    }
};

__device__ __forceinline__ void p0_transpose_item(const float* W, int K, int N, bf16* WT, int dst_row0, int k0, int n0, LAS float* scr, int lane) {
#pragma unroll 8
    for (int i = 0; i < 32; ++i) { const int kk = 2 * i + (lane >> 5); scr[kk * 33 + (lane & 31)] = W[(size_t)(k0 + kk) * N + n0 + (lane & 31)]; }
    asm volatile("s_waitcnt lgkmcnt(0)" ::: "memory");
    const int c = lane & 7;
#pragma unroll
    for (int j = 0; j < 4; ++j) { const int n = (lane >> 3) + 8 * j; const LAS float* s = scr + (8 * c) * 33 + n;
        v4u o; o.x = pk2(s[0 * 33], s[1 * 33]); o.y = pk2(s[2 * 33], s[3 * 33]); o.z = pk2(s[4 * 33], s[5 * 33]); o.w = pk2(s[6 * 33], s[7 * 33]);
        *(v4u*)(WT + (size_t)(dst_row0 + n) * K + k0 + 8 * c) = o; }
    asm volatile("s_waitcnt lgkmcnt(0)" ::: "memory");
}

__device__ __forceinline__ void p0_prologue(Frame& F, const Args& AR) {
    LAS float* scr = (LAS float*)(F.lds + F.wave * 16384);
    const int gw = F.bid * NWAVES + F.wave, NGW = F.G * NWAVES, lane = F.lane;
    unsigned char* ws = F.ws;
    constexpr int I_IN = (1024 / 64) * (5504 / 32), I_GU = (1024 / 64) * (2816 / 32), I_D = (2816 / 64) * (1024 / 32), I_O = 16 * 32, I_HY = 8 * 32;
    constexpr int NITEMS = I_IN + 2 * I_GU + I_D + I_O + 2 * I_HY;
    for (int it = gw; it < NITEMS; it += NGW) {
        int r = it;
        if (r < I_IN) { const int nblk = 5504 / 32, kb = r / nblk, nb = r % nblk; p0_transpose_item(AR.in[1], 1024, 5504, (bf16*)(ws + WS_WIN), 32 * nb, 64 * kb, 32 * nb, scr, lane); continue; } r -= I_IN;
        if (r < 2 * I_GU) { const int up = r >= I_GU; if (up) r -= I_GU; const int nblk = 2816 / 32, kb = r / nblk, nb = r % nblk, n0 = 32 * nb;
            p0_transpose_item(AR.in[up ? 30 : 29], 1024, 2816, (bf16*)(ws + WS_WGU), (n0 >> 7) * 256 + (n0 & 127) + (up ? 128 : 0), 64 * kb, n0, scr, lane); continue; } r -= 2 * I_GU;
        if (r < I_D) { const int nblk = 32, kb = r / nblk, nb = r % nblk; p0_transpose_item(AR.in[31], 2816, 1024, (bf16*)(ws + WS_WD), 32 * nb, 64 * kb, 32 * nb, scr, lane); continue; } r -= I_D;
        if (r < I_O) { const int kb = r / 32, nb = r % 32; p0_transpose_item(AR.in[26], 1024, 1024, (bf16*)(ws + WS_WO), 32 * nb, 64 * kb, 32 * nb, scr, lane); continue; } r -= I_O;
        if (r < I_HY) { const int kb = r / 32, nb = r % 32; p0_transpose_item(AR.in[24], 512, 1024, (bf16*)(ws + WS_WHY), 32 * nb, 64 * kb, 32 * nb, scr, lane); continue; } r -= I_HY;
        { const int kb = r / 32, nb = r % 32; p0_transpose_item(AR.in[25], 512, 1024, (bf16*)(ws + WS_WRW), 32 * nb, 64 * kb, 32 * nb, scr, lane); }
    }
    const size_t gt = (size_t)F.bid * 512 + F.tid, NT = (size_t)F.G * 512;
    { v4u z = {0u, 0u, 0u, 0u}; v4u* p = (v4u*)((bf16*)(ws + WS_WIN) + (size_t)5504 * 1024); for (size_t i = gt; i < (size_t)128 * 1024 / 8; i += NT) p[i] = z; }
    { bf16* WL = (bf16*)(ws + WS_WLORA);
      for (size_t i = gt; i < (size_t)LORA_N * LORA_K; i += NT) {
          const int n = (int)(i / LORA_K), k = (int)(i % LORA_K), blk = n >> 9, c = n & 511; float v = 0.f;
          if (blk < 2) { if ((k >> 6) == blk) v = AR.in[15][((size_t)blk * 64 + (k & 63)) * 512 + c]; }
          else if (blk < 4) { if ((k >> 6) == blk) v = AR.in[17][((size_t)(blk - 2) * 64 + (k & 63)) * 512 + c]; }
          else { if (k >= 256) v = AR.in[18][(size_t)(k - 256) * 512 + c]; }
          WL[i] = (bf16)f2bf(v);
      } }
    { const f32x4* x4 = (const f32x4*)AR.in[0]; v4u* xb = (v4u*)(ws + WS_XB);
      for (size_t i = gt; i < (size_t)M * DM / 8; i += NT) { const f32x4 a = x4[2 * i], b = x4[2 * i + 1]; xb[i] = pack8(a, b); } }
    { float* H3T = (float*)(ws + WS_H3T);
      const float* fw1 = AR.in[4]; const float* fb1 = AR.in[5]; const float* fw2 = AR.in[6]; const float* fb2 = AR.in[7]; const float* fw3 = AR.in[8]; const float* fb3 = AR.in[9]; const float* sf = AR.in[11];
      for (int pos = gw; pos < SEQ; pos += NGW) {
          const float t = (float)pos / 4095.0f, wv = 6.283185307179586f * (float)pos / 4096.0f;
          float feat = 0.f;
          if (lane == 0) feat = t;
          else if (lane <= 32) { const int j = (lane - 1) & 15; const float f = 1e-4f + (float)j * ((15.0f - 1e-4f) / 15.0f); const float ang = wv * f; feat = (lane <= 16) ? cosf(ang) : -sinf(ang); }
          float z = fb1[lane];
#pragma unroll
          for (int f = 0; f < 33; ++f) z += __shfl(feat, f) * fw1[f * 64 + lane];
          float h = sinf(sf[lane] * z);
          z = fb2[lane];
#pragma unroll 8
          for (int j = 0; j < 64; ++j) z += __shfl(h, j) * fw2[j * 64 + lane];
          h = sinf(sf[64 + lane] * z);
          z = fb3[lane];
#pragma unroll 8
          for (int j = 0; j < 64; ++j) z += __shfl(h, j) * fw3[j * 64 + lane];
          h = sinf(sf[128 + lane] * z);
          H3T[lane * SEQ + pos] = h;
      } }
}

__device__ __forceinline__ void p2_prep(Frame& F, const Args& AR) {
    unsigned char* ws = F.ws; const int tid = F.tid, lane = F.lane;
    const int gw = F.bid * NWAVES + F.wave, NGW = F.G * NWAVES;
    { const bf16* PH = (const bf16*)(ws + WS_PH); bf16* HT = (bf16*)((unsigned char*)F.out + DO_HT);
      const float* cw = AR.in[2]; const float* cb = AR.in[3];
      LAS bf16* raw = (LAS bf16*)(F.lds + F.wave * 9216);
      constexpr int NIT = NB * (SEQ / 64) * (PH_P / 64);
      const int lr = lane >> 3, lc = lane & 7;
      for (int it = gw; it < NIT; it += NGW) {
          const int cbk = it % 24, tb = (it / 24) % 64, b = it / (24 * 64); const int t0 = tb * 64, c0 = cbk * 64;
          const bf16* src = PH + ((size_t)b * SEQ + t0) * PH_P + c0 + 8 * lc;
          v4u v[9];
#pragma unroll
          for (int i = 0; i < 8; ++i) v[i] = *(const v4u*)(src + (size_t)(lr + 8 * i) * PH_P);
          { const int hrow = (lane < 8) ? -1 : 64; const int t = t0 + hrow; v[8] = (v4u){0u, 0u, 0u, 0u};
            if (lane < 16 && t >= 0 && t < SEQ) v[8] = *(const v4u*)(src + (ptrdiff_t)hrow * PH_P); }
#pragma unroll
          for (int i = 0; i < 8; ++i) { LAS unsigned* d = (LAS unsigned*)(raw + (1 + lr + 8 * i) * 66 + 8 * lc); d[0] = v[i].x; d[1] = v[i].y; d[2] = v[i].z; d[3] = v[i].w; }
          if (lane < 16) { LAS unsigned* d = (LAS unsigned*)(raw + ((lane < 8) ? 0 : 65) * 66 + 8 * lc); d[0] = v[8].x; d[1] = v[8].y; d[2] = v[8].z; d[3] = v[8].w; }
          asm volatile("s_waitcnt lgkmcnt(0)" ::: "memory");
          const int col = c0 + lane;
          const float w0 = cw[col], w1 = cw[PH_P + col], w2 = cw[2 * PH_P + col], bb = cb[col];
          const int which = col >> 9, c = col & 511;
          v4u* dst = (v4u*)(HT + (((size_t)which * 512 + c) * NB + b) * SEQ + t0);
          float pv = bf2f(raw[lane]), cv = bf2f(raw[66 + lane]);
#pragma unroll
          for (int q8 = 0; q8 < 8; ++q8) {
              float o[8];
#pragma unroll
              for (int i = 0; i < 8; ++i) { const float nv = bf2f(raw[(8 * q8 + i + 2) * 66 + lane]); o[i] = w0 * pv + w1 * cv + w2 * nv + bb; pv = cv; cv = nv; }
              v4u w; w.x = pk2(o[0], o[1]); w.y = pk2(o[2], o[3]); w.z = pk2(o[4], o[5]); w.w = pk2(o[6], o[7]);
              dst[q8] = w;
          }
          asm volatile("s_waitcnt lgkmcnt(0)" ::: "memory");
      }
    }
    const size_t gt = (size_t)F.bid * 512 + tid, NT = (size_t)F.G * 512;
    { const bf16* PR = (const bf16*)(ws + WS_PR); bf16* LIN = (bf16*)(ws + WS_TOP); const float* mu = AR.in[13];
      for (size_t i = gt; i < (size_t)M * 96; i += NT) {
          const int m = (int)(i / 96), cg4 = (int)(i % 96), t = m & (SEQ - 1); const int col = 1536 + 4 * cg4;
          const bf16* p = PR + (size_t)m * PR_P + col;
          const v2u c = *(const v2u*)p; v2u pv = {0u, 0u}, nv = {0u, 0u};
          if (t > 0) pv = *(const v2u*)(p - PR_P);
          if (t < SEQ - 1) nv = *(const v2u*)(p + PR_P);
          const f32x4 muv = *(const f32x4*)(mu + col);
          float u[4], pr[4], nx[4];
          u[0] = bflo(c.x); u[1] = bfhi(c.x); u[2] = bflo(c.y); u[3] = bfhi(c.y);
          pr[0] = bflo(pv.x); pr[1] = bfhi(pv.x); pr[2] = bflo(pv.y); pr[3] = bfhi(pv.y);
          nx[0] = bflo(nv.x); nx[1] = bfhi(nv.x); nx[2] = bflo(nv.y); nx[3] = bfhi(nv.y);
#pragma unroll
          for (int j = 0; j < 4; ++j) { float sft = u[j] + muv[j] * (0.5f * (pr[j] + nx[j]) - u[j]);
              if (cg4 < 32) sft = 2.0f * fsig(2.0f * sft) - 1.0f; else if (cg4 >= 64) sft = fsig(sft); u[j] = sft; }
          v2u o; o.x = pk2(u[0], u[1]); o.y = pk2(u[2], u[3]);
          *(v2u*)(LIN + (size_t)m * LORA_K + 4 * cg4) = o;
      } }
    { const float* H3T = (const float*)(ws + WS_H3T); const float* fw4 = AR.in[10]; const float* skip = AR.in[12];
      bf16* FT = (bf16*)(ws + WS_FT);
      for (int it = gw; it < 64 * 128; it += NGW) {
          const int pb = it & 63, cb8 = it >> 6; const int o = cb8 >> 6, c0 = (cb8 & 63) * 8;
          const int pos = pb * 64 + lane;
          float hf[8], hb[8];
#pragma unroll
          for (int e = 0; e < 8; ++e) { hf[e] = 0.f; hb[e] = 0.f; }
          const float* wrow = fw4 + o * 1024 + c0;
#pragma unroll 4
          for (int j = 0; j < 64; ++j) {
              const float hv = H3T[j * SEQ + pos];
              const f32x4 a0 = *(const f32x4*)(wrow + (size_t)j * 2048), a1 = *(const f32x4*)(wrow + (size_t)j * 2048 + 4);
              const f32x4 b0 = *(const f32x4*)(wrow + (size_t)j * 2048 + 512), b1 = *(const f32x4*)(wrow + (size_t)j * 2048 + 516);
#pragma unroll
              for (int e = 0; e < 4; ++e) { hf[e] += hv * a0[e]; hf[4 + e] += hv * a1[e]; hb[e] += hv * b0[e]; hb[4 + e] += hv * b1[e]; }
          }
          const float tpos = (float)pos / 4095.0f;
#pragma unroll
          for (int e = 0; e < 8; ++e) {
              const int c = c0 + e;
              const float delta = fabsf(HY_MIN_DECAY + (float)c * ((HY_MAX_DECAY - HY_MIN_DECAY) / 511.0f));
              bf16* TE = FT + (size_t)(o * 512 + c) * 16384; bf16* TO = TE + 8192;
              const float win = expf(-tpos * delta);
              if (pos == 0) { const bf16 v = (bf16)f2bf(hf[e] + hb[e] + skip[o * 512 + c]); TE[2 * 2048] = v; TO[2 * 2048 + 1] = v; TE[0] = 0; TE[1] = 0; TO[1] = 0; }
              else {
                  const bf16 vf = (bf16)f2bf(hf[e] * win), vb = (bf16)f2bf(hb[e] * win);
                  { const int d = pos, n = d >> 1;
                    if (d & 1) { TO[2 * (n + 2048)] = vf; if (n + 1 + 2048 < 4096) TE[2 * (n + 1 + 2048) + 1] = vf; }
                    else { TE[2 * (n + 2048)] = vf; TO[2 * (n + 2048) + 1] = vf; } }
                  { const int d = -pos, n = d >> 1;
                    if (d & 1) { TO[2 * (n + 2048)] = vb; TE[2 * (n + 1 + 2048) + 1] = vb; }
                    else { TE[2 * (n + 2048)] = vb; TO[2 * (n + 2048) + 1] = vb; } }
              }
          }
      } }
}

constexpr int HL_TE = 0, HL_TO = 16384 + 64, HL_Z = 32896, HZ_ROW = 80, HZ_PAD = 24;

__device__ __forceinline__ void hyena_item(Frame& F, const Args& AR, int c, bool dry) {
    LAS unsigned char* lds = F.lds; const int tid = F.tid, lane = F.lane, wave = F.wave;
    bf16* HT = (bf16*)((unsigned char*)F.out + DO_HT);
    const bf16* FT = (const bf16*)(F.ws + WS_FT);
    const int r = lane & 31, h = lane >> 5, par = r & 1;
    __syncthreads();
    if (tid < 240) { const int rr = tid / 5, ch = tid % 5; const int row = rr < 24 ? rr : 1024 + rr; v4u z = {0u, 0u, 0u, 0u}; *(LAS v4u*)(lds + HL_Z + row * HZ_ROW + 16 * ch) = z; }
    { const v4u* src = (const v4u*)(HT + ((size_t)0 * 512 + c) * NB * SEQ);
#pragma unroll
      for (int it = 0; it < 8; ++it) { const int rem = tid; const v4u v = src[it * 512 + rem];
          *(LAS v4u*)(lds + HL_Z + (((rem >> 2) * 8 + it) + HZ_PAD) * HZ_ROW + (rem & 3) * 16) = v; } }
#pragma unroll 1
    for (int o = 0; o < 2; ++o) {
        { const v4u* src = (const v4u*)(FT + ((size_t)o * 512 + c) * 16384);
#pragma unroll
          for (int it = 0; it < 4; ++it) { const int e = it * 512 + tid; const v4u v = src[e]; *(LAS v4u*)(lds + (e < 1024 ? HL_TE + e * 16 : HL_TO + (e - 1024) * 16)) = v; } }
        __syncthreads();
        f32x16 acc[4];
#pragma unroll
        for (int nn = 0; nn < 4; ++nn)
#pragma unroll
            for (int j = 0; j < 16; ++j) acc[nn][j] = 0.f;
        const LAS unsigned* T = (const LAS unsigned*)(lds + (par ? HL_TO : HL_TE));
        const int nb0 = 4 * wave;
#pragma unroll 1
        for (int q = 16 * wave - 127; q <= 16 * wave + 15; ++q) {
#pragma unroll
            for (int jh = 0; jh < 2; ++jh) {
                const int base = 32 * q + r - 16 * jh - 8 * h;
                const int n0 = ((base - par) >> 1) + 2048;
                v4u av; av.x = T[n0]; av.y = T[n0 - 1]; av.z = T[n0 - 2]; av.w = T[n0 - 3];
                const bf16x8 A = __builtin_bit_cast(bf16x8, av);
#pragma unroll
                for (int nn = 0; nn < 4; ++nn) {
                    const int n = nb0 + nn;
                    if (q >= 4 * n - 127 && q <= 4 * n + 3) {
                        const int row = 32 * n + r - 8 * q + HZ_PAD;
                        const bf16x8 Bf = *(const LAS bf16x8*)(lds + HL_Z + row * HZ_ROW + 32 * jh + 16 * h);
                        acc[nn] = __builtin_amdgcn_mfma_f32_32x32x16_bf16(A, Bf, acc[nn], 0, 0, 0);
                    }
                }
            }
        }
        __syncthreads();
        const bf16* XG = HT + ((size_t)(1 + o) * 512 + c) * NB * SEQ;
#pragma unroll
        for (int nn = 0; nn < 4; ++nn) {
            const int colg = 32 * (nb0 + nn) + r, tb = colg >> 3, b = colg & 7;
#pragma unroll
            for (int g = 0; g < 4; ++g) {
                const int i0 = 8 * g + 4 * h;
                const v2u xv = *(const v2u*)(XG + (size_t)b * SEQ + 32 * tb + i0);
                v2u w; w.x = pk2(acc[nn][4 * g + 0] * bflo(xv.x), acc[nn][4 * g + 1] * bfhi(xv.x)); w.y = pk2(acc[nn][4 * g + 2] * bflo(xv.y), acc[nn][4 * g + 3] * bfhi(xv.y));
                *(LAS v2u*)(lds + HL_Z + (colg + HZ_PAD) * HZ_ROW + i0 * 2) = w;
            }
        }
        __syncthreads();
    }
    if (!dry) { v4u* dst = (v4u*)(HT + ((size_t)0 * 512 + c) * NB * SEQ);
#pragma unroll
      for (int it = 0; it < 8; ++it) { const int rem = tid; dst[it * 512 + rem] = *(const LAS v4u*)(lds + HL_Z + (((rem >> 2) * 8 + it) + HZ_PAD) * HZ_ROW + (rem & 3) * 16); } }
}

constexpr int SC_SLOT = 464;
template <int CTRL> __device__ __forceinline__ float dppf(float x) { return __builtin_bit_cast(float, __builtin_amdgcn_update_dpp(0, __builtin_bit_cast(int, x), CTRL, 0xf, 0xf, true)); }
__device__ __forceinline__ float xsum16(float x) { float a = x, b = x; asm volatile("s_nop 1\n\tv_permlane16_swap_b32 %0, %1" : "+v"(a), "+v"(b)); return a + b; }
__device__ __forceinline__ float xsum32(float x) { float a = x, b = x; asm volatile("s_nop 1\n\tv_permlane32_swap_b32 %0, %1" : "+v"(a), "+v"(b)); return a + b; }
__device__ __forceinline__ float allsum4(const float (&p)[4], bool b0, bool b1) {
    const float m0 = b0 ? p[1] : p[0], g0 = b0 ? p[0] : p[1], m1 = b0 ? p[3] : p[2], g1 = b0 ? p[2] : p[3];
    const float q0 = m0 + dppf<0xB1>(g0), q1 = m1 + dppf<0xB1>(g1);
    const float mm = b1 ? q1 : q0, gg = b1 ? q0 : q1;
    float q = mm + dppf<0x4E>(gg);
    q += dppf<0x124>(q);
    q += dppf<0x128>(q);
    q = xsum16(q);
    q = xsum32(q);
    return q;
}
__device__ __forceinline__ float wave_allsum(float q) {
    q += dppf<0xB1>(q); q += dppf<0x4E>(q); q += dppf<0x124>(q); q += dppf<0x128>(q); q = xsum16(q); q = xsum32(q); return q;
}
constexpr int SC_YOFF = 16 * SC_SLOT;
struct ScanRaw { unsigned rc, kc, vc, rp, kp, vp, rn, kn, vn, wd, ad; };
__device__ __forceinline__ void rwkv_scan(Frame& F, const Args& AR, int bid) {
    const int seq = (bid & 7) + 8 * (bid >> 4), half = (bid >> 3) & 1;
    const int dir = seq >> 6, b = (seq >> 3) & 7, h = seq & 7, lane = F.lane, wave = F.wave, tid = F.tid;
    LAS float* ring = (LAS float*)F.lds;
    const int ch = h * 64 + lane, rbase = 32 * half + 4 * wave;
    const float* mu = AR.in[13];
    const float mu_r = mu[ch], mu_k = mu[512 + ch], mu_v = mu[1024 + ch];
    const float kk_c = AR.in[19][ch], ka_c = AR.in[20][ch], rk_c = AR.in[21][ch];
    const float w0_c = AR.in[14][dir * 512 + ch], a0_c = AR.in[16][dir * 512 + ch];
    const bf16* PRb = (const bf16*)(F.ws + WS_PR) + (size_t)b * SEQ * PR_P + ch;
    const bf16* Wd = (const bf16*)(F.ws + WS_LW) + (size_t)dir * ((size_t)M * 512) + (size_t)b * SEQ * 512 + ch;
    const bf16* Ad = (const bf16*)(F.ws + WS_LW) + (size_t)(2 + dir) * ((size_t)M * 512) + (size_t)b * SEQ * 512 + ch;
    bf16* YS = dir ? (bf16*)(F.ws + WS_TOP) : (bf16*)((unsigned char*)F.out + DO_YSF);
    YS += (size_t)b * SEQ * 512 + h * 64 + 32 * half;
    float* BON = (float*)(F.ws + WS_BONUS) + ((size_t)dir * M + (size_t)b * SEQ) * 8;
    float S[4];
#pragma unroll
    for (int i = 0; i < 4; ++i) S[i] = 0.f;
    const bool b0 = (lane & 1) != 0, b1 = (lane & 2) != 0;
    ScanRaw R;
#define SC_LOAD(jj) do { const int s_ = 8 * (jj) + wave, tau_ = dir ? SEQ - 1 - s_ : s_; const bf16* row_ = PRb + (size_t)tau_ * PR_P; \
        const int up_ = tau_ > 0 ? -PR_P : 0, dn_ = tau_ < SEQ - 1 ? PR_P : 0; \
        R.rc = row_[0]; R.kc = row_[512]; R.vc = row_[1024]; R.rp = row_[up_]; R.kp = row_[512 + up_]; R.vp = row_[1024 + up_]; \
        R.rn = row_[dn_]; R.kn = row_[512 + dn_]; R.vn = row_[1024 + dn_]; R.wd = Wd[(size_t)tau_ * 512]; R.ad = Ad[(size_t)tau_ * 512]; } while (0)
    SC_LOAD(0);
    __syncthreads();
#pragma unroll 1
    for (int j = 0; j < SEQ / 8; ++j) {
        {
            const int s = 8 * j + wave, tau = dir ? SEQ - 1 - s : s;
            const float rc = bf2f(R.rc), kc = bf2f(R.kc), vc = bf2f(R.vc);
            const float pm = tau > 0 ? 1.f : 0.f, nm = tau < SEQ - 1 ? 1.f : 0.f;
            const float rp = pm * bf2f(R.rp), kp = pm * bf2f(R.kp), vp = pm * bf2f(R.vp), rn = nm * bf2f(R.rn), kn = nm * bf2f(R.kn), vn = nm * bf2f(R.vn);
            const float rr = rc + mu_r * (0.5f * (rp + rn) - rc), kx = kc + mu_k * (0.5f * (kp + kn) - kc), vx = vc + mu_v * (0.5f * (vp + vn) - vc);
            const float wv = __expf(-0.60653065971f * sigmoidf_(w0_c + bf2f(R.wd))), av = sigmoidf_(a0_c + bf2f(R.ad));
            const float kkr = kx * kk_c; const float ss = wave_allsum(kkr * kkr); const float kk = kkr / fmaxf(sqrtf(ss), 1e-12f);
            const float kd = kx * (1.0f + (av - 1.0f) * ka_c), kka = kk * av;
            const float c2 = wave_allsum(rr * kd), c1 = wave_allsum(rr * kka);
            const float bon = wave_allsum(rr * kd * rk_c);
            LAS float* sl = ring + ((j & 1) * 8 + wave) * SC_SLOT;
            sl[lane] = -kk; sl[64 + lane] = wv; sl[128 + lane] = kka; sl[192 + lane] = kd; sl[256 + lane] = wv * rr; sl[320 + lane] = vx; sl[384 + lane] = vx * c2;
            if (lane == 0) sl[448] = c1;
            if (lane == 0 && half == 0) BON[(size_t)tau * 8 + h] = bon;
        }
        if (j + 1 < SEQ / 8) SC_LOAD(j + 1);
        __syncthreads();
        if (j > 0 && tid < 256) {
            const int u = tid >> 5, rrow = tid & 31, s = 8 * (j - 1) + u, tau = dir ? SEQ - 1 - s : s;
            YS[(size_t)tau * 512 + rrow] = (bf16)f2bf(ring[SC_YOFF + (((j - 1) & 1) * 8 + u) * 32 + rrow]);
        }
        {
            const LAS float* sl0 = ring + ((j & 1) * 8) * SC_SLOT;
            float nkk = sl0[lane], w = sl0[64 + lane], kka = sl0[128 + lane], kd = sl0[192 + lane], wr = sl0[256 + lane], vc2 = sl0[384 + rbase + (lane & 3)], c1 = sl0[448];
            f32x4 va = *(const LAS f32x4*)(sl0 + 320 + rbase);
#pragma unroll
            for (int u = 0; u < 8; ++u) {
                float nkk_n = 0.f, w_n = 0.f, kka_n = 0.f, kd_n = 0.f, wr_n = 0.f, vc2_n = 0.f, c1_n = 0.f; f32x4 va_n = {0.f, 0.f, 0.f, 0.f};
                if (u < 7) { const LAS float* sl = sl0 + (u + 1) * SC_SLOT;
                    nkk_n = sl[lane]; w_n = sl[64 + lane]; kka_n = sl[128 + lane]; kd_n = sl[192 + lane]; wr_n = sl[256 + lane]; vc2_n = sl[384 + rbase + (lane & 3)]; c1_n = sl[448];
                    va_n = *(const LAS f32x4*)(sl + 320 + rbase); }
                float p[4], pp[4];
#pragma unroll
                for (int i = 0; i < 4; ++i) { p[i] = S[i] * nkk; pp[i] = S[i] * wr; }
                const float q = allsum4(p, b0, b1);
                const float qy = allsum4(pp, b0, b1);
                const float sa[4] = {dppf<0x00>(q), dppf<0x55>(q), dppf<0xAA>(q), dppf<0xFF>(q)};
#pragma unroll
                for (int i = 0; i < 4; ++i) S[i] = S[i] * w + (sa[i] * kka + va[i] * kd);
                const float y = qy + (q * c1 + vc2);
                if (lane < 4) ring[SC_YOFF + ((j & 1) * 8 + u) * 32 + 4 * wave + lane] = y;
                nkk = nkk_n; w = w_n; kka = kka_n; kd = kd_n; wr = wr_n; vc2 = vc2_n; c1 = c1_n; va = va_n;
            }
        }
    }
    __syncthreads();
    if (tid < 256) { const int j = SEQ / 8; const int u = tid >> 5, rrow = tid & 31, s = 8 * (j - 1) + u, tau = dir ? SEQ - 1 - s : s;
        YS[(size_t)tau * 512 + rrow] = (bf16)f2bf(ring[SC_YOFF + (((j - 1) & 1) * 8 + u) * 32 + rrow]); }
#undef SC_LOAD
}

constexpr int S2_W = 0, S2_KKA = 64, S2_KD = 128, S2_VX = 192, S2_C = 256, S2_NKKB = 260, S2_WRB = 292, S2_ZB = 324, S2_SLOT = 368;
constexpr int S2_YOFF = 16 * S2_SLOT;
__device__ __forceinline__ void rwkv_scan2(Frame& F, const Args& AR, int seq) {
    const int dir = seq >> 6, b = (seq >> 3) & 7, h = seq & 7, lane = F.lane, wave = F.wave, tid = F.tid;
    LAS float* ring = (LAS float*)F.lds;
    bf16* YS = dir ? (bf16*)(F.ws + WS_TOP) : (bf16*)((unsigned char*)F.out + DO_YSF);
    YS += (size_t)b * SEQ * 512 + h * 64;
    __syncthreads();
    for (int i = tid; i < 16 * 32; i += 512) ring[(i >> 5) * S2_SLOT + S2_ZB + (i & 31)] = 0.f;
    constexpr int NBLK = SEQ / 8;
    if (wave >= 4) {
        const int p = wave - 4, ch = h * 64 + lane;
        const float* mu = AR.in[13];
        const float mu_r = mu[ch], mu_k = mu[512 + ch], mu_v = mu[1024 + ch];
        const float kk_c = AR.in[19][ch], ka_c = AR.in[20][ch], rk_c = AR.in[21][ch];
        const float w0_c = AR.in[14][dir * 512 + ch], a0_c = AR.in[16][dir * 512 + ch];
        const bf16* PRb = (const bf16*)(F.ws + WS_PR) + (size_t)b * SEQ * PR_P + ch;
        const bf16* Wd = (const bf16*)(F.ws + WS_LW) + (size_t)dir * ((size_t)M * 512) + (size_t)b * SEQ * 512 + ch;
        const bf16* Ad = (const bf16*)(F.ws + WS_LW) + (size_t)(2 + dir) * ((size_t)M * 512) + (size_t)b * SEQ * 512 + ch;
        float* BON = (float*)(F.ws + WS_BONUS) + ((size_t)dir * M + (size_t)b * SEQ) * 8;
        ScanRaw R[2];
#define S2_LOAD(jj) do { _Pragma("unroll") for (int e_ = 0; e_ < 2; ++e_) { const int s_ = 8 * (jj) + p + 4 * e_, tau_ = dir ? SEQ - 1 - s_ : s_; const bf16* row_ = PRb + (size_t)tau_ * PR_P; \
            const int up_ = tau_ > 0 ? -PR_P : 0, dn_ = tau_ < SEQ - 1 ? PR_P : 0; \
            R[e_].rc = row_[0]; R[e_].kc = row_[512]; R[e_].vc = row_[1024]; R[e_].rp = row_[up_]; R[e_].kp = row_[512 + up_]; R[e_].vp = row_[1024 + up_]; \
            R[e_].rn = row_[dn_]; R[e_].kn = row_[512 + dn_]; R[e_].vn = row_[1024 + dn_]; R[e_].wd = Wd[(size_t)tau_ * 512]; R[e_].ad = Ad[(size_t)tau_ * 512]; } } while (0)
#define S2_PRODUCE(jj) do { _Pragma("unroll") for (int e_ = 0; e_ < 2; ++e_) { const int u_ = p + 4 * e_, s_ = 8 * (jj) + u_, tau_ = dir ? SEQ - 1 - s_ : s_; \
            const float rc = bf2f(R[e_].rc), kc = bf2f(R[e_].kc), vc = bf2f(R[e_].vc); \
            const float pm = tau_ > 0 ? 1.f : 0.f, nm = tau_ < SEQ - 1 ? 1.f : 0.f; \
            const float rp = pm * bf2f(R[e_].rp), kp = pm * bf2f(R[e_].kp), vp = pm * bf2f(R[e_].vp), rn = nm * bf2f(R[e_].rn), kn = nm * bf2f(R[e_].kn), vn = nm * bf2f(R[e_].vn); \
            const float rr = rc + mu_r * (0.5f * (rp + rn) - rc), kx = kc + mu_k * (0.5f * (kp + kn) - kc), vx = vc + mu_v * (0.5f * (vp + vn) - vc); \
            const float wv = __expf(-0.60653065971f * fsig(w0_c + bf2f(R[e_].wd))), av = fsig(a0_c + bf2f(R[e_].ad)); \
            const float kkr = kx * kk_c, kd = kx * (1.0f + (av - 1.0f) * ka_c), rkd = rr * kd; \
            const float ps_[4] = {kkr * kkr, rr * kkr * av, rkd, rkd * rk_c}; \
            const float tot_ = allsum4(ps_, (lane & 1) != 0, (lane & 2) != 0); \
            const float ss = dppf<0x00>(tot_), c1r = dppf<0x55>(tot_), c2 = dppf<0xAA>(tot_), bon = dppf<0xFF>(tot_); \
            const float rn_ = __builtin_amdgcn_rsqf(fmaxf(ss, 1e-24f)); const float kk = kkr * rn_, kka = kk * av, c1 = c1r * rn_; \
            LAS float* sl = ring + (((jj) & 1) * 8 + u_) * S2_SLOT; \
            sl[S2_W + lane] = wv; sl[S2_KKA + lane] = kka; sl[S2_KD + lane] = kd; sl[S2_VX + lane] = vx; \
            ((LAS bf16*)(sl + S2_NKKB))[lane] = (bf16)f2bf(-kk); ((LAS bf16*)(sl + S2_WRB))[lane] = (bf16)f2bf(wv * rr); \
            if (lane == 0) { sl[S2_C] = c1; sl[S2_C + 1] = c2; BON[(size_t)tau_ * 8 + h] = bon; } } } while (0)
        S2_LOAD(0); S2_PRODUCE(0); S2_LOAD(1);
        __syncthreads();
#pragma unroll 1
        for (int j = 0; j < NBLK; ++j) {
            if (j + 1 < NBLK) { S2_PRODUCE(j + 1); if (j + 2 < NBLK) S2_LOAD(j + 2); }
            if (j > 0) {
                const int pt = tid - 256;
#pragma unroll
                for (int e = 0; e < 2; ++e) { const int idx = pt + 256 * e, u = idx >> 6, rrow = idx & 63, s = 8 * (j - 1) + u, tau = dir ? SEQ - 1 - s : s;
                    YS[(size_t)tau * 512 + rrow] = (bf16)f2bf(ring[S2_YOFF + (((j - 1) & 1) * 8 + u) * 64 + rrow]); }
            }
            __syncthreads();
        }
        { const int j = NBLK; const int pt = tid - 256;
#pragma unroll
          for (int e = 0; e < 2; ++e) { const int idx = pt + 256 * e, u = idx >> 6, rrow = idx & 63, s = 8 * (j - 1) + u, tau = dir ? SEQ - 1 - s : s;
              YS[(size_t)tau * 512 + rrow] = (bf16)f2bf(ring[S2_YOFF + (((j - 1) & 1) * 8 + u) * 64 + rrow]); } }
#undef S2_LOAD
#undef S2_PRODUCE
    } else {
        const int c = lane & 15, g = lane >> 4, row = 16 * wave + c;
        const int aoff = (((c & 3) == 0) ? S2_NKKB : ((c & 3) == 1) ? S2_WRB : S2_ZB) * 4 + (((c & 3) < 2) ? 16 * g : 0);
        const int aoff1 = aoff + (((c & 3) < 2) ? 64 : 0);
        float S[16];
#pragma unroll
        for (int i = 0; i < 16; ++i) S[i] = 0.f;
        __syncthreads();
#pragma unroll 1
        for (int j = 0; j < NBLK; ++j) {
            const LAS float* sl0 = ring + ((j & 1) * 8) * S2_SLOT;
            f32x4 w4[4], ka4[4], kd4[4]; bf16x8 A0, A1; float vv, c1, c2;
#define S2_CLOAD(sl) do { const LAS float* sl_ = (sl); \
            w4[0] = *(const LAS f32x4*)(sl_ + S2_W + 8 * g); w4[1] = *(const LAS f32x4*)(sl_ + S2_W + 8 * g + 4); w4[2] = *(const LAS f32x4*)(sl_ + S2_W + 32 + 8 * g); w4[3] = *(const LAS f32x4*)(sl_ + S2_W + 36 + 8 * g); \
            ka4[0] = *(const LAS f32x4*)(sl_ + S2_KKA + 8 * g); ka4[1] = *(const LAS f32x4*)(sl_ + S2_KKA + 8 * g + 4); ka4[2] = *(const LAS f32x4*)(sl_ + S2_KKA + 32 + 8 * g); ka4[3] = *(const LAS f32x4*)(sl_ + S2_KKA + 36 + 8 * g); \
            kd4[0] = *(const LAS f32x4*)(sl_ + S2_KD + 8 * g); kd4[1] = *(const LAS f32x4*)(sl_ + S2_KD + 8 * g + 4); kd4[2] = *(const LAS f32x4*)(sl_ + S2_KD + 32 + 8 * g); kd4[3] = *(const LAS f32x4*)(sl_ + S2_KD + 36 + 8 * g); \
            A0 = *(const LAS bf16x8*)((const LAS unsigned char*)sl_ + aoff); A1 = *(const LAS bf16x8*)((const LAS unsigned char*)sl_ + aoff1); \
            vv = sl_[S2_VX + row]; c1 = sl_[S2_C]; c2 = sl_[S2_C + 1]; } while (0)
            S2_CLOAD(sl0);
#pragma unroll
            for (int u = 0; u < 8; ++u) {
                const f32x4 cw0 = w4[0], cw1 = w4[1], cw2 = w4[2], cw3 = w4[3], ca0 = ka4[0], ca1 = ka4[1], ca2 = ka4[2], ca3 = ka4[3], cd0 = kd4[0], cd1 = kd4[1], cd2 = kd4[2], cd3 = kd4[3];
                const bf16x8 cA0 = A0, cA1 = A1; const float cvv = vv, cc1 = c1, cc2 = c2;
                if (u < 7) S2_CLOAD(sl0 + (u + 1) * S2_SLOT);
                v4u b0v, b1v;
                b0v.x = cvt_pk_bf16(S[0], S[1]); b0v.y = cvt_pk_bf16(S[2], S[3]); b0v.z = cvt_pk_bf16(S[4], S[5]); b0v.w = cvt_pk_bf16(S[6], S[7]);
                b1v.x = cvt_pk_bf16(S[8], S[9]); b1v.y = cvt_pk_bf16(S[10], S[11]); b1v.z = cvt_pk_bf16(S[12], S[13]); b1v.w = cvt_pk_bf16(S[14], S[15]);
                const f32x4 zz = {0.f, 0.f, 0.f, 0.f};
                const f32x4 acc0 = __builtin_amdgcn_mfma_f32_16x16x32_bf16(cA0, __builtin_bit_cast(bf16x8, b0v), zz, 0, 0, 0);
                const f32x4 acc1 = __builtin_amdgcn_mfma_f32_16x16x32_bf16(cA1, __builtin_bit_cast(bf16x8, b1v), zz, 0, 0, 0);
                float t[16];
#pragma unroll
                for (int i = 0; i < 4; ++i) {
                    t[i] = S[i] * cw0[i] + cvv * cd0[i]; t[4 + i] = S[4 + i] * cw1[i] + cvv * cd1[i];
                    t[8 + i] = S[8 + i] * cw2[i] + cvv * cd2[i]; t[12 + i] = S[12 + i] * cw3[i] + cvv * cd3[i];
                }
                const float sa = acc0[0] + acc1[0], yp = acc0[1] + acc1[1];
#pragma unroll
                for (int i = 0; i < 4; ++i) {
                    S[i] = sa * ca0[i] + t[i]; S[4 + i] = sa * ca1[i] + t[4 + i]; S[8 + i] = sa * ca2[i] + t[8 + i]; S[12 + i] = sa * ca3[i] + t[12 + i];
                }
                const float y = yp + (sa * cc1 + cvv * cc2);
                if (g == 0) ring[S2_YOFF + ((j & 1) * 8 + u) * 64 + row] = y;
            }
            __syncthreads();
        }
#undef S2_CLOAD
    }
    __syncthreads();
}

__device__ __forceinline__ void p4_mixers(Frame& F, const Args& AR, bool do_scan, bool do_hy, bool dry) {
    if (F.bid < 128) { if (do_scan) rwkv_scan2(F, AR, F.bid); }
    else if (do_hy) { for (int c = F.bid - 128; c < 512; c += F.G - 128) hyena_item(F, AR, c, dry); }
}

__device__ __forceinline__ float row16_allsum(float q) { q += dppf<0xB1>(q); q += dppf<0x4E>(q); q += dppf<0x124>(q); q += dppf<0x128>(q); return q; }
__device__ __forceinline__ void p5_combine(Frame& F, const Args& AR, bool dry) {
    unsigned char* ws = F.ws; const int lane = F.lane;
    const int gw = F.bid * NWAVES + F.wave, NGW = F.G * NWAVES;
    {
      bf16* YSF = (bf16*)((unsigned char*)F.out + DO_YSF); const bf16* YSB = (const bf16*)(ws + WS_TOP);
      const bf16* PR = (const bf16*)(ws + WS_PR); const bf16* Gt = (const bf16*)(ws + WS_LW) + (size_t)4 * ((size_t)M * 512);
      const float* BON = (const float*)(ws + WS_BONUS);
      const int hh = gw & 1, ch0 = 256 * hh + 4 * lane, head = 4 * hh + (lane >> 4);
      const f32x4 gnw = *(const f32x4*)(AR.in[22] + ch0), gnb = *(const f32x4*)(AR.in[23] + ch0), muv = *(const f32x4*)(AR.in[13] + 1024 + ch0);
      for (int it0 = gw; it0 < 2 * M; it0 += 2 * NGW) {
          v2u yf[2], yb[2], gg[2], vc[2], vp[2], vn[2]; float bon[2];
#pragma unroll
          for (int e = 0; e < 2; ++e) { const int m = (it0 + e * NGW) >> 1, t = m & (SEQ - 1);
              yf[e] = *(const v2u*)(YSF + (size_t)m * 512 + ch0); yb[e] = *(const v2u*)(YSB + (size_t)m * 512 + ch0); gg[e] = *(const v2u*)(Gt + (size_t)m * 512 + ch0);
              const bf16* p = PR + (size_t)m * PR_P + 1024 + ch0; vc[e] = *(const v2u*)p;
              vp[e] = *(const v2u*)(p - (t > 0 ? PR_P : 0)); vn[e] = *(const v2u*)(p + (t < SEQ - 1 ? PR_P : 0));
              bon[e] = BON[(size_t)m * 8 + head] + BON[((size_t)M + m) * 8 + head]; }
#pragma unroll
          for (int e = 0; e < 2; ++e) { const int m = (it0 + e * NGW) >> 1, t = m & (SEQ - 1);
              const float pm = t > 0 ? 1.f : 0.f, nm = t < SEQ - 1 ? 1.f : 0.f;
              float y[4] = {bflo(yf[e].x) + bflo(yb[e].x), bfhi(yf[e].x) + bfhi(yb[e].x), bflo(yf[e].y) + bflo(yb[e].y), bfhi(yf[e].y) + bfhi(yb[e].y)};
              const float mean = row16_allsum((y[0] + y[1]) + (y[2] + y[3])) * (1.0f / 64.0f);
#pragma unroll
              for (int i = 0; i < 4; ++i) y[i] -= mean;
              const float var = row16_allsum((y[0] * y[0] + y[1] * y[1]) + (y[2] * y[2] + y[3] * y[3])) * (1.0f / 64.0f);
              const float rs = rsqrtf(var + GN_EPS);
              const float vcur[4] = {bflo(vc[e].x), bfhi(vc[e].x), bflo(vc[e].y), bfhi(vc[e].y)};
              const float vprv[4] = {bflo(vp[e].x), bfhi(vp[e].x), bflo(vp[e].y), bfhi(vp[e].y)};
              const float vnxt[4] = {bflo(vn[e].x), bfhi(vn[e].x), bflo(vn[e].y), bfhi(vn[e].y)};
              const float gv[4] = {bflo(gg[e].x), bfhi(gg[e].x), bflo(gg[e].y), bfhi(gg[e].y)};
              float o[4];
#pragma unroll
              for (int i = 0; i < 4; ++i) { const float vx = vcur[i] + muv[i] * (0.5f * (pm * vprv[i] + nm * vnxt[i]) - vcur[i]);
                  o[i] = (y[i] * rs * gnw[i] + gnb[i] + bon[e] * vx) * gv[i]; }
              v2u w; w.x = pk2(o[0], o[1]); w.y = pk2(o[2], o[3]);
              if (!dry) *(v2u*)(YSF + (size_t)m * 512 + ch0) = w; }
      } }
    { const bf16* ZHT = (const bf16*)((unsigned char*)F.out + DO_HT); bf16* ZH = (bf16*)(ws + WS_ZH);
      LAS bf16* tile = (LAS bf16*)(F.lds + F.wave * 9216);
      const int lr = lane >> 3, lc = lane & 7;
      for (int it = gw; it < 8 * NB * 64; it += NGW) {
          const int tb = it & 63, b = (it >> 6) & 7, cbk = it >> 9; const int t0 = tb * 64, c0 = cbk * 64;
          v4u v[8];
#pragma unroll
          for (int i = 0; i < 8; ++i) v[i] = *(const v4u*)(ZHT + ((size_t)(c0 + lr + 8 * i) * NB + b) * SEQ + t0 + 8 * lc);
#pragma unroll
          for (int i = 0; i < 8; ++i) { LAS unsigned* d = (LAS unsigned*)(tile + (lr + 8 * i) * 66 + 8 * lc); d[0] = v[i].x; d[1] = v[i].y; d[2] = v[i].z; d[3] = v[i].w; }
          asm volatile("s_waitcnt lgkmcnt(0)" ::: "memory");
#pragma unroll
          for (int i = 0; i < 8; ++i) { const int tl = lr + 8 * i; unsigned e[8];
#pragma unroll
              for (int k = 0; k < 8; ++k) e[k] = tile[(8 * lc + k) * 66 + tl];
              v4u w; w.x = e[0] | (e[1] << 16); w.y = e[2] | (e[3] << 16); w.z = e[4] | (e[5] << 16); w.w = e[6] | (e[7] << 16);
              *(v4u*)(ZH + ((size_t)b * SEQ + t0 + tl) * 512 + c0 + 8 * lc) = w; }
          asm volatile("s_waitcnt lgkmcnt(0)" ::: "memory");
      }
    }
}

__device__ __forceinline__ void ln1_pass(Frame& F, const Args& AR) {
    const int gw = F.bid * NWAVES + F.wave, NGW = F.G * NWAVES, lane = F.lane;
    const float* H1 = (const float*)(F.ws + WS_H1); float* ST = (float*)(F.ws + WS_STATS); bf16* X1B = (bf16*)(F.ws + WS_X1B);
    const f32x4* w4 = (const f32x4*)AR.in[27]; const f32x4* b4 = (const f32x4*)AR.in[28];
    for (int m = gw; m < M; m += NGW) {
        const f32x4* xr = (const f32x4*)(H1 + (size_t)m * DM) + lane;
        f32x4 v[4]; float s = 0.f;
#pragma unroll
        for (int j = 0; j < 4; ++j) { v[j] = xr[64 * j]; s += (v[j].x + v[j].y) + (v[j].z + v[j].w); }
        const float mean = wave_sum(s) * (1.f / DM); float s2 = 0.f;
#pragma unroll
        for (int j = 0; j < 4; ++j) { v[j] = v[j] - mean; s2 += (v[j].x * v[j].x + v[j].y * v[j].y) + (v[j].z * v[j].z + v[j].w * v[j].w); }
        const float rstd = 1.f / sqrtf(wave_sum(s2) * (1.f / DM) + LN_EPS);
        if (lane == 0) { ST[2 * m] = mean; ST[2 * m + 1] = rstd; }
        v2u* o8 = (v2u*)(X1B + (size_t)m * DM) + lane;
#pragma unroll
        for (int j = 0; j < 4; ++j) { const f32x4 y = v[j] * rstd * w4[64 * j + lane] + b4[64 * j + lane]; v2u o; o.x = pk2(y.x, y.y); o.y = pk2(y.z, y.w); o8[64 * j] = o; }
    }
}
__device__ __forceinline__ void ln2_pass(Frame& F, const Args& AR, bool dry) {
    const int gw = F.bid * NWAVES + F.wave, NGW = F.G * NWAVES, lane = F.lane;
    const f32x4* w4 = (const f32x4*)AR.in[32]; const f32x4* b4 = (const f32x4*)AR.in[33];
    for (int m = gw; m < M; m += NGW) {
        f32x4* xr = (f32x4*)(F.out + (size_t)m * DM) + lane;
        f32x4 v[4]; float s = 0.f;
#pragma unroll
        for (int j = 0; j < 4; ++j) { v[j] = xr[64 * j]; s += (v[j].x + v[j].y) + (v[j].z + v[j].w); }
        const float mean = wave_sum(s) * (1.f / DM); float s2 = 0.f;
#pragma unroll
        for (int j = 0; j < 4; ++j) { v[j] = v[j] - mean; s2 += (v[j].x * v[j].x + v[j].y * v[j].y) + (v[j].z * v[j].z + v[j].w * v[j].w); }
        const float rstd = 1.f / sqrtf(wave_sum(s2) * (1.f / DM) + LN_EPS);
#pragma unroll
        for (int j = 0; j < 4; ++j) { const f32x4 y = v[j] * rstd * w4[64 * j + lane] + b4[64 * j + lane]; if (!dry) xr[64 * j] = y; }
    }
}

constexpr int LDS_BYTES = 147456;
constexpr int N_PHASES = 13;
#ifndef PROBE_DUP
#define PROBE_DUP -1
#endif
#ifndef PROBE_SUB
#define PROBE_SUB 0
#endif

__global__ void __launch_bounds__(512, 2) hybrid_fwd(Args args) {
    extern __shared__ __attribute__((aligned(16))) unsigned char lds_raw[];
    cg::grid_group grid = cg::this_grid();
    Frame F;
    F.lds = (LAS unsigned char*)lds_raw;
    F.tid = threadIdx.x; F.lane = F.tid & 63; F.wave = __builtin_amdgcn_readfirstlane(F.tid >> 6);
    F.G = gridDim.x; F.bid = blockIdx.x;
    F.out = args.out; F.ws = args.ws;
    unsigned char* ws = args.ws;
    const int lo = args.ph_lo, hi = args.ph_hi;
#define IN(k) (lo <= (k) && (k) < hi)
#define SEAM(k) do { if (IN(k) && IN((k) + 1)) grid.sync(); } while (0)
    using pg8::Gemm; using pg8::StaticOrder; using pg8::gemm_phase;

#define REP(k) for (int rep = 0; rep < ((PROBE_DUP == (k)) ? 2 : 1); ++rep, ((PROBE_DUP == (k)) ? grid.sync() : (void)0))
    if (IN(0)) REP(0) { p0_prologue(F, args); } SEAM(0);
    if (IN(1)) REP(1) {
        Gemm g{(const bf16*)(ws + WS_XB), (const bf16*)(ws + WS_WIN), M, NP, DM}; StaticOrder S; S.init(M, NP, F.G, F.bid);
        EpiProj E{(bf16*)(ws + WS_PH), (bf16*)(ws + WS_PR), (bf16*)(ws + WS_PG)};
        gemm_phase<EpiProj, StaticOrder, true, true>(F.lds, g, S, E);
    } SEAM(1);
    if (IN(2)) REP(2) { p2_prep(F, args); } SEAM(2);
    if (IN(3)) REP(3) {
        Gemm g{(const bf16*)(ws + WS_TOP), (const bf16*)(ws + WS_WLORA), M, LORA_N, LORA_K}; StaticOrder S; S.init(M, LORA_N, F.G, F.bid);
        EpiLora E{(bf16*)(ws + WS_LW)};
        gemm_phase<EpiLora, StaticOrder, true, true>(F.lds, g, S, E);
    } SEAM(3);
    if (IN(4)) { if (PROBE_DUP == 4) { p4_mixers(F, args, PROBE_SUB != 2, PROBE_SUB != 1, true); grid.sync(); } p4_mixers(F, args, true, true, false); } SEAM(4);
    if (IN(5)) REP(5) { p5_combine(F, args, (PROBE_DUP == 5) && rep == 0); } SEAM(5);
    if (IN(6)) REP(6) {
        Gemm g{(const bf16*)(ws + WS_ZH), (const bf16*)(ws + WS_WHY), M, DM, 512}; StaticOrder S; S.init(M, DM, F.G, F.bid);
        EpiGate<0> E{(const bf16*)(ws + WS_PG), (bf16*)(ws + WS_T), nullptr};
        gemm_phase<EpiGate<0>, StaticOrder, true, true>(F.lds, g, S, E);
    } SEAM(6);
    if (IN(7)) REP(7) {
        Gemm g{(const bf16*)((unsigned char*)F.out + DO_YSF), (const bf16*)(ws + WS_WRW), M, DM, 512}; StaticOrder S; S.init(M, DM, F.G, F.bid);
        EpiGate<1> E{(const bf16*)(ws + WS_PG), (bf16*)(ws + WS_T), (bf16*)(ws + WS_MIXIN)};
        gemm_phase<EpiGate<1>, StaticOrder, true, true>(F.lds, g, S, E);
    } SEAM(7);
    if (IN(8)) REP(8) {
        Gemm g{(const bf16*)(ws + WS_MIXIN), (const bf16*)(ws + WS_WO), M, DM, DM}; StaticOrder S; S.init(M, DM, F.G, F.bid);
        EpiWo E{args.in[0], (float*)(ws + WS_H1)};
        gemm_phase<EpiWo, StaticOrder, true, true>(F.lds, g, S, E);
    } SEAM(8);
    if (IN(9)) REP(9) { ln1_pass(F, args); } SEAM(9);
    if (IN(10)) REP(10) {
        Gemm g{(const bf16*)(ws + WS_X1B), (const bf16*)(ws + WS_WGU), M, NGU, DM}; StaticOrder S; S.init(M, NGU, F.G, F.bid);
        EpiSwiGLU E{(bf16*)(ws + WS_HID)};
        gemm_phase<EpiSwiGLU, StaticOrder, true, true>(F.lds, g, S, E);
    } SEAM(10);
    if (IN(11)) REP(11) {
        Gemm g{(const bf16*)(ws + WS_HID), (const bf16*)(ws + WS_WD), M, DM, FFH}; StaticOrder S; S.init(M, DM, F.G, F.bid);
        EpiDown E{(const float*)(ws + WS_H1), (const float*)(ws + WS_STATS), args.in[27], args.in[28], F.out};
        gemm_phase<EpiDown, StaticOrder, true, true>(F.lds, g, S, E);
    } SEAM(11);
    if (IN(12)) REP(12) { ln2_pass(F, args, (PROBE_DUP == 12) && rep == 0); }
#undef IN
#undef SEAM
}

extern "C" void kernel_launch(void* const* d_in, const int* in_sizes, int n_in, void* d_out, int out_size, void* d_ws, size_t ws_size, hipStream_t stream) {
    static int grid = 0;
    if (grid == 0) {
        if (n_in != 34 || out_size != M * DM || ws_size < WS_NEED) { fprintf(stderr, "kernel_launch: unexpected shapes (n_in %d out %d ws %zu)\n", n_in, out_size, ws_size); grid = -1; return; }
        int dev = 0, cus = 0, per_cu = 0;
        if (hipGetDevice(&dev) != hipSuccess || hipDeviceGetAttribute(&cus, hipDeviceAttributeMultiprocessorCount, dev) != hipSuccess) { grid = -1; return; }
        if (hipFuncSetAttribute((const void*)hybrid_fwd, hipFuncAttributeMaxDynamicSharedMemorySize, LDS_BYTES) != hipSuccess) { fprintf(stderr, "kernel_launch: hipFuncSetAttribute failed\n"); grid = -1; return; }
        if (hipOccupancyMaxActiveBlocksPerMultiprocessor(&per_cu, (const void*)hybrid_fwd, 512, LDS_BYTES) != hipSuccess || per_cu < 1) { fprintf(stderr, "kernel_launch: occupancy query says %d\n", per_cu); per_cu = 1; }
        (void)hipGetLastError();
        grid = cus;
        if (grid != 256) fprintf(stderr, "kernel_launch: %d CUs (built for 256)\n", grid);
    }
    if (grid < 0) return;
    Args a{};
    for (int i = 0; i < 34; ++i) a.in[i] = (const float*)d_in[i];
    a.out = (float*)d_out; a.ws = (unsigned char*)d_ws; a.ph_lo = 0; a.ph_hi = N_PHASES;
    void* kargs[] = {&a};
    hipError_t e = hipLaunchCooperativeKernel((void*)hybrid_fwd, dim3(grid), dim3(512), kargs, LDS_BYTES, stream);
    if (e != hipSuccess) fprintf(stderr, "kernel_launch: cooperative launch failed: %s\n", hipGetErrorString(e));
}
```

```cpp
#include <hip/hip_runtime.h>
#include <hip/hip_cooperative_groups.h>
#include <cstdio>
#include <cstdint>
namespace cg = cooperative_groups;
namespace pg8 {
#define PG8_LAS __attribute__((address_space(3)))
typedef unsigned short bf16_t;
typedef short bf16x8 __attribute__((ext_vector_type(8)));
typedef float f32x4 __attribute__((ext_vector_type(4)));
typedef unsigned u32x4 __attribute__((ext_vector_type(4)));
constexpr int BM = 256, BK = 64, HALF = 128, HTB = HALF * BK * 2  , STAGE_BYTES = 8 * HTB, NXCD = 8, WGM = 8;

__host__ __device__ __forceinline__ int lds_byte(int r, int c) { const int st = (r >> 4) * 2 + (c >> 5), rr = r & 15, cc = c & 31, ob = rr * 64 + cc * 2; return st * 1024 + (ob ^ (((ob >> 9) & 1) << 5)); }
__host__ __device__ __forceinline__ void stage_rc(int b, int& R, int& C) { const int st = b / 1024, sb = b % 1024, swz = sb ^ (((sb >> 9) & 1) << 5); R = (st >> 1) * 16 + swz / 64; C = (st & 1) * 32 + (swz % 64) / 2; }
__host__ __device__ __forceinline__ int perm32(int rho) { const int n = rho >> 4, i = rho & 15; return 8 * (i >> 2) + 4 * n + (i & 3); }

struct Unit { int pm, pn; };
struct Gemm { const bf16_t* A; const bf16_t* Bt; int M, N, K; };

struct StaticOrder {
    int nM, nN, nwg, G, c;
    __host__ __device__ void init(int M, int N, int G_, int c_) { nM = M / BM; nN = N / BM; nwg = nM * nN; G = G_; c = c_; }
    __host__ __device__ bool next(int i, Unit& u) const {
        const long L = (long)i * G + c; if (L >= nwg) return false;
        int wgid = (int)L; { const int q = nwg / NXCD, r = nwg % NXCD, xcd = wgid % NXCD, off = wgid / NXCD; wgid = (xcd < r ? xcd * (q + 1) : r * (q + 1) + (xcd - r) * q) + off; }
        const int nig = WGM * nN, gid = wgid / nig, fm = gid * WGM, gsz = (nM - fm) < WGM ? (nM - fm) : WGM;
        u.pm = fm + ((wgid % nig) % gsz); u.pn = (wgid % nig) / gsz; return true;
    }
    __device__ __forceinline__ void a_ready(const Unit&) const {}
    __device__ __forceinline__ void done(const Unit&) const {}
};

__device__ __forceinline__ unsigned cvt_pk_bf16(float lo, float hi) { unsigned r; asm volatile("v_cvt_pk_bf16_f32 %0, %1, %2" : "=v"(r) : "v"(lo), "v"(hi)); return r; }
typedef float f32x2 __attribute__((ext_vector_type(2)));
template <class Epi, class Sched, bool ALIGN_EPI = false, bool SP2 = false>
__device__ __forceinline__ void gemm_phase(PG8_LAS unsigned char* lds, const Gemm g, const Sched& S, const Epi& E) {
    const int tid = threadIdx.x, wid = __builtin_amdgcn_readfirstlane(tid >> 6), lane = tid & 63, wr = wid >> 2, wc = wid & 3, fr = lane & 15, fq = lane >> 4;
    const int K = g.K, nt = K / BK;
    unsigned voffA[2], voffB[2];
#pragma unroll
    for (int i = 0; i < 2; ++i) { int R, C; stage_rc(tid * 16 + i * 8192, R, C); const int Rb = Epi::PERM ? ((R & ~31) + perm32(R & 31)) : R;
        voffA[i] = (unsigned)(R * K + C) * 2u; voffB[i] = (unsigned)(Rb * K + C) * 2u; }
    const size_t kstep = (size_t)(BK * 2);
    const size_t hstep = (size_t)HALF * K * 2;
    const size_t tstep = 2 * hstep;
    const unsigned ldsw = (unsigned)wid * 1024u;
    const int aoff = lds_byte(wr * 64 + fr, fq * 8), boff = lds_byte(wc * 32 + fr, fq * 8);
#define PG8_SA(b, h) (((b) * 2 + (h)) * HTB)
#define PG8_SB(b, h) ((4 + (b) * 2 + (h)) * HTB)
#define PG8_STAGE(bufoff, gbase, voff) do { _Pragma("unroll") for (int _i = 0; _i < 2; ++_i) \
        __builtin_amdgcn_global_load_lds((const unsigned*)((const char*)(gbase) + (voff)[_i]), (PG8_LAS unsigned*)(lds + (bufoff) + ldsw + _i * 8192), 16, 0, 0); } while (0)
#define PG8_LDA(dst, b, h) do { _Pragma("unroll") for (int m = 0; m < 4; ++m) _Pragma("unroll") for (int k = 0; k < 2; ++k) dst[m][k] = *(const PG8_LAS bf16x8*)(lds + PG8_SA(b, h) + aoff + m * 2048 + k * 1024); } while (0)
#define PG8_LDB(dst, b, h) do { _Pragma("unroll") for (int n = 0; n < 2; ++n) _Pragma("unroll") for (int k = 0; k < 2; ++k) dst[n][k] = *(const PG8_LAS bf16x8*)(lds + PG8_SB(b, h) + boff + n * 2048 + k * 1024); } while (0)
#define PG8_MMA(ai, bj, At, Bt) do { __builtin_amdgcn_s_setprio(1); _Pragma("unroll") for (int m = 0; m < 4; ++m) _Pragma("unroll") for (int n = 0; n < 2; ++n) _Pragma("unroll") for (int k = 0; k < 2; ++k) \
        acc[ai][bj][m][n] = __builtin_amdgcn_mfma_f32_16x16x32_bf16(Bt[n][k], At[m][k], acc[ai][bj][m][n], 0, 0, 0); __builtin_amdgcn_s_setprio(0); } while (0)
#define PG8_WAIT_V(n) asm volatile("s_waitcnt vmcnt(" #n ")" ::: "memory")
#define PG8_WAIT_L(n) asm volatile("s_waitcnt lgkmcnt(" #n ")" ::: "memory")
#define PG8_BAR __builtin_amdgcn_s_barrier()
#define PG8_SCHED __builtin_amdgcn_sched_barrier(0)
    Unit cur, nxt; int ui = 0;
    if (!S.next(0, cur)) return;
    f32x4 acc[2][2][4][2];
#pragma unroll
    for (int a = 0; a < 2; ++a)
#pragma unroll
        for (int b = 0; b < 2; ++b)
#pragma unroll
            for (int m = 0; m < 4; ++m)
#pragma unroll
                for (int n = 0; n < 2; ++n) acc[a][b][m][n] = (f32x4){0.f, 0.f, 0.f, 0.f};
    bf16x8 At[4][2], B0[2][2], B1[2][2];
    const char* cA = (const char*)g.A + (size_t)cur.pm * tstep; const char* cB = (const char*)g.Bt + (size_t)cur.pn * tstep;
    S.a_ready(cur);
    if constexpr (SP2) {
        PG8_STAGE(PG8_SB(0, 0), cB, voffB); PG8_STAGE(PG8_SB(0, 1), cB + hstep, voffB); PG8_STAGE(PG8_SA(0, 0), cA, voffA); PG8_STAGE(PG8_SA(0, 1), cA + hstep, voffA);
        if (wr == 1) PG8_BAR;
        PG8_WAIT_V(2); PG8_BAR;
        PG8_STAGE(PG8_SB(1, 0), cB + kstep, voffB); PG8_STAGE(PG8_SA(1, 0), cA + kstep, voffA); PG8_STAGE(PG8_SB(1, 1), cB + hstep + kstep, voffB);
        PG8_WAIT_V(6); PG8_BAR;
    } else {
        PG8_STAGE(PG8_SB(0, 0), cB, voffB); PG8_STAGE(PG8_SA(0, 0), cA, voffA); PG8_STAGE(PG8_SB(0, 1), cB + hstep, voffB); PG8_STAGE(PG8_SA(0, 1), cA + hstep, voffA);
        if (wr == 1) PG8_BAR;
        PG8_WAIT_V(4); PG8_BAR;
        PG8_STAGE(PG8_SB(1, 0), cB + kstep, voffB); PG8_STAGE(PG8_SA(1, 0), cA + kstep, voffA); PG8_STAGE(PG8_SB(1, 1), cB + hstep + kstep, voffB);
        PG8_WAIT_V(6); PG8_BAR;
    }
    for (;;) {
        const bool has_next = S.next(ui + 1, nxt);
        const char* nA = has_next ? (const char*)g.A + (size_t)nxt.pm * tstep : cA; const char* nB = has_next ? (const char*)g.Bt + (size_t)nxt.pn * tstep : cB;
#pragma unroll 1
        for (int t = 0; t < nt; t += 2) {
            const bool last = (t == nt - 2);
            const char* a1 = cA + (size_t)(t + 1) * kstep;
            const char* a2 = last ? nA : cA + (size_t)(t + 2) * kstep; const char* b2 = last ? nB : cB + (size_t)(t + 2) * kstep;
            const char* a3 = a2 + kstep; const char* b3 = b2 + kstep;
            if (last && has_next) S.a_ready(nxt);
            if constexpr (SP2) {
            PG8_LDB(B0, 0, 0); PG8_LDB(B1, 0, 1); PG8_SCHED; PG8_LDA(At, 0, 0); PG8_STAGE(PG8_SA(1, 1), a1 + hstep, voffA);
            PG8_WAIT_V(8); PG8_WAIT_L(0); PG8_BAR; PG8_MMA(0, 0, At, B0); PG8_MMA(0, 1, At, B1); PG8_BAR; PG8_SCHED;
            PG8_LDA(At, 0, 1); PG8_STAGE(PG8_SB(0, 0), b2, voffB); PG8_STAGE(PG8_SB(0, 1), b2 + hstep, voffB); PG8_STAGE(PG8_SA(0, 0), a2, voffA);
            PG8_WAIT_V(8); PG8_WAIT_L(0); PG8_BAR; PG8_MMA(1, 0, At, B0); PG8_MMA(1, 1, At, B1); PG8_BAR; PG8_SCHED;
            PG8_LDB(B0, 1, 0); PG8_LDB(B1, 1, 1); PG8_SCHED; PG8_LDA(At, 1, 0); PG8_STAGE(PG8_SA(0, 1), a2 + hstep, voffA);
            PG8_WAIT_V(8); PG8_WAIT_L(0); PG8_BAR; PG8_MMA(0, 0, At, B0); PG8_MMA(0, 1, At, B1); PG8_BAR; PG8_SCHED;
            PG8_LDA(At, 1, 1); PG8_STAGE(PG8_SB(1, 0), b3, voffB); PG8_STAGE(PG8_SB(1, 1), b3 + hstep, voffB); PG8_STAGE(PG8_SA(1, 0), a3, voffA);
            PG8_WAIT_V(8); PG8_WAIT_L(0); PG8_BAR; PG8_MMA(1, 0, At, B0); PG8_MMA(1, 1, At, B1); PG8_BAR; PG8_SCHED;
            } else {
            PG8_LDB(B0, 0, 0); PG8_SCHED; PG8_LDA(At, 0, 0); PG8_STAGE(PG8_SA(1, 1), a1 + hstep, voffA);
            PG8_WAIT_L(8); PG8_BAR; PG8_WAIT_L(0); PG8_MMA(0, 0, At, B0); PG8_BAR; PG8_SCHED;
            PG8_LDB(B1, 0, 1); PG8_STAGE(PG8_SB(0, 0), b2, voffB);
            PG8_BAR; PG8_WAIT_L(0); PG8_MMA(0, 1, At, B1); PG8_BAR;
            PG8_LDA(At, 0, 1); PG8_STAGE(PG8_SA(0, 0), a2, voffA);
            PG8_BAR; PG8_WAIT_L(0); PG8_MMA(1, 0, At, B0); PG8_BAR; PG8_SCHED;
            PG8_STAGE(PG8_SB(0, 1), b2 + hstep, voffB);
            PG8_WAIT_V(6); PG8_BAR; PG8_MMA(1, 1, At, B1); PG8_BAR;
            PG8_LDB(B0, 1, 0); PG8_SCHED; PG8_LDA(At, 1, 0); PG8_STAGE(PG8_SA(0, 1), a2 + hstep, voffA);
            PG8_WAIT_L(8); PG8_BAR; PG8_WAIT_L(0); PG8_MMA(0, 0, At, B0); PG8_BAR; PG8_SCHED;
            PG8_LDB(B1, 1, 1); PG8_STAGE(PG8_SB(1, 0), b3, voffB);
            PG8_BAR; PG8_WAIT_L(0); PG8_MMA(0, 1, At, B1); PG8_BAR;
            PG8_LDA(At, 1, 1); PG8_STAGE(PG8_SA(1, 0), a3, voffA);
            PG8_BAR; PG8_WAIT_L(0); PG8_MMA(1, 0, At, B0); PG8_BAR; PG8_SCHED;
            PG8_STAGE(PG8_SB(1, 1), b3 + hstep, voffB);
            PG8_WAIT_V(6); PG8_BAR; PG8_MMA(1, 1, At, B1); PG8_BAR;
            }
        }
        if constexpr (ALIGN_EPI) { if (wr == 0) PG8_BAR; }
        if constexpr (!Epi::AFTER_DRAIN) { E(acc, cur, wr, wc, fr, fq); S.done(cur); }
        if (!has_next) break;
#pragma unroll
        for (int a = 0; a < 2; ++a)
#pragma unroll
            for (int b = 0; b < 2; ++b)
#pragma unroll
                for (int m = 0; m < 4; ++m)
#pragma unroll
                    for (int n = 0; n < 2; ++n) acc[a][b][m][n] = (f32x4){0.f, 0.f, 0.f, 0.f};
        cur = nxt; cA = nA; cB = nB; ++ui;
        if constexpr (ALIGN_EPI) { if (wr == 1) PG8_BAR; }
    }
    PG8_WAIT_V(0);
    if constexpr (!ALIGN_EPI) { if (wr == 0) PG8_BAR; }
    PG8_BAR;
    if constexpr (Epi::AFTER_DRAIN) { E.fused(acc, cur, wr, wc, fr, fq, lds, wid, lane); S.done(cur); }
#undef PG8_SA
#undef PG8_SB
#undef PG8_STAGE
#undef PG8_LDA
#undef PG8_LDB
#undef PG8_MMA
#undef PG8_WAIT_V
#undef PG8_WAIT_L
#undef PG8_BAR
#undef PG8_SCHED
}
}

constexpr int NB = 8, SEQ = 4096, DM = 1024, M = NB * SEQ;
constexpr int NHEAD = 8;
constexpr int PH_P = 1536, PR_P = 1920, PG_P = 2048;
constexpr int NP = 5632;
constexpr int FFH = 2816, NGU = 5632;
constexpr int LORA_K = 384, LORA_N = 2560;
constexpr float DN_ALPHA = 1.18920711500272f;
constexpr float LN_EPS = 1e-5f, GN_EPS = 64e-5f;
constexpr float HY_MIN_DECAY = -3.07011346f, HY_MAX_DECAY = -15.3505673f;
constexpr int NWAVES = 8;

constexpr size_t MiB = 1u << 20;
constexpr size_t WS_H3T = 1 * MiB;
constexpr size_t WS_STATS = 2 * MiB;
constexpr size_t WS_BONUS = 3 * MiB;
constexpr size_t WS_WIN = 5 * MiB, WS_WGU = 16 * MiB, WS_WD = 27 * MiB, WS_WO = 33 * MiB, WS_WHY = 35 * MiB, WS_WRW = 36 * MiB, WS_WLORA = 37 * MiB;
constexpr size_t WS_FT = 39 * MiB;
constexpr size_t WS_XB = 71 * MiB;
constexpr size_t WS_LW = 71 * MiB;
constexpr size_t WS_PH = 135 * MiB, WS_PR = 231 * MiB, WS_PG = 351 * MiB;
constexpr size_t WS_TOP = 479 * MiB;
constexpr size_t WS_ZH = 71 * MiB, WS_T = 103 * MiB, WS_MIXIN = 167 * MiB;
constexpr size_t WS_H1 = 351 * MiB, WS_X1B = 71 * MiB, WS_HID = 135 * MiB;
constexpr size_t WS_NEED = 511 * MiB;
constexpr size_t DO_HT = 0, DO_YSF = 96 * MiB;

#define GAS __attribute__((address_space(1)))
#define LAS __attribute__((address_space(3)))
typedef unsigned short bf16;
typedef unsigned v4u __attribute__((ext_vector_type(4)));
typedef unsigned v2u __attribute__((ext_vector_type(2)));
typedef float f32x4 __attribute__((ext_vector_type(4)));
typedef float f32x16 __attribute__((ext_vector_type(16)));
typedef short bf16x8 __attribute__((ext_vector_type(8)));

__device__ __forceinline__ float bf2f(unsigned b) { return __uint_as_float(b << 16); }
__device__ __forceinline__ float bflo(unsigned w) { return __uint_as_float(w << 16); }
__device__ __forceinline__ float bfhi(unsigned w) { return __uint_as_float(w & 0xffff0000u); }
__device__ __forceinline__ unsigned f2bf(float f) { unsigned u = __float_as_uint(f); return (u + 0x7fffu + ((u >> 16) & 1u)) >> 16; }
__device__ __forceinline__ unsigned pk2(float lo, float hi) { return f2bf(lo) | (f2bf(hi) << 16); }
__device__ __forceinline__ float sigmoidf_(float x) { return 1.0f / (1.0f + __expf(-x)); }
__device__ __forceinline__ float fsig(float x) { return __builtin_amdgcn_rcpf(1.0f + __expf(-x)); }
__device__ __forceinline__ float wave_sum(float v) {
#pragma unroll
    for (int o = 1; o < 64; o <<= 1) v += __shfl_xor(v, o);
    return v;
}

struct Frame {
    LAS unsigned char* lds;
    int tid, lane, wave, G, bid;
    float* out; unsigned char* ws;
};
struct Args { const float* in[34]; float* out; unsigned char* ws; int ph_lo, ph_hi; };

using pg8::Unit; using pg8::cvt_pk_bf16; constexpr int HALF = 128, BM = 256;

__device__ __forceinline__ v4u pack8(f32x4 v0, f32x4 v1) { v4u w; w.x = cvt_pk_bf16(v0[0], v0[1]); w.y = cvt_pk_bf16(v0[2], v0[3]); w.z = cvt_pk_bf16(v1[0], v1[1]); w.w = cvt_pk_bf16(v1[2], v1[3]); return w; }

struct EpiProj {
    static constexpr bool PERM = true, AFTER_DRAIN = false;
    bf16 *PH, *PR, *PG;
    __device__ __forceinline__ void operator()(const f32x4 (&acc)[2][2][4][2], const Unit& u, int wr, int wc, int fr, int fq) const {
        const int row0 = u.pm * BM + wr * 64 + fr;
#pragma unroll
        for (int bj = 0; bj < 2; ++bj) {
            const int hb = 2 * u.pn + bj; bf16* base; int pitch, col;
            if (hb < 12) { base = PH; pitch = PH_P; col = 128 * hb; }
            else if (hb < 27) { base = PR; pitch = PR_P; col = 128 * (hb - 12); }
            else if (hb < 43) { base = PG; pitch = PG_P; col = 128 * (hb - 27); }
            else continue;
            col += wc * 32 + 8 * fq;
#pragma unroll
            for (int ai = 0; ai < 2; ++ai)
#pragma unroll
                for (int m = 0; m < 4; ++m)
                    *(v4u*)(base + (size_t)(row0 + ai * HALF + m * 16) * pitch + col) = pack8(acc[ai][bj][m][0], acc[ai][bj][m][1]);
        }
    }
};

struct EpiLora {
    static constexpr bool PERM = true, AFTER_DRAIN = false;
    bf16* LW;
    __device__ __forceinline__ void operator()(const f32x4 (&acc)[2][2][4][2], const Unit& u, int wr, int wc, int fr, int fq) const {
        const int row0 = u.pm * BM + wr * 64 + fr;
        bf16* base = LW + (size_t)(u.pn >> 1) * ((size_t)M * 512) + (u.pn & 1) * 256 + wc * 32 + 8 * fq;
#pragma unroll
        for (int ai = 0; ai < 2; ++ai)
#pragma unroll
            for (int m = 0; m < 4; ++m) { bf16* rowp = base + (size_t)(row0 + ai * HALF + m * 16) * 512;
#pragma unroll
                for (int bj = 0; bj < 2; ++bj) *(v4u*)(rowp + bj * HALF) = pack8(acc[ai][bj][m][0], acc[ai][bj][m][1]); }
    }
};

template <int STAGE> struct EpiGate {
    static constexpr bool PERM = true, AFTER_DRAIN = false;
    const bf16* PG; bf16* T; bf16* O;
    __device__ __forceinline__ void operator()(const f32x4 (&acc)[2][2][4][2], const Unit& u, int wr, int wc, int fr, int fq) const {
        const int row0 = u.pm * BM + wr * 64 + fr;
#pragma unroll
        for (int bj = 0; bj < 2; ++bj) {
            const int col = u.pn * BM + bj * HALF + wc * 32 + 8 * fq;
#pragma unroll
            for (int ai = 0; ai < 2; ++ai)
#pragma unroll
                for (int m = 0; m < 4; ++m) {
                    const size_t row = (size_t)(row0 + ai * HALF + m * 16);
                    const v4u g = *(const v4u*)(PG + row * PG_P + STAGE * 1024 + col);
                    f32x4 v0 = acc[ai][bj][m][0], v1 = acc[ai][bj][m][1];
                    v0[0] *= sigmoidf_(bflo(g.x)); v0[1] *= sigmoidf_(bfhi(g.x)); v0[2] *= sigmoidf_(bflo(g.y)); v0[3] *= sigmoidf_(bfhi(g.y));
                    v1[0] *= sigmoidf_(bflo(g.z)); v1[1] *= sigmoidf_(bfhi(g.z)); v1[2] *= sigmoidf_(bflo(g.w)); v1[3] *= sigmoidf_(bfhi(g.w));
                    if (STAGE == 1) {
                        const v4u t = *(const v4u*)(T + row * 1024 + col);
                        v0[0] += bflo(t.x); v0[1] += bfhi(t.x); v0[2] += bflo(t.y); v0[3] += bfhi(t.y);
                        v1[0] += bflo(t.z); v1[1] += bfhi(t.z); v1[2] += bflo(t.w); v1[3] += bfhi(t.w);
                        *(v4u*)(O + row * 1024 + col) = pack8(v0, v1);
                    } else {
                        *(v4u*)(T + row * 1024 + col) = pack8(v0, v1);
                    }
                }
        }
    }
};

struct EpiWo {
    static constexpr bool PERM = false, AFTER_DRAIN = false;
    const float* X; float* H1;
    __device__ __forceinline__ void operator()(const f32x4 (&acc)[2][2][4][2], const Unit& u, int wr, int wc, int fr, int fq) const {
        const int row0 = u.pm * BM + wr * 64 + fr, col0 = u.pn * BM + wc * 32 + 4 * fq;
#pragma unroll
        for (int ai = 0; ai < 2; ++ai)
#pragma unroll
            for (int m = 0; m < 4; ++m) {
                const size_t off = (size_t)(row0 + ai * HALF + m * 16) * DM + col0;
#pragma unroll
                for (int bj = 0; bj < 2; ++bj)
#pragma unroll
                    for (int n = 0; n < 2; ++n) {
                        const f32x4 xv = *(const f32x4*)(X + off + bj * HALF + n * 16);
                        *(f32x4*)(H1 + off + bj * HALF + n * 16) = xv * DN_ALPHA + acc[ai][bj][m][n];
                    }
            }
    }
};

struct EpiSwiGLU {
    static constexpr bool PERM = true, AFTER_DRAIN = false;
    bf16* HID;
    __device__ __forceinline__ void operator()(const f32x4 (&acc)[2][2][4][2], const Unit& u, int wr, int wc, int fr, int fq) const {
        const int row0 = u.pm * BM + wr * 64 + fr, col = u.pn * HALF + wc * 32 + 8 * fq;
#pragma unroll
        for (int ai = 0; ai < 2; ++ai)
#pragma unroll
            for (int m = 0; m < 4; ++m) {
                f32x4 g0 = acc[ai][0][m][0], g1 = acc[ai][0][m][1]; const f32x4 u0 = acc[ai][1][m][0], u1 = acc[ai][1][m][1];
#pragma unroll
                for (int j = 0; j < 4; ++j) { g0[j] = g0[j] * sigmoidf_(g0[j]) * u0[j]; g1[j] = g1[j] * sigmoidf_(g1[j]) * u1[j]; }
                *(v4u*)(HID + (size_t)(row0 + ai * HALF + m * 16) * FFH + col) = pack8(g0, g1);
            }
    }
};

struct EpiDown {
    static constexpr bool PERM = false, AFTER_DRAIN = false;
    const float* H1; const float* STATS; const float* lnw; const float* lnb; float* O;
    __device__ __forceinline__ void operator()(const f32x4 (&acc)[2][2][4][2], const Unit& u, int wr, int wc, int fr, int fq) const {
        const int row0 = u.pm * BM + wr * 64 + fr, col0 = u.pn * BM + wc * 32 + 4 * fq;
#pragma unroll
        for (int ai = 0; ai < 2; ++ai)
#pragma unroll
            for (int m = 0; m < 4; ++m) {
                const int row = row0 + ai * HALF + m * 16; const size_t off = (size_t)row * DM + col0;
                const float mean = STATS[2 * row], rstd = STATS[2 * row + 1];
#pragma unroll
                for (int bj = 0; bj < 2; ++bj)
#pragma unroll
                    for (int n = 0; n < 2; ++n) {
                        const f32x4 hv = *(const f32x4*)(H1 + off + bj * HALF + n * 16);
                        const f32x4 wv = *(const f32x4*)(lnw + col0 + bj * HALF + n * 16), bv = *(const f32x4*)(lnb + col0 + bj * HALF + n * 16);
                        const f32x4 x1 = (hv - mean) * rstd * wv + bv;
                        *(f32x4*)(O + off + bj * HALF + n * 16) = x1 * DN_ALPHA + acc[ai][bj][m][n];
                    }
            }
    }
};

__device__ __forceinline__ void p0_transpose_item(const float* W, int K, int N, bf16* WT, int dst_row0, int k0, int n0, LAS float* scr, int lane) {
#pragma unroll 8
    for (int i = 0; i < 32; ++i) { const int kk = 2 * i + (lane >> 5); scr[kk * 33 + (lane & 31)] = W[(size_t)(k0 + kk) * N + n0 + (lane & 31)]; }
    asm volatile("s_waitcnt lgkmcnt(0)" ::: "memory");
    const int c = lane & 7;
#pragma unroll
    for (int j = 0; j < 4; ++j) { const int n = (lane >> 3) + 8 * j; const LAS float* s = scr + (8 * c) * 33 + n;
        v4u o; o.x = pk2(s[0 * 33], s[1 * 33]); o.y = pk2(s[2 * 33], s[3 * 33]); o.z = pk2(s[4 * 33], s[5 * 33]); o.w = pk2(s[6 * 33], s[7 * 33]);
        *(v4u*)(WT + (size_t)(dst_row0 + n) * K + k0 + 8 * c) = o; }
    asm volatile("s_waitcnt lgkmcnt(0)" ::: "memory");
}

__device__ __forceinline__ void p0_prologue(Frame& F, const Args& AR) {
    LAS float* scr = (LAS float*)(F.lds + F.wave * 16384);
    const int gw = F.bid * NWAVES + F.wave, NGW = F.G * NWAVES, lane = F.lane;
    unsigned char* ws = F.ws;
    constexpr int I_IN = (1024 / 64) * (5504 / 32), I_GU = (1024 / 64) * (2816 / 32), I_D = (2816 / 64) * (1024 / 32), I_O = 16 * 32, I_HY = 8 * 32;
    constexpr int NITEMS = I_IN + 2 * I_GU + I_D + I_O + 2 * I_HY;
    for (int it = gw; it < NITEMS; it += NGW) {
        int r = it;
        if (r < I_IN) { const int nblk = 5504 / 32, kb = r / nblk, nb = r % nblk; p0_transpose_item(AR.in[1], 1024, 5504, (bf16*)(ws + WS_WIN), 32 * nb, 64 * kb, 32 * nb, scr, lane); continue; } r -= I_IN;
        if (r < 2 * I_GU) { const int up = r >= I_GU; if (up) r -= I_GU; const int nblk = 2816 / 32, kb = r / nblk, nb = r % nblk, n0 = 32 * nb;
            p0_transpose_item(AR.in[up ? 30 : 29], 1024, 2816, (bf16*)(ws + WS_WGU), (n0 >> 7) * 256 + (n0 & 127) + (up ? 128 : 0), 64 * kb, n0, scr, lane); continue; } r -= 2 * I_GU;
        if (r < I_D) { const int nblk = 32, kb = r / nblk, nb = r % nblk; p0_transpose_item(AR.in[31], 2816, 1024, (bf16*)(ws + WS_WD), 32 * nb, 64 * kb, 32 * nb, scr, lane); continue; } r -= I_D;
        if (r < I_O) { const int kb = r / 32, nb = r % 32; p0_transpose_item(AR.in[26], 1024, 1024, (bf16*)(ws + WS_WO), 32 * nb, 64 * kb, 32 * nb, scr, lane); continue; } r -= I_O;
        if (r < I_HY) { const int kb = r / 32, nb = r % 32; p0_transpose_item(AR.in[24], 512, 1024, (bf16*)(ws + WS_WHY), 32 * nb, 64 * kb, 32 * nb, scr, lane); continue; } r -= I_HY;
        { const int kb = r / 32, nb = r % 32; p0_transpose_item(AR.in[25], 512, 1024, (bf16*)(ws + WS_WRW), 32 * nb, 64 * kb, 32 * nb, scr, lane); }
    }
    const size_t gt = (size_t)F.bid * 512 + F.tid, NT = (size_t)F.G * 512;
    { v4u z = {0u, 0u, 0u, 0u}; v4u* p = (v4u*)((bf16*)(ws + WS_WIN) + (size_t)5504 * 1024); for (size_t i = gt; i < (size_t)128 * 1024 / 8; i += NT) p[i] = z; }
    { bf16* WL = (bf16*)(ws + WS_WLORA);
      for (size_t i = gt; i < (size_t)LORA_N * LORA_K; i += NT) {
          const int n = (int)(i / LORA_K), k = (int)(i % LORA_K), blk = n >> 9, c = n & 511; float v = 0.f;
          if (blk < 2) { if ((k >> 6) == blk) v = AR.in[15][((size_t)blk * 64 + (k & 63)) * 512 + c]; }
          else if (blk < 4) { if ((k >> 6) == blk) v = AR.in[17][((size_t)(blk - 2) * 64 + (k & 63)) * 512 + c]; }
          else { if (k >= 256) v = AR.in[18][(size_t)(k - 256) * 512 + c]; }
          WL[i] = (bf16)f2bf(v);
      } }
    { const f32x4* x4 = (const f32x4*)AR.in[0]; v4u* xb = (v4u*)(ws + WS_XB);
      for (size_t i = gt; i < (size_t)M * DM / 8; i += NT) { const f32x4 a = x4[2 * i], b = x4[2 * i + 1]; xb[i] = pack8(a, b); } }
    { float* H3T = (float*)(ws + WS_H3T);
      const float* fw1 = AR.in[4]; const float* fb1 = AR.in[5]; const float* fw2 = AR.in[6]; const float* fb2 = AR.in[7]; const float* fw3 = AR.in[8]; const float* fb3 = AR.in[9]; const float* sf = AR.in[11];
      for (int pos = gw; pos < SEQ; pos += NGW) {
          const float t = (float)pos / 4095.0f, wv = 6.283185307179586f * (float)pos / 4096.0f;
          float feat = 0.f;
          if (lane == 0) feat = t;
          else if (lane <= 32) { const int j = (lane - 1) & 15; const float f = 1e-4f + (float)j * ((15.0f - 1e-4f) / 15.0f); const float ang = wv * f; feat = (lane <= 16) ? cosf(ang) : -sinf(ang); }
          float z = fb1[lane];
#pragma unroll
          for (int f = 0; f < 33; ++f) z += __shfl(feat, f) * fw1[f * 64 + lane];
          float h = sinf(sf[lane] * z);
          z = fb2[lane];
#pragma unroll 8
          for (int j = 0; j < 64; ++j) z += __shfl(h, j) * fw2[j * 64 + lane];
          h = sinf(sf[64 + lane] * z);
          z = fb3[lane];
#pragma unroll 8
          for (int j = 0; j < 64; ++j) z += __shfl(h, j) * fw3[j * 64 + lane];
          h = sinf(sf[128 + lane] * z);
          H3T[lane * SEQ + pos] = h;
      } }
}

__device__ __forceinline__ void p2_prep(Frame& F, const Args& AR) {
    unsigned char* ws = F.ws; const int tid = F.tid, lane = F.lane;
    const int gw = F.bid * NWAVES + F.wave, NGW = F.G * NWAVES;
    { const bf16* PH = (const bf16*)(ws + WS_PH); bf16* HT = (bf16*)((unsigned char*)F.out + DO_HT);
      const float* cw = AR.in[2]; const float* cb = AR.in[3];
      LAS bf16* raw = (LAS bf16*)(F.lds + F.wave * 9216);
      constexpr int NIT = NB * (SEQ / 64) * (PH_P / 64);
      const int lr = lane >> 3, lc = lane & 7;
      for (int it = gw; it < NIT; it += NGW) {
          const int cbk = it % 24, tb = (it / 24) % 64, b = it / (24 * 64); const int t0 = tb * 64, c0 = cbk * 64;
          const bf16* src = PH + ((size_t)b * SEQ + t0) * PH_P + c0 + 8 * lc;
          v4u v[9];
#pragma unroll
          for (int i = 0; i < 8; ++i) v[i] = *(const v4u*)(src + (size_t)(lr + 8 * i) * PH_P);
          { const int hrow = (lane < 8) ? -1 : 64; const int t = t0 + hrow; v[8] = (v4u){0u, 0u, 0u, 0u};
            if (lane < 16 && t >= 0 && t < SEQ) v[8] = *(const v4u*)(src + (ptrdiff_t)hrow * PH_P); }
#pragma unroll
          for (int i = 0; i < 8; ++i) { LAS unsigned* d = (LAS unsigned*)(raw + (1 + lr + 8 * i) * 66 + 8 * lc); d[0] = v[i].x; d[1] = v[i].y; d[2] = v[i].z; d[3] = v[i].w; }
          if (lane < 16) { LAS unsigned* d = (LAS unsigned*)(raw + ((lane < 8) ? 0 : 65) * 66 + 8 * lc); d[0] = v[8].x; d[1] = v[8].y; d[2] = v[8].z; d[3] = v[8].w; }
          asm volatile("s_waitcnt lgkmcnt(0)" ::: "memory");
          const int col = c0 + lane;
          const float w0 = cw[col], w1 = cw[PH_P + col], w2 = cw[2 * PH_P + col], bb = cb[col];
          const int which = col >> 9, c = col & 511;
          v4u* dst = (v4u*)(HT + (((size_t)which * 512 + c) * NB + b) * SEQ + t0);
          float pv = bf2f(raw[lane]), cv = bf2f(raw[66 + lane]);
#pragma unroll
          for (int q8 = 0; q8 < 8; ++q8) {
              float o[8];
#pragma unroll
              for (int i = 0; i < 8; ++i) { const float nv = bf2f(raw[(8 * q8 + i + 2) * 66 + lane]); o[i] = w0 * pv + w1 * cv + w2 * nv + bb; pv = cv; cv = nv; }
              v4u w; w.x = pk2(o[0], o[1]); w.y = pk2(o[2], o[3]); w.z = pk2(o[4], o[5]); w.w = pk2(o[6], o[7]);
              dst[q8] = w;
          }
          asm volatile("s_waitcnt lgkmcnt(0)" ::: "memory");
      }
    }
    const size_t gt = (size_t)F.bid * 512 + tid, NT = (size_t)F.G * 512;
    { const bf16* PR = (const bf16*)(ws + WS_PR); bf16* LIN = (bf16*)(ws + WS_TOP); const float* mu = AR.in[13];
      for (size_t i = gt; i < (size_t)M * 96; i += NT) {
          const int m = (int)(i / 96), cg4 = (int)(i % 96), t = m & (SEQ - 1); const int col = 1536 + 4 * cg4;
          const bf16* p = PR + (size_t)m * PR_P + col;
          const v2u c = *(const v2u*)p; v2u pv = {0u, 0u}, nv = {0u, 0u};
          if (t > 0) pv = *(const v2u*)(p - PR_P);
          if (t < SEQ - 1) nv = *(const v2u*)(p + PR_P);
          const f32x4 muv = *(const f32x4*)(mu + col);
          float u[4], pr[4], nx[4];
          u[0] = bflo(c.x); u[1] = bfhi(c.x); u[2] = bflo(c.y); u[3] = bfhi(c.y);
          pr[0] = bflo(pv.x); pr[1] = bfhi(pv.x); pr[2] = bflo(pv.y); pr[3] = bfhi(pv.y);
          nx[0] = bflo(nv.x); nx[1] = bfhi(nv.x); nx[2] = bflo(nv.y); nx[3] = bfhi(nv.y);
#pragma unroll
          for (int j = 0; j < 4; ++j) { float sft = u[j] + muv[j] * (0.5f * (pr[j] + nx[j]) - u[j]);
              if (cg4 < 32) sft = 2.0f * fsig(2.0f * sft) - 1.0f; else if (cg4 >= 64) sft = fsig(sft); u[j] = sft; }
          v2u o; o.x = pk2(u[0], u[1]); o.y = pk2(u[2], u[3]);
          *(v2u*)(LIN + (size_t)m * LORA_K + 4 * cg4) = o;
      } }
    { const float* H3T = (const float*)(ws + WS_H3T); const float* fw4 = AR.in[10]; const float* skip = AR.in[12];
      bf16* FT = (bf16*)(ws + WS_FT);
      for (int it = gw; it < 64 * 128; it += NGW) {
          const int pb = it & 63, cb8 = it >> 6; const int o = cb8 >> 6, c0 = (cb8 & 63) * 8;
          const int pos = pb * 64 + lane;
          float hf[8], hb[8];
#pragma unroll
          for (int e = 0; e < 8; ++e) { hf[e] = 0.f; hb[e] = 0.f; }
          const float* wrow = fw4 + o * 1024 + c0;
#pragma unroll 4
          for (int j = 0; j < 64; ++j) {
              const float hv = H3T[j * SEQ + pos];
              const f32x4 a0 = *(const f32x4*)(wrow + (size_t)j * 2048), a1 = *(const f32x4*)(wrow + (size_t)j * 2048 + 4);
              const f32x4 b0 = *(const f32x4*)(wrow + (size_t)j * 2048 + 512), b1 = *(const f32x4*)(wrow + (size_t)j * 2048 + 516);
#pragma unroll
              for (int e = 0; e < 4; ++e) { hf[e] += hv * a0[e]; hf[4 + e] += hv * a1[e]; hb[e] += hv * b0[e]; hb[4 + e] += hv * b1[e]; }
          }
          const float tpos = (float)pos / 4095.0f;
#pragma unroll
          for (int e = 0; e < 8; ++e) {
              const int c = c0 + e;
              const float delta = fabsf(HY_MIN_DECAY + (float)c * ((HY_MAX_DECAY - HY_MIN_DECAY) / 511.0f));
              bf16* TE = FT + (size_t)(o * 512 + c) * 16384; bf16* TO = TE + 8192;
              const float win = expf(-tpos * delta);
              if (pos == 0) { const bf16 v = (bf16)f2bf(hf[e] + hb[e] + skip[o * 512 + c]); TE[2 * 2048] = v; TO[2 * 2048 + 1] = v; TE[0] = 0; TE[1] = 0; TO[1] = 0; }
              else {
                  const bf16 vf = (bf16)f2bf(hf[e] * win), vb = (bf16)f2bf(hb[e] * win);
                  { const int d = pos, n = d >> 1;
                    if (d & 1) { TO[2 * (n + 2048)] = vf; if (n + 1 + 2048 < 4096) TE[2 * (n + 1 + 2048) + 1] = vf; }
                    else { TE[2 * (n + 2048)] = vf; TO[2 * (n + 2048) + 1] = vf; } }
                  { const int d = -pos, n = d >> 1;
                    if (d & 1) { TO[2 * (n + 2048)] = vb; TE[2 * (n + 1 + 2048) + 1] = vb; }
                    else { TE[2 * (n + 2048)] = vb; TO[2 * (n + 2048) + 1] = vb; } }
              }
          }
      } }
}

constexpr int HL_TE = 0, HL_TO = 16384 + 64, HL_Z = 32896, HZ_ROW = 80, HZ_PAD = 24;

__device__ __forceinline__ void hyena_item(Frame& F, const Args& AR, int c, bool dry) {
    LAS unsigned char* lds = F.lds; const int tid = F.tid, lane = F.lane, wave = F.wave;
    bf16* HT = (bf16*)((unsigned char*)F.out + DO_HT);
    const bf16* FT = (const bf16*)(F.ws + WS_FT);
    const int r = lane & 31, h = lane >> 5, par = r & 1;
    __syncthreads();
    if (tid < 240) { const int rr = tid / 5, ch = tid % 5; const int row = rr < 24 ? rr : 1024 + rr; v4u z = {0u, 0u, 0u, 0u}; *(LAS v4u*)(lds + HL_Z + row * HZ_ROW + 16 * ch) = z; }
    { const v4u* src = (const v4u*)(HT + ((size_t)0 * 512 + c) * NB * SEQ);
#pragma unroll
      for (int it = 0; it < 8; ++it) { const int rem = tid; const v4u v = src[it * 512 + rem];
          *(LAS v4u*)(lds + HL_Z + (((rem >> 2) * 8 + it) + HZ_PAD) * HZ_ROW + (rem & 3) * 16) = v; } }
#pragma unroll 1
    for (int o = 0; o < 2; ++o) {
        { const v4u* src = (const v4u*)(FT + ((size_t)o * 512 + c) * 16384);
#pragma unroll
          for (int it = 0; it < 4; ++it) { const int e = it * 512 + tid; const v4u v = src[e]; *(LAS v4u*)(lds + (e < 1024 ? HL_TE + e * 16 : HL_TO + (e - 1024) * 16)) = v; } }
        __syncthreads();
        f32x16 acc[4];
#pragma unroll
        for (int nn = 0; nn < 4; ++nn)
#pragma unroll
            for (int j = 0; j < 16; ++j) acc[nn][j] = 0.f;
        const LAS unsigned* T = (const LAS unsigned*)(lds + (par ? HL_TO : HL_TE));
        const int nb0 = 4 * wave;
#pragma unroll 1
        for (int q = 16 * wave - 127; q <= 16 * wave + 15; ++q) {
#pragma unroll
            for (int jh = 0; jh < 2; ++jh) {
                const int base = 32 * q + r - 16 * jh - 8 * h;
                const int n0 = ((base - par) >> 1) + 2048;
                v4u av; av.x = T[n0]; av.y = T[n0 - 1]; av.z = T[n0 - 2]; av.w = T[n0 - 3];
                const bf16x8 A = __builtin_bit_cast(bf16x8, av);
#pragma unroll
                for (int nn = 0; nn < 4; ++nn) {
                    const int n = nb0 + nn;
                    if (q >= 4 * n - 127 && q <= 4 * n + 3) {
                        const int row = 32 * n + r - 8 * q + HZ_PAD;
                        const bf16x8 Bf = *(const LAS bf16x8*)(lds + HL_Z + row * HZ_ROW + 32 * jh + 16 * h);
                        acc[nn] = __builtin_amdgcn_mfma_f32_32x32x16_bf16(A, Bf, acc[nn], 0, 0, 0);
                    }
                }
            }
        }
        __syncthreads();
        const bf16* XG = HT + ((size_t)(1 + o) * 512 + c) * NB * SEQ;
#pragma unroll
        for (int nn = 0; nn < 4; ++nn) {
            const int colg = 32 * (nb0 + nn) + r, tb = colg >> 3, b = colg & 7;
#pragma unroll
            for (int g = 0; g < 4; ++g) {
                const int i0 = 8 * g + 4 * h;
                const v2u xv = *(const v2u*)(XG + (size_t)b * SEQ + 32 * tb + i0);
                v2u w; w.x = pk2(acc[nn][4 * g + 0] * bflo(xv.x), acc[nn][4 * g + 1] * bfhi(xv.x)); w.y = pk2(acc[nn][4 * g + 2] * bflo(xv.y), acc[nn][4 * g + 3] * bfhi(xv.y));
                *(LAS v2u*)(lds + HL_Z + (colg + HZ_PAD) * HZ_ROW + i0 * 2) = w;
            }
        }
        __syncthreads();
    }
    if (!dry) { v4u* dst = (v4u*)(HT + ((size_t)0 * 512 + c) * NB * SEQ);
#pragma unroll
      for (int it = 0; it < 8; ++it) { const int rem = tid; dst[it * 512 + rem] = *(const LAS v4u*)(lds + HL_Z + (((rem >> 2) * 8 + it) + HZ_PAD) * HZ_ROW + (rem & 3) * 16); } }
}

constexpr int SC_SLOT = 464;
template <int CTRL> __device__ __forceinline__ float dppf(float x) { return __builtin_bit_cast(float, __builtin_amdgcn_update_dpp(0, __builtin_bit_cast(int, x), CTRL, 0xf, 0xf, true)); }
__device__ __forceinline__ float xsum16(float x) { float a = x, b = x; asm volatile("s_nop 1\n\tv_permlane16_swap_b32 %0, %1" : "+v"(a), "+v"(b)); return a + b; }
__device__ __forceinline__ float xsum32(float x) { float a = x, b = x; asm volatile("s_nop 1\n\tv_permlane32_swap_b32 %0, %1" : "+v"(a), "+v"(b)); return a + b; }
__device__ __forceinline__ float allsum4(const float (&p)[4], bool b0, bool b1) {
    const float m0 = b0 ? p[1] : p[0], g0 = b0 ? p[0] : p[1], m1 = b0 ? p[3] : p[2], g1 = b0 ? p[2] : p[3];
    const float q0 = m0 + dppf<0xB1>(g0), q1 = m1 + dppf<0xB1>(g1);
    const float mm = b1 ? q1 : q0, gg = b1 ? q0 : q1;
    float q = mm + dppf<0x4E>(gg);
    q += dppf<0x124>(q);
    q += dppf<0x128>(q);
    q = xsum16(q);
    q = xsum32(q);
    return q;
}
__device__ __forceinline__ float wave_allsum(float q) {
    q += dppf<0xB1>(q); q += dppf<0x4E>(q); q += dppf<0x124>(q); q += dppf<0x128>(q); q = xsum16(q); q = xsum32(q); return q;
}
constexpr int SC_YOFF = 16 * SC_SLOT;
struct ScanRaw { unsigned rc, kc, vc, rp, kp, vp, rn, kn, vn, wd, ad; };
__device__ __forceinline__ void rwkv_scan(Frame& F, const Args& AR, int bid) {
    const int seq = (bid & 7) + 8 * (bid >> 4), half = (bid >> 3) & 1;
    const int dir = seq >> 6, b = (seq >> 3) & 7, h = seq & 7, lane = F.lane, wave = F.wave, tid = F.tid;
    LAS float* ring = (LAS float*)F.lds;
    const int ch = h * 64 + lane, rbase = 32 * half + 4 * wave;
    const float* mu = AR.in[13];
    const float mu_r = mu[ch], mu_k = mu[512 + ch], mu_v = mu[1024 + ch];
    const float kk_c = AR.in[19][ch], ka_c = AR.in[20][ch], rk_c = AR.in[21][ch];
    const float w0_c = AR.in[14][dir * 512 + ch], a0_c = AR.in[16][dir * 512 + ch];
    const bf16* PRb = (const bf16*)(F.ws + WS_PR) + (size_t)b * SEQ * PR_P + ch;
    const bf16* Wd = (const bf16*)(F.ws + WS_LW) + (size_t)dir * ((size_t)M * 512) + (size_t)b * SEQ * 512 + ch;
    const bf16* Ad = (const bf16*)(F.ws + WS_LW) + (size_t)(2 + dir) * ((size_t)M * 512) + (size_t)b * SEQ * 512 + ch;
    bf16* YS = dir ? (bf16*)(F.ws + WS_TOP) : (bf16*)((unsigned char*)F.out + DO_YSF);
    YS += (size_t)b * SEQ * 512 + h * 64 + 32 * half;
    float* BON = (float*)(F.ws + WS_BONUS) + ((size_t)dir * M + (size_t)b * SEQ) * 8;
    float S[4];
#pragma unroll
    for (int i = 0; i < 4; ++i) S[i] = 0.f;
    const bool b0 = (lane & 1) != 0, b1 = (lane & 2) != 0;
    ScanRaw R;
#define SC_LOAD(jj) do { const int s_ = 8 * (jj) + wave, tau_ = dir ? SEQ - 1 - s_ : s_; const bf16* row_ = PRb + (size_t)tau_ * PR_P; \
        const int up_ = tau_ > 0 ? -PR_P : 0, dn_ = tau_ < SEQ - 1 ? PR_P : 0; \
        R.rc = row_[0]; R.kc = row_[512]; R.vc = row_[1024]; R.rp = row_[up_]; R.kp = row_[512 + up_]; R.vp = row_[1024 + up_]; \
        R.rn = row_[dn_]; R.kn = row_[512 + dn_]; R.vn = row_[1024 + dn_]; R.wd = Wd[(size_t)tau_ * 512]; R.ad = Ad[(size_t)tau_ * 512]; } while (0)
    SC_LOAD(0);
    __syncthreads();
#pragma unroll 1
    for (int j = 0; j < SEQ / 8; ++j) {
        {
            const int s = 8 * j + wave, tau = dir ? SEQ - 1 - s : s;
            const float rc = bf2f(R.rc), kc = bf2f(R.kc), vc = bf2f(R.vc);
            const float pm = tau > 0 ? 1.f : 0.f, nm = tau < SEQ - 1 ? 1.f : 0.f;
            const float rp = pm * bf2f(R.rp), kp = pm * bf2f(R.kp), vp = pm * bf2f(R.vp), rn = nm * bf2f(R.rn), kn = nm * bf2f(R.kn), vn = nm * bf2f(R.vn);
            const float rr = rc + mu_r * (0.5f * (rp + rn) - rc), kx = kc + mu_k * (0.5f * (kp + kn) - kc), vx = vc + mu_v * (0.5f * (vp + vn) - vc);
            const float wv = __expf(-0.60653065971f * sigmoidf_(w0_c + bf2f(R.wd))), av = sigmoidf_(a0_c + bf2f(R.ad));
            const float kkr = kx * kk_c; const float ss = wave_allsum(kkr * kkr); const float kk = kkr / fmaxf(sqrtf(ss), 1e-12f);
            const float kd = kx * (1.0f + (av - 1.0f) * ka_c), kka = kk * av;
            const float c2 = wave_allsum(rr * kd), c1 = wave_allsum(rr * kka);
            const float bon = wave_allsum(rr * kd * rk_c);
            LAS float* sl = ring + ((j & 1) * 8 + wave) * SC_SLOT;
            sl[lane] = -kk; sl[64 + lane] = wv; sl[128 + lane] = kka; sl[192 + lane] = kd; sl[256 + lane] = wv * rr; sl[320 + lane] = vx; sl[384 + lane] = vx * c2;
            if (lane == 0) sl[448] = c1;
            if (lane == 0 && half == 0) BON[(size_t)tau * 8 + h] = bon;
        }
        if (j + 1 < SEQ / 8) SC_LOAD(j + 1);
        __syncthreads();
        if (j > 0 && tid < 256) {
            const int u = tid >> 5, rrow = tid & 31, s = 8 * (j - 1) + u, tau = dir ? SEQ - 1 - s : s;
            YS[(size_t)tau * 512 + rrow] = (bf16)f2bf(ring[SC_YOFF + (((j - 1) & 1) * 8 + u) * 32 + rrow]);
        }
        {
            const LAS float* sl0 = ring + ((j & 1) * 8) * SC_SLOT;
            float nkk = sl0[lane], w = sl0[64 + lane], kka = sl0[128 + lane], kd = sl0[192 + lane], wr = sl0[256 + lane], vc2 = sl0[384 + rbase + (lane & 3)], c1 = sl0[448];
            f32x4 va = *(const LAS f32x4*)(sl0 + 320 + rbase);
#pragma unroll
            for (int u = 0; u < 8; ++u) {
                float nkk_n = 0.f, w_n = 0.f, kka_n = 0.f, kd_n = 0.f, wr_n = 0.f, vc2_n = 0.f, c1_n = 0.f; f32x4 va_n = {0.f, 0.f, 0.f, 0.f};
                if (u < 7) { const LAS float* sl = sl0 + (u + 1) * SC_SLOT;
                    nkk_n = sl[lane]; w_n = sl[64 + lane]; kka_n = sl[128 + lane]; kd_n = sl[192 + lane]; wr_n = sl[256 + lane]; vc2_n = sl[384 + rbase + (lane & 3)]; c1_n = sl[448];
                    va_n = *(const LAS f32x4*)(sl + 320 + rbase); }
                float p[4], pp[4];
#pragma unroll
                for (int i = 0; i < 4; ++i) { p[i] = S[i] * nkk; pp[i] = S[i] * wr; }
                const float q = allsum4(p, b0, b1);
                const float qy = allsum4(pp, b0, b1);
                const float sa[4] = {dppf<0x00>(q), dppf<0x55>(q), dppf<0xAA>(q), dppf<0xFF>(q)};
#pragma unroll
                for (int i = 0; i < 4; ++i) S[i] = S[i] * w + (sa[i] * kka + va[i] * kd);
                const float y = qy + (q * c1 + vc2);
                if (lane < 4) ring[SC_YOFF + ((j & 1) * 8 + u) * 32 + 4 * wave + lane] = y;
                nkk = nkk_n; w = w_n; kka = kka_n; kd = kd_n; wr = wr_n; vc2 = vc2_n; c1 = c1_n; va = va_n;
            }
        }
    }
    __syncthreads();
    if (tid < 256) { const int j = SEQ / 8; const int u = tid >> 5, rrow = tid & 31, s = 8 * (j - 1) + u, tau = dir ? SEQ - 1 - s : s;
        YS[(size_t)tau * 512 + rrow] = (bf16)f2bf(ring[SC_YOFF + (((j - 1) & 1) * 8 + u) * 32 + rrow]); }
#undef SC_LOAD
}

constexpr int S2_W = 0, S2_KKA = 64, S2_KD = 128, S2_VX = 192, S2_C = 256, S2_NKKB = 260, S2_WRB = 292, S2_ZB = 324, S2_SLOT = 368;
constexpr int S2_YOFF = 16 * S2_SLOT;
__device__ __forceinline__ void rwkv_scan2(Frame& F, const Args& AR, int seq) {
    const int dir = seq >> 6, b = (seq >> 3) & 7, h = seq & 7, lane = F.lane, wave = F.wave, tid = F.tid;
    LAS float* ring = (LAS float*)F.lds;
    bf16* YS = dir ? (bf16*)(F.ws + WS_TOP) : (bf16*)((unsigned char*)F.out + DO_YSF);
    YS += (size_t)b * SEQ * 512 + h * 64;
    __syncthreads();
    for (int i = tid; i < 16 * 32; i += 512) ring[(i >> 5) * S2_SLOT + S2_ZB + (i & 31)] = 0.f;
    constexpr int NBLK = SEQ / 8;
    if (wave >= 4) {
        const int p = wave - 4, ch = h * 64 + lane;
        const float* mu = AR.in[13];
        const float mu_r = mu[ch], mu_k = mu[512 + ch], mu_v = mu[1024 + ch];
        const float kk_c = AR.in[19][ch], ka_c = AR.in[20][ch], rk_c = AR.in[21][ch];
        const float w0_c = AR.in[14][dir * 512 + ch], a0_c = AR.in[16][dir * 512 + ch];
        const bf16* PRb = (const bf16*)(F.ws + WS_PR) + (size_t)b * SEQ * PR_P + ch;
        const bf16* Wd = (const bf16*)(F.ws + WS_LW) + (size_t)dir * ((size_t)M * 512) + (size_t)b * SEQ * 512 + ch;
        const bf16* Ad = (const bf16*)(F.ws + WS_LW) + (size_t)(2 + dir) * ((size_t)M * 512) + (size_t)b * SEQ * 512 + ch;
        float* BON = (float*)(F.ws + WS_BONUS) + ((size_t)dir * M + (size_t)b * SEQ) * 8;
        ScanRaw R[2];
#define S2_LOAD(jj) do { _Pragma("unroll") for (int e_ = 0; e_ < 2; ++e_) { const int s_ = 8 * (jj) + p + 4 * e_, tau_ = dir ? SEQ - 1 - s_ : s_; const bf16* row_ = PRb + (size_t)tau_ * PR_P; \
            const int up_ = tau_ > 0 ? -PR_P : 0, dn_ = tau_ < SEQ - 1 ? PR_P : 0; \
            R[e_].rc = row_[0]; R[e_].kc = row_[512]; R[e_].vc = row_[1024]; R[e_].rp = row_[up_]; R[e_].kp = row_[512 + up_]; R[e_].vp = row_[1024 + up_]; \
            R[e_].rn = row_[dn_]; R[e_].kn = row_[512 + dn_]; R[e_].vn = row_[1024 + dn_]; R[e_].wd = Wd[(size_t)tau_ * 512]; R[e_].ad = Ad[(size_t)tau_ * 512]; } } while (0)
#define S2_PRODUCE(jj) do { _Pragma("unroll") for (int e_ = 0; e_ < 2; ++e_) { const int u_ = p + 4 * e_, s_ = 8 * (jj) + u_, tau_ = dir ? SEQ - 1 - s_ : s_; \
            const float rc = bf2f(R[e_].rc), kc = bf2f(R[e_].kc), vc = bf2f(R[e_].vc); \
            const float pm = tau_ > 0 ? 1.f : 0.f, nm = tau_ < SEQ - 1 ? 1.f : 0.f; \
            const float rp = pm * bf2f(R[e_].rp), kp = pm * bf2f(R[e_].kp), vp = pm * bf2f(R[e_].vp), rn = nm * bf2f(R[e_].rn), kn = nm * bf2f(R[e_].kn), vn = nm * bf2f(R[e_].vn); \
            const float rr = rc + mu_r * (0.5f * (rp + rn) - rc), kx = kc + mu_k * (0.5f * (kp + kn) - kc), vx = vc + mu_v * (0.5f * (vp + vn) - vc); \
            const float wv = __expf(-0.60653065971f * fsig(w0_c + bf2f(R[e_].wd))), av = fsig(a0_c + bf2f(R[e_].ad)); \
            const float kkr = kx * kk_c, kd = kx * (1.0f + (av - 1.0f) * ka_c), rkd = rr * kd; \
            const float ps_[4] = {kkr * kkr, rr * kkr * av, rkd, rkd * rk_c}; \
            const float tot_ = allsum4(ps_, (lane & 1) != 0, (lane & 2) != 0); \
            const float ss = dppf<0x00>(tot_), c1r = dppf<0x55>(tot_), c2 = dppf<0xAA>(tot_), bon = dppf<0xFF>(tot_); \
            const float rn_ = __builtin_amdgcn_rsqf(fmaxf(ss, 1e-24f)); const float kk = kkr * rn_, kka = kk * av, c1 = c1r * rn_; \
            LAS float* sl = ring + (((jj) & 1) * 8 + u_) * S2_SLOT; \
            sl[S2_W + lane] = wv; sl[S2_KKA + lane] = kka; sl[S2_KD + lane] = kd; sl[S2_VX + lane] = vx; \
            ((LAS bf16*)(sl + S2_NKKB))[lane] = (bf16)f2bf(-kk); ((LAS bf16*)(sl + S2_WRB))[lane] = (bf16)f2bf(wv * rr); \
            if (lane == 0) { sl[S2_C] = c1; sl[S2_C + 1] = c2; BON[(size_t)tau_ * 8 + h] = bon; } } } while (0)
        S2_LOAD(0); S2_PRODUCE(0); S2_LOAD(1);
        __syncthreads();
#pragma unroll 1
        for (int j = 0; j < NBLK; ++j) {
            if (j + 1 < NBLK) { S2_PRODUCE(j + 1); if (j + 2 < NBLK) S2_LOAD(j + 2); }
            if (j > 0) {
                const int pt = tid - 256;
#pragma unroll
                for (int e = 0; e < 2; ++e) { const int idx = pt + 256 * e, u = idx >> 6, rrow = idx & 63, s = 8 * (j - 1) + u, tau = dir ? SEQ - 1 - s : s;
                    YS[(size_t)tau * 512 + rrow] = (bf16)f2bf(ring[S2_YOFF + (((j - 1) & 1) * 8 + u) * 64 + rrow]); }
            }
            __syncthreads();
        }
        { const int j = NBLK; const int pt = tid - 256;
#pragma unroll
          for (int e = 0; e < 2; ++e) { const int idx = pt + 256 * e, u = idx >> 6, rrow = idx & 63, s = 8 * (j - 1) + u, tau = dir ? SEQ - 1 - s : s;
              YS[(size_t)tau * 512 + rrow] = (bf16)f2bf(ring[S2_YOFF + (((j - 1) & 1) * 8 + u) * 64 + rrow]); } }
#undef S2_LOAD
#undef S2_PRODUCE
    } else {
        const int c = lane & 15, g = lane >> 4, row = 16 * wave + c;
        const int aoff = (((c & 3) == 0) ? S2_NKKB : ((c & 3) == 1) ? S2_WRB : S2_ZB) * 4 + (((c & 3) < 2) ? 16 * g : 0);
        const int aoff1 = aoff + (((c & 3) < 2) ? 64 : 0);
        float S[16];
#pragma unroll
        for (int i = 0; i < 16; ++i) S[i] = 0.f;
        __syncthreads();
#pragma unroll 1
        for (int j = 0; j < NBLK; ++j) {
            const LAS float* sl0 = ring + ((j & 1) * 8) * S2_SLOT;
            f32x4 w4[4], ka4[4], kd4[4]; bf16x8 A0, A1; float vv, c1, c2;
#define S2_CLOAD(sl) do { const LAS float* sl_ = (sl); \
            w4[0] = *(const LAS f32x4*)(sl_ + S2_W + 8 * g); w4[1] = *(const LAS f32x4*)(sl_ + S2_W + 8 * g + 4); w4[2] = *(const LAS f32x4*)(sl_ + S2_W + 32 + 8 * g); w4[3] = *(const LAS f32x4*)(sl_ + S2_W + 36 + 8 * g); \
            ka4[0] = *(const LAS f32x4*)(sl_ + S2_KKA + 8 * g); ka4[1] = *(const LAS f32x4*)(sl_ + S2_KKA + 8 * g + 4); ka4[2] = *(const LAS f32x4*)(sl_ + S2_KKA + 32 + 8 * g); ka4[3] = *(const LAS f32x4*)(sl_ + S2_KKA + 36 + 8 * g); \
            kd4[0] = *(const LAS f32x4*)(sl_ + S2_KD + 8 * g); kd4[1] = *(const LAS f32x4*)(sl_ + S2_KD + 8 * g + 4); kd4[2] = *(const LAS f32x4*)(sl_ + S2_KD + 32 + 8 * g); kd4[3] = *(const LAS f32x4*)(sl_ + S2_KD + 36 + 8 * g); \
            A0 = *(const LAS bf16x8*)((const LAS unsigned char*)sl_ + aoff); A1 = *(const LAS bf16x8*)((const LAS unsigned char*)sl_ + aoff1); \
            vv = sl_[S2_VX + row]; c1 = sl_[S2_C]; c2 = sl_[S2_C + 1]; } while (0)
            S2_CLOAD(sl0);
#pragma unroll
            for (int u = 0; u < 8; ++u) {
                const f32x4 cw0 = w4[0], cw1 = w4[1], cw2 = w4[2], cw3 = w4[3], ca0 = ka4[0], ca1 = ka4[1], ca2 = ka4[2], ca3 = ka4[3], cd0 = kd4[0], cd1 = kd4[1], cd2 = kd4[2], cd3 = kd4[3];
                const bf16x8 cA0 = A0, cA1 = A1; const float cvv = vv, cc1 = c1, cc2 = c2;
                if (u < 7) S2_CLOAD(sl0 + (u + 1) * S2_SLOT);
                v4u b0v, b1v;
                b0v.x = cvt_pk_bf16(S[0], S[1]); b0v.y = cvt_pk_bf16(S[2], S[3]); b0v.z = cvt_pk_bf16(S[4], S[5]); b0v.w = cvt_pk_bf16(S[6], S[7]);
                b1v.x = cvt_pk_bf16(S[8], S[9]); b1v.y = cvt_pk_bf16(S[10], S[11]); b1v.z = cvt_pk_bf16(S[12], S[13]); b1v.w = cvt_pk_bf16(S[14], S[15]);
                const f32x4 zz = {0.f, 0.f, 0.f, 0.f};
                const f32x4 acc0 = __builtin_amdgcn_mfma_f32_16x16x32_bf16(cA0, __builtin_bit_cast(bf16x8, b0v), zz, 0, 0, 0);
                const f32x4 acc1 = __builtin_amdgcn_mfma_f32_16x16x32_bf16(cA1, __builtin_bit_cast(bf16x8, b1v), zz, 0, 0, 0);
                float t[16];
#pragma unroll
                for (int i = 0; i < 4; ++i) {
                    t[i] = S[i] * cw0[i] + cvv * cd0[i]; t[4 + i] = S[4 + i] * cw1[i] + cvv * cd1[i];
                    t[8 + i] = S[8 + i] * cw2[i] + cvv * cd2[i]; t[12 + i] = S[12 + i] * cw3[i] + cvv * cd3[i];
                }
                const float sa = acc0[0] + acc1[0], yp = acc0[1] + acc1[1];
#pragma unroll
                for (int i = 0; i < 4; ++i) {
                    S[i] = sa * ca0[i] + t[i]; S[4 + i] = sa * ca1[i] + t[4 + i]; S[8 + i] = sa * ca2[i] + t[8 + i]; S[12 + i] = sa * ca3[i] + t[12 + i];
                }
                const float y = yp + (sa * cc1 + cvv * cc2);
                if (g == 0) ring[S2_YOFF + ((j & 1) * 8 + u) * 64 + row] = y;
            }
            __syncthreads();
        }
#undef S2_CLOAD
    }
    __syncthreads();
}

__device__ __forceinline__ void p4_mixers(Frame& F, const Args& AR, bool do_scan, bool do_hy, bool dry) {
    if (F.bid < 128) { if (do_scan) rwkv_scan2(F, AR, F.bid); }
    else if (do_hy) { for (int c = F.bid - 128; c < 512; c += F.G - 128) hyena_item(F, AR, c, dry); }
}

__device__ __forceinline__ float row16_allsum(float q) { q += dppf<0xB1>(q); q += dppf<0x4E>(q); q += dppf<0x124>(q); q += dppf<0x128>(q); return q; }
__device__ __forceinline__ void p5_combine(Frame& F, const Args& AR, bool dry) {
    unsigned char* ws = F.ws; const int lane = F.lane;
    const int gw = F.bid * NWAVES + F.wave, NGW = F.G * NWAVES;
    {
      bf16* YSF = (bf16*)((unsigned char*)F.out + DO_YSF); const bf16* YSB = (const bf16*)(ws + WS_TOP);
      const bf16* PR = (const bf16*)(ws + WS_PR); const bf16* Gt = (const bf16*)(ws + WS_LW) + (size_t)4 * ((size_t)M * 512);
      const float* BON = (const float*)(ws + WS_BONUS);
      const int hh = gw & 1, ch0 = 256 * hh + 4 * lane, head = 4 * hh + (lane >> 4);
      const f32x4 gnw = *(const f32x4*)(AR.in[22] + ch0), gnb = *(const f32x4*)(AR.in[23] + ch0), muv = *(const f32x4*)(AR.in[13] + 1024 + ch0);
      for (int it0 = gw; it0 < 2 * M; it0 += 2 * NGW) {
          v2u yf[2], yb[2], gg[2], vc[2], vp[2], vn[2]; float bon[2];
#pragma unroll
          for (int e = 0; e < 2; ++e) { const int m = (it0 + e * NGW) >> 1, t = m & (SEQ - 1);
              yf[e] = *(const v2u*)(YSF + (size_t)m * 512 + ch0); yb[e] = *(const v2u*)(YSB + (size_t)m * 512 + ch0); gg[e] = *(const v2u*)(Gt + (size_t)m * 512 + ch0);
              const bf16* p = PR + (size_t)m * PR_P + 1024 + ch0; vc[e] = *(const v2u*)p;
              vp[e] = *(const v2u*)(p - (t > 0 ? PR_P : 0)); vn[e] = *(const v2u*)(p + (t < SEQ - 1 ? PR_P : 0));
              bon[e] = BON[(size_t)m * 8 + head] + BON[((size_t)M + m) * 8 + head]; }
#pragma unroll
          for (int e = 0; e < 2; ++e) { const int m = (it0 + e * NGW) >> 1, t = m & (SEQ - 1);
              const float pm = t > 0 ? 1.f : 0.f, nm = t < SEQ - 1 ? 1.f : 0.f;
              float y[4] = {bflo(yf[e].x) + bflo(yb[e].x), bfhi(yf[e].x) + bfhi(yb[e].x), bflo(yf[e].y) + bflo(yb[e].y), bfhi(yf[e].y) + bfhi(yb[e].y)};
              const float mean = row16_allsum((y[0] + y[1]) + (y[2] + y[3])) * (1.0f / 64.0f);
#pragma unroll
              for (int i = 0; i < 4; ++i) y[i] -= mean;
              const float var = row16_allsum((y[0] * y[0] + y[1] * y[1]) + (y[2] * y[2] + y[3] * y[3])) * (1.0f / 64.0f);
              const float rs = rsqrtf(var + GN_EPS);
              const float vcur[4] = {bflo(vc[e].x), bfhi(vc[e].x), bflo(vc[e].y), bfhi(vc[e].y)};
              const float vprv[4] = {bflo(vp[e].x), bfhi(vp[e].x), bflo(vp[e].y), bfhi(vp[e].y)};
              const float vnxt[4] = {bflo(vn[e].x), bfhi(vn[e].x), bflo(vn[e].y), bfhi(vn[e].y)};
              const float gv[4] = {bflo(gg[e].x), bfhi(gg[e].x), bflo(gg[e].y), bfhi(gg[e].y)};
              float o[4];
#pragma unroll
              for (int i = 0; i < 4; ++i) { const float vx = vcur[i] + muv[i] * (0.5f * (pm * vprv[i] + nm * vnxt[i]) - vcur[i]);
                  o[i] = (y[i] * rs * gnw[i] + gnb[i] + bon[e] * vx) * gv[i]; }
              v2u w; w.x = pk2(o[0], o[1]); w.y = pk2(o[2], o[3]);
              if (!dry) *(v2u*)(YSF + (size_t)m * 512 + ch0) = w; }
      } }
    { const bf16* ZHT = (const bf16*)((unsigned char*)F.out + DO_HT); bf16* ZH = (bf16*)(ws + WS_ZH);
      LAS bf16* tile = (LAS bf16*)(F.lds + F.wave * 9216);
      const int lr = lane >> 3, lc = lane & 7;
      for (int it = gw; it < 8 * NB * 64; it += NGW) {
          const int tb = it & 63, b = (it >> 6) & 7, cbk = it >> 9; const int t0 = tb * 64, c0 = cbk * 64;
          v4u v[8];
#pragma unroll
          for (int i = 0; i < 8; ++i) v[i] = *(const v4u*)(ZHT + ((size_t)(c0 + lr + 8 * i) * NB + b) * SEQ + t0 + 8 * lc);
#pragma unroll
          for (int i = 0; i < 8; ++i) { LAS unsigned* d = (LAS unsigned*)(tile + (lr + 8 * i) * 66 + 8 * lc); d[0] = v[i].x; d[1] = v[i].y; d[2] = v[i].z; d[3] = v[i].w; }
          asm volatile("s_waitcnt lgkmcnt(0)" ::: "memory");
#pragma unroll
          for (int i = 0; i < 8; ++i) { const int tl = lr + 8 * i; unsigned e[8];
#pragma unroll
              for (int k = 0; k < 8; ++k) e[k] = tile[(8 * lc + k) * 66 + tl];
              v4u w; w.x = e[0] | (e[1] << 16); w.y = e[2] | (e[3] << 16); w.z = e[4] | (e[5] << 16); w.w = e[6] | (e[7] << 16);
              *(v4u*)(ZH + ((size_t)b * SEQ + t0 + tl) * 512 + c0 + 8 * lc) = w; }
          asm volatile("s_waitcnt lgkmcnt(0)" ::: "memory");
      }
    }
}

__device__ __forceinline__ void ln1_pass(Frame& F, const Args& AR) {
    const int gw = F.bid * NWAVES + F.wave, NGW = F.G * NWAVES, lane = F.lane;
    const float* H1 = (const float*)(F.ws + WS_H1); float* ST = (float*)(F.ws + WS_STATS); bf16* X1B = (bf16*)(F.ws + WS_X1B);
    const f32x4* w4 = (const f32x4*)AR.in[27]; const f32x4* b4 = (const f32x4*)AR.in[28];
    for (int m = gw; m < M; m += NGW) {
        const f32x4* xr = (const f32x4*)(H1 + (size_t)m * DM) + lane;
        f32x4 v[4]; float s = 0.f;
#pragma unroll
        for (int j = 0; j < 4; ++j) { v[j] = xr[64 * j]; s += (v[j].x + v[j].y) + (v[j].z + v[j].w); }
        const float mean = wave_sum(s) * (1.f / DM); float s2 = 0.f;
#pragma unroll
        for (int j = 0; j < 4; ++j) { v[j] = v[j] - mean; s2 += (v[j].x * v[j].x + v[j].y * v[j].y) + (v[j].z * v[j].z + v[j].w * v[j].w); }
        const float rstd = 1.f / sqrtf(wave_sum(s2) * (1.f / DM) + LN_EPS);
        if (lane == 0) { ST[2 * m] = mean; ST[2 * m + 1] = rstd; }
        v2u* o8 = (v2u*)(X1B + (size_t)m * DM) + lane;
#pragma unroll
        for (int j = 0; j < 4; ++j) { const f32x4 y = v[j] * rstd * w4[64 * j + lane] + b4[64 * j + lane]; v2u o; o.x = pk2(y.x, y.y); o.y = pk2(y.z, y.w); o8[64 * j] = o; }
    }
}
__device__ __forceinline__ void ln2_pass(Frame& F, const Args& AR, bool dry) {
    const int gw = F.bid * NWAVES + F.wave, NGW = F.G * NWAVES, lane = F.lane;
    const f32x4* w4 = (const f32x4*)AR.in[32]; const f32x4* b4 = (const f32x4*)AR.in[33];
    for (int m = gw; m < M; m += NGW) {
        f32x4* xr = (f32x4*)(F.out + (size_t)m * DM) + lane;
        f32x4 v[4]; float s = 0.f;
#pragma unroll
        for (int j = 0; j < 4; ++j) { v[j] = xr[64 * j]; s += (v[j].x + v[j].y) + (v[j].z + v[j].w); }
        const float mean = wave_sum(s) * (1.f / DM); float s2 = 0.f;
#pragma unroll
        for (int j = 0; j < 4; ++j) { v[j] = v[j] - mean; s2 += (v[j].x * v[j].x + v[j].y * v[j].y) + (v[j].z * v[j].z + v[j].w * v[j].w); }
        const float rstd = 1.f / sqrtf(wave_sum(s2) * (1.f / DM) + LN_EPS);
#pragma unroll
        for (int j = 0; j < 4; ++j) { const f32x4 y = v[j] * rstd * w4[64 * j + lane] + b4[64 * j + lane]; if (!dry) xr[64 * j] = y; }
    }
}

#define XB_TMO      128
#define XB_XCNT(j)  (256  + 64 * (j))
#define XB_XSUB(j)  (1280 + 64 * (j))
#define XB_XGEN(j)  (2304 + 64 * (j))
#define XB_TOP      3328
#define XB_TOPGEN   3392
#define XCD_BAR_WORDS 3456
#define XB_SPIN_CAP (1u << 18)

__device__ __forceinline__ unsigned xb_ld(unsigned* p)              { return __hip_atomic_load(p, __ATOMIC_RELAXED, __HIP_MEMORY_SCOPE_AGENT); }
__device__ __forceinline__ unsigned xb_add(unsigned* p, unsigned v) { return __hip_atomic_fetch_add(p, v, __ATOMIC_RELAXED, __HIP_MEMORY_SCOPE_AGENT); }
__device__ __forceinline__ unsigned xb_xcc_id() { return (unsigned)__builtin_amdgcn_s_getreg((3 << 11) | 20) & 0xFu; }
#define XB_SPIN(cond, bar) do { unsigned _sp = 0; while (cond) { __builtin_amdgcn_s_sleep(1); \
    if ((++_sp & 255u) == 0u) { if (xb_ld(&(bar)[XB_TMO])) break; if (_sp > XB_SPIN_CAP) { atomicAdd(&(bar)[XB_TMO], 1u); break; } } } } while (0)

struct XcdBarrier {
    unsigned* bar; unsigned x;
    volatile LAS unsigned* st;
};

__device__ __forceinline__ XcdBarrier xcd_barrier_post(unsigned* bar, volatile LAS unsigned* st) {
    XcdBarrier b; b.bar = bar; b.x = xb_xcc_id(); b.st = st;
    if (threadIdx.x == 0) (void)xb_add(&bar[XB_XCNT(b.x)], 1u);
    return b;
}
__device__ __forceinline__ void xcd_barrier_complete(unsigned* bar, unsigned x, unsigned& nloc, unsigned& nx) {
    const unsigned G = gridDim.x * gridDim.y * gridDim.z;
    unsigned sum, cnt, mine, sp = 0u;
    for (;;) {
        sum = 0u; cnt = 0u; mine = 0u;
#pragma unroll
        for (unsigned j = 0; j < 16; ++j) { const unsigned c = xb_ld(&bar[XB_XCNT(j)]); sum += c; cnt += (c > 0u) ? 1u : 0u; mine = (j == x) ? c : mine; }
        if (sum == G) break;
        __builtin_amdgcn_s_sleep(1);
        if ((++sp & 255u) == 0u) { if (xb_ld(&bar[XB_TMO])) break; if (sp > XB_SPIN_CAP) { atomicAdd(&bar[XB_TMO], 1u); break; } }
    }
    nloc = mine > 0u ? mine : 1u; nx = cnt > 0u ? cnt : 1u;
}

__device__ __forceinline__ void xcd_barrier(const XcdBarrier& b) {
    asm volatile("s_waitcnt vmcnt(0)" ::: "memory");
    __syncthreads();
    if (threadIdx.x == 0) {
        unsigned* bar = b.bar;
        __builtin_amdgcn_s_waitcnt(0);
        unsigned nloc = b.st[0], nx = b.st[1];
        if (nloc == 0u) { xcd_barrier_complete(bar, b.x, nloc, nx); b.st[0] = nloc; b.st[1] = nx; }
        const unsigned old = xb_add(&bar[XB_XSUB(b.x)], 1u);
        const unsigned gen = old / nloc;
        if (old + 1u == (gen + 1u) * nloc) {
            __builtin_amdgcn_fence(__ATOMIC_RELEASE, "agent");
            asm volatile("s_waitcnt vmcnt(0)" ::: "memory");
            const unsigned og = xb_add(&bar[XB_TOP], 1u);
            const unsigned tg = og / nx;
            if (og + 1u == (tg + 1u) * nx) xb_add(&bar[XB_TOPGEN], 1u);
            else XB_SPIN(xb_ld(&bar[XB_TOPGEN]) == tg, bar);
            __builtin_amdgcn_fence(__ATOMIC_ACQUIRE, "agent");
            xb_add(&bar[XB_XGEN(b.x)], 1u);
            asm volatile("s_waitcnt vmcnt(0)" ::: "memory");
        } else {
            XB_SPIN(xb_ld(&bar[XB_XGEN(b.x)]) == gen, bar);
            __builtin_amdgcn_fence(__ATOMIC_ACQUIRE, "agent");
            asm volatile("s_waitcnt vmcnt(0)" ::: "memory");
        }
    }
    __syncthreads();
}

constexpr int LDS_BYTES = 147456;
constexpr int N_PHASES = 13;
constexpr int CW_BAR = 1024;
#ifndef PROBE_DUP
#define PROBE_DUP -1
#endif
#ifndef PROBE_SUB
#define PROBE_SUB 0
#endif

__global__ void __launch_bounds__(512, 2) hybrid_fwd(Args args) {
    extern __shared__ __attribute__((aligned(16))) unsigned char lds_raw[];
    Frame F;
    F.lds = (LAS unsigned char*)lds_raw;
    F.tid = threadIdx.x; F.lane = F.tid & 63; F.wave = __builtin_amdgcn_readfirstlane(F.tid >> 6);
    F.G = gridDim.x; F.bid = blockIdx.x;
    F.out = args.out; F.ws = args.ws;
    unsigned char* ws = args.ws;
    volatile LAS unsigned* MISC = (volatile LAS unsigned*)(F.lds + 131072 + 320);
    if (F.tid < 32) MISC[F.tid] = 0u;
    __syncthreads();
    XcdBarrier bar = xcd_barrier_post((unsigned*)ws + CW_BAR, MISC + 8);
    const int lo = args.ph_lo, hi = args.ph_hi;
#define IN(k) (lo <= (k) && (k) < hi)
#define SEAM(k) do { if (IN(k) && IN((k) + 1)) xcd_barrier(bar); } while (0)
    using pg8::Gemm; using pg8::StaticOrder; using pg8::gemm_phase;

#define REP(k) for (int rep = 0; rep < ((PROBE_DUP == (k)) ? 2 : 1); ++rep, ((PROBE_DUP == (k)) ? xcd_barrier(bar) : (void)0))
    if (IN(0)) REP(0) { p0_prologue(F, args); } SEAM(0);
    if (IN(1)) REP(1) {
        Gemm g{(const bf16*)(ws + WS_XB), (const bf16*)(ws + WS_WIN), M, NP, DM}; StaticOrder S; S.init(M, NP, F.G, F.bid);
        EpiProj E{(bf16*)(ws + WS_PH), (bf16*)(ws + WS_PR), (bf16*)(ws + WS_PG)};
        gemm_phase<EpiProj, StaticOrder, true, true>(F.lds, g, S, E);
    } SEAM(1);
    if (IN(2)) REP(2) { p2_prep(F, args); } SEAM(2);
    if (IN(3)) REP(3) {
        Gemm g{(const bf16*)(ws + WS_TOP), (const bf16*)(ws + WS_WLORA), M, LORA_N, LORA_K}; StaticOrder S; S.init(M, LORA_N, F.G, F.bid);
        EpiLora E{(bf16*)(ws + WS_LW)};
        gemm_phase<EpiLora, StaticOrder, true, true>(F.lds, g, S, E);
    } SEAM(3);
    if (IN(4)) { if (PROBE_DUP == 4) { p4_mixers(F, args, PROBE_SUB != 2, PROBE_SUB != 1, true); xcd_barrier(bar); } p4_mixers(F, args, true, true, false); } SEAM(4);
    if (IN(5)) REP(5) { p5_combine(F, args, (PROBE_DUP == 5) && rep == 0); } SEAM(5);
    if (IN(6)) REP(6) {
        Gemm g{(const bf16*)(ws + WS_ZH), (const bf16*)(ws + WS_WHY), M, DM, 512}; StaticOrder S; S.init(M, DM, F.G, F.bid);
        EpiGate<0> E{(const bf16*)(ws + WS_PG), (bf16*)(ws + WS_T), nullptr};
        gemm_phase<EpiGate<0>, StaticOrder, true, true>(F.lds, g, S, E);
    } SEAM(6);
    if (IN(7)) REP(7) {
        Gemm g{(const bf16*)((unsigned char*)F.out + DO_YSF), (const bf16*)(ws + WS_WRW), M, DM, 512}; StaticOrder S; S.init(M, DM, F.G, F.bid);
        EpiGate<1> E{(const bf16*)(ws + WS_PG), (bf16*)(ws + WS_T), (bf16*)(ws + WS_MIXIN)};
        gemm_phase<EpiGate<1>, StaticOrder, true, true>(F.lds, g, S, E);
    } SEAM(7);
    if (IN(8)) REP(8) {
        Gemm g{(const bf16*)(ws + WS_MIXIN), (const bf16*)(ws + WS_WO), M, DM, DM}; StaticOrder S; S.init(M, DM, F.G, F.bid);
        EpiWo E{args.in[0], (float*)(ws + WS_H1)};
        gemm_phase<EpiWo, StaticOrder, true, true>(F.lds, g, S, E);
    } SEAM(8);
    if (IN(9)) REP(9) { ln1_pass(F, args); } SEAM(9);
    if (IN(10)) REP(10) {
        Gemm g{(const bf16*)(ws + WS_X1B), (const bf16*)(ws + WS_WGU), M, NGU, DM}; StaticOrder S; S.init(M, NGU, F.G, F.bid);
        EpiSwiGLU E{(bf16*)(ws + WS_HID)};
        gemm_phase<EpiSwiGLU, StaticOrder, true, true>(F.lds, g, S, E);
    } SEAM(10);
    if (IN(11)) REP(11) {
        Gemm g{(const bf16*)(ws + WS_HID), (const bf16*)(ws + WS_WD), M, DM, FFH}; StaticOrder S; S.init(M, DM, F.G, F.bid);
        EpiDown E{(const float*)(ws + WS_H1), (const float*)(ws + WS_STATS), args.in[27], args.in[28], F.out};
        gemm_phase<EpiDown, StaticOrder, true, true>(F.lds, g, S, E);
    } SEAM(11);
    if (IN(12)) REP(12) { ln2_pass(F, args, (PROBE_DUP == 12) && rep == 0); }
#undef IN
#undef SEAM
}

extern "C" void kernel_launch(void* const* d_in, const int* in_sizes, int n_in, void* d_out, int out_size, void* d_ws, size_t ws_size, hipStream_t stream) {
    static int grid = 0;
    if (grid == 0) {
        if (n_in != 34 || out_size != M * DM || ws_size < WS_NEED) { fprintf(stderr, "kernel_launch: unexpected shapes (n_in %d out %d ws %zu)\n", n_in, out_size, ws_size); grid = -1; return; }
        int dev = 0, cus = 0, per_cu = 0;
        if (hipGetDevice(&dev) != hipSuccess || hipDeviceGetAttribute(&cus, hipDeviceAttributeMultiprocessorCount, dev) != hipSuccess) { grid = -1; return; }
        if (hipFuncSetAttribute((const void*)hybrid_fwd, hipFuncAttributeMaxDynamicSharedMemorySize, LDS_BYTES) != hipSuccess) { fprintf(stderr, "kernel_launch: hipFuncSetAttribute failed\n"); grid = -1; return; }
        if (hipOccupancyMaxActiveBlocksPerMultiprocessor(&per_cu, (const void*)hybrid_fwd, 512, LDS_BYTES) != hipSuccess || per_cu < 1) { fprintf(stderr, "kernel_launch: occupancy query says %d\n", per_cu); per_cu = 1; }
        (void)hipGetLastError();
        grid = cus;
        if (grid != 256) fprintf(stderr, "kernel_launch: %d CUs (built for 256)\n", grid);
    }
    if (grid < 0) return;
    Args a{};
    for (int i = 0; i < 34; ++i) a.in[i] = (const float*)d_in[i];
    a.out = (float*)d_out; a.ws = (unsigned char*)d_ws; a.ph_lo = 0; a.ph_hi = N_PHASES;
    if (hipMemsetAsync(d_ws, 0, 65536, stream) != hipSuccess) { fprintf(stderr, "kernel_launch: memset failed\n"); return; }
    hipLaunchKernelGGL(hybrid_fwd, dim3(grid), dim3(512), LDS_BYTES, stream, a);
    const hipError_t e = hipPeekAtLastError();
    if (e != hipSuccess) fprintf(stderr, "kernel_launch: launch failed: %s\n", hipGetErrorString(e));
}
```

```cpp
#include <hip/hip_runtime.h>
#include <hip/hip_cooperative_groups.h>
#include <cstdio>
#include <cstdint>
namespace cg = cooperative_groups;
namespace pg8 {
#define PG8_LAS __attribute__((address_space(3)))
typedef unsigned short bf16_t;
typedef short bf16x8 __attribute__((ext_vector_type(8)));
typedef float f32x4 __attribute__((ext_vector_type(4)));
typedef unsigned u32x4 __attribute__((ext_vector_type(4)));
constexpr int BM = 256, BK = 64, HALF = 128, HTB = HALF * BK * 2  , STAGE_BYTES = 8 * HTB, NXCD = 8, WGM = 8;

__host__ __device__ __forceinline__ int lds_byte(int r, int c) { const int st = (r >> 4) * 2 + (c >> 5), rr = r & 15, cc = c & 31, ob = rr * 64 + cc * 2; return st * 1024 + (ob ^ (((ob >> 9) & 1) << 5)); }
__host__ __device__ __forceinline__ void stage_rc(int b, int& R, int& C) { const int st = b / 1024, sb = b % 1024, swz = sb ^ (((sb >> 9) & 1) << 5); R = (st >> 1) * 16 + swz / 64; C = (st & 1) * 32 + (swz % 64) / 2; }
__host__ __device__ __forceinline__ int perm32(int rho) { const int n = rho >> 4, i = rho & 15; return 8 * (i >> 2) + 4 * n + (i & 3); }

struct Unit { int pm, pn; };
struct Gemm { const bf16_t* A; const bf16_t* Bt; int M, N, K; };

struct StaticOrder {
    int nM, nN, nwg, G, c;
    __host__ __device__ void init(int M, int N, int G_, int c_) { nM = M / BM; nN = N / BM; nwg = nM * nN; G = G_; c = c_; }
    __host__ __device__ bool next(int i, Unit& u) const {
        const long L = (long)i * G + c; if (L >= nwg) return false;
        int wgid = (int)L; { const int q = nwg / NXCD, r = nwg % NXCD, xcd = wgid % NXCD, off = wgid / NXCD; wgid = (xcd < r ? xcd * (q + 1) : r * (q + 1) + (xcd - r) * q) + off; }
        const int nig = WGM * nN, gid = wgid / nig, fm = gid * WGM, gsz = (nM - fm) < WGM ? (nM - fm) : WGM;
        u.pm = fm + ((wgid % nig) % gsz); u.pn = (wgid % nig) / gsz; return true;
    }
    __device__ __forceinline__ void a_ready(const Unit&) const {}
    __device__ __forceinline__ void done(const Unit&) const {}
};

__device__ __forceinline__ unsigned cvt_pk_bf16(float lo, float hi) { unsigned r; asm volatile("v_cvt_pk_bf16_f32 %0, %1, %2" : "=v"(r) : "v"(lo), "v"(hi)); return r; }
typedef float f32x2 __attribute__((ext_vector_type(2)));
template <class Epi, class Sched, bool ALIGN_EPI = false, bool SP2 = false>
__device__ __forceinline__ void gemm_phase(PG8_LAS unsigned char* lds, const Gemm g, const Sched& S, const Epi& E) {
    const int tid = threadIdx.x, wid = __builtin_amdgcn_readfirstlane(tid >> 6), lane = tid & 63, wr = wid >> 2, wc = wid & 3, fr = lane & 15, fq = lane >> 4;
    const int K = g.K, nt = K / BK;
    unsigned voffA[2], voffB[2];
#pragma unroll
    for (int i = 0; i < 2; ++i) { int R, C; stage_rc(tid * 16 + i * 8192, R, C); const int Rb = Epi::PERM ? ((R & ~31) + perm32(R & 31)) : R;
        voffA[i] = (unsigned)(R * K + C) * 2u; voffB[i] = (unsigned)(Rb * K + C) * 2u; }
    const size_t kstep = (size_t)(BK * 2);
    const size_t hstep = (size_t)HALF * K * 2;
    const size_t tstep = 2 * hstep;
    const unsigned ldsw = (unsigned)wid * 1024u;
    const int aoff = lds_byte(wr * 64 + fr, fq * 8), boff = lds_byte(wc * 32 + fr, fq * 8);
#define PG8_SA(b, h) (((b) * 2 + (h)) * HTB)
#define PG8_SB(b, h) ((4 + (b) * 2 + (h)) * HTB)
#define PG8_STAGE(bufoff, gbase, voff) do { _Pragma("unroll") for (int _i = 0; _i < 2; ++_i) \
        __builtin_amdgcn_global_load_lds((const unsigned*)((const char*)(gbase) + (voff)[_i]), (PG8_LAS unsigned*)(lds + (bufoff) + ldsw + _i * 8192), 16, 0, 0); } while (0)
#define PG8_LDA(dst, b, h) do { _Pragma("unroll") for (int m = 0; m < 4; ++m) _Pragma("unroll") for (int k = 0; k < 2; ++k) dst[m][k] = *(const PG8_LAS bf16x8*)(lds + PG8_SA(b, h) + aoff + m * 2048 + k * 1024); } while (0)
#define PG8_LDB(dst, b, h) do { _Pragma("unroll") for (int n = 0; n < 2; ++n) _Pragma("unroll") for (int k = 0; k < 2; ++k) dst[n][k] = *(const PG8_LAS bf16x8*)(lds + PG8_SB(b, h) + boff + n * 2048 + k * 1024); } while (0)
#define PG8_MMA(ai, bj, At, Bt) do { __builtin_amdgcn_s_setprio(1); _Pragma("unroll") for (int m = 0; m < 4; ++m) _Pragma("unroll") for (int n = 0; n < 2; ++n) _Pragma("unroll") for (int k = 0; k < 2; ++k) \
        acc[ai][bj][m][n] = __builtin_amdgcn_mfma_f32_16x16x32_bf16(Bt[n][k], At[m][k], acc[ai][bj][m][n], 0, 0, 0); __builtin_amdgcn_s_setprio(0); } while (0)
#define PG8_WAIT_V(n) asm volatile("s_waitcnt vmcnt(" #n ")" ::: "memory")
#define PG8_WAIT_L(n) asm volatile("s_waitcnt lgkmcnt(" #n ")" ::: "memory")
#define PG8_BAR __builtin_amdgcn_s_barrier()
#define PG8_SCHED __builtin_amdgcn_sched_barrier(0)
    Unit cur, nxt; int ui = 0;
    if (!S.next(0, cur)) return;
    f32x4 acc[2][2][4][2];
#pragma unroll
    for (int a = 0; a < 2; ++a)
#pragma unroll
        for (int b = 0; b < 2; ++b)
#pragma unroll
            for (int m = 0; m < 4; ++m)
#pragma unroll
                for (int n = 0; n < 2; ++n) acc[a][b][m][n] = (f32x4){0.f, 0.f, 0.f, 0.f};
    bf16x8 At[4][2], B0[2][2], B1[2][2];
    const char* cA = (const char*)g.A + (size_t)cur.pm * tstep; const char* cB = (const char*)g.Bt + (size_t)cur.pn * tstep;
    S.a_ready(cur);
    if constexpr (SP2) {
        PG8_STAGE(PG8_SB(0, 0), cB, voffB); PG8_STAGE(PG8_SB(0, 1), cB + hstep, voffB); PG8_STAGE(PG8_SA(0, 0), cA, voffA); PG8_STAGE(PG8_SA(0, 1), cA + hstep, voffA);
        if (wr == 1) PG8_BAR;
        PG8_WAIT_V(2); PG8_BAR;
        PG8_STAGE(PG8_SB(1, 0), cB + kstep, voffB); PG8_STAGE(PG8_SA(1, 0), cA + kstep, voffA); PG8_STAGE(PG8_SB(1, 1), cB + hstep + kstep, voffB);
        PG8_WAIT_V(6); PG8_BAR;
    } else {
        PG8_STAGE(PG8_SB(0, 0), cB, voffB); PG8_STAGE(PG8_SA(0, 0), cA, voffA); PG8_STAGE(PG8_SB(0, 1), cB + hstep, voffB); PG8_STAGE(PG8_SA(0, 1), cA + hstep, voffA);
        if (wr == 1) PG8_BAR;
        PG8_WAIT_V(4); PG8_BAR;
        PG8_STAGE(PG8_SB(1, 0), cB + kstep, voffB); PG8_STAGE(PG8_SA(1, 0), cA + kstep, voffA); PG8_STAGE(PG8_SB(1, 1), cB + hstep + kstep, voffB);
        PG8_WAIT_V(6); PG8_BAR;
    }
    for (;;) {
        const bool has_next = S.next(ui + 1, nxt);
        const char* nA = has_next ? (const char*)g.A + (size_t)nxt.pm * tstep : cA; const char* nB = has_next ? (const char*)g.Bt + (size_t)nxt.pn * tstep : cB;
#pragma unroll 1
        for (int t = 0; t < nt; t += 2) {
            const bool last = (t == nt - 2);
            const char* a1 = cA + (size_t)(t + 1) * kstep;
            const char* a2 = last ? nA : cA + (size_t)(t + 2) * kstep; const char* b2 = last ? nB : cB + (size_t)(t + 2) * kstep;
            const char* a3 = a2 + kstep; const char* b3 = b2 + kstep;
            if (last && has_next) S.a_ready(nxt);
            if constexpr (SP2) {
            PG8_LDB(B0, 0, 0); PG8_LDB(B1, 0, 1); PG8_SCHED; PG8_LDA(At, 0, 0); PG8_STAGE(PG8_SA(1, 1), a1 + hstep, voffA);
            PG8_WAIT_V(8); PG8_WAIT_L(0); PG8_BAR; PG8_MMA(0, 0, At, B0); PG8_MMA(0, 1, At, B1); PG8_BAR; PG8_SCHED;
            PG8_LDA(At, 0, 1); PG8_STAGE(PG8_SB(0, 0), b2, voffB); PG8_STAGE(PG8_SB(0, 1), b2 + hstep, voffB); PG8_STAGE(PG8_SA(0, 0), a2, voffA);
            PG8_WAIT_V(8); PG8_WAIT_L(0); PG8_BAR; PG8_MMA(1, 0, At, B0); PG8_MMA(1, 1, At, B1); PG8_BAR; PG8_SCHED;
            PG8_LDB(B0, 1, 0); PG8_LDB(B1, 1, 1); PG8_SCHED; PG8_LDA(At, 1, 0); PG8_STAGE(PG8_SA(0, 1), a2 + hstep, voffA);
            PG8_WAIT_V(8); PG8_WAIT_L(0); PG8_BAR; PG8_MMA(0, 0, At, B0); PG8_MMA(0, 1, At, B1); PG8_BAR; PG8_SCHED;
            PG8_LDA(At, 1, 1); PG8_STAGE(PG8_SB(1, 0), b3, voffB); PG8_STAGE(PG8_SB(1, 1), b3 + hstep, voffB); PG8_STAGE(PG8_SA(1, 0), a3, voffA);
            PG8_WAIT_V(8); PG8_WAIT_L(0); PG8_BAR; PG8_MMA(1, 0, At, B0); PG8_MMA(1, 1, At, B1); PG8_BAR; PG8_SCHED;
            } else {
            PG8_LDB(B0, 0, 0); PG8_SCHED; PG8_LDA(At, 0, 0); PG8_STAGE(PG8_SA(1, 1), a1 + hstep, voffA);
            PG8_WAIT_L(8); PG8_BAR; PG8_WAIT_L(0); PG8_MMA(0, 0, At, B0); PG8_BAR; PG8_SCHED;
            PG8_LDB(B1, 0, 1); PG8_STAGE(PG8_SB(0, 0), b2, voffB);
            PG8_BAR; PG8_WAIT_L(0); PG8_MMA(0, 1, At, B1); PG8_BAR;
            PG8_LDA(At, 0, 1); PG8_STAGE(PG8_SA(0, 0), a2, voffA);
            PG8_BAR; PG8_WAIT_L(0); PG8_MMA(1, 0, At, B0); PG8_BAR; PG8_SCHED;
            PG8_STAGE(PG8_SB(0, 1), b2 + hstep, voffB);
            PG8_WAIT_V(6); PG8_BAR; PG8_MMA(1, 1, At, B1); PG8_BAR;
            PG8_LDB(B0, 1, 0); PG8_SCHED; PG8_LDA(At, 1, 0); PG8_STAGE(PG8_SA(0, 1), a2 + hstep, voffA);
            PG8_WAIT_L(8); PG8_BAR; PG8_WAIT_L(0); PG8_MMA(0, 0, At, B0); PG8_BAR; PG8_SCHED;
            PG8_LDB(B1, 1, 1); PG8_STAGE(PG8_SB(1, 0), b3, voffB);
            PG8_BAR; PG8_WAIT_L(0); PG8_MMA(0, 1, At, B1); PG8_BAR;
            PG8_LDA(At, 1, 1); PG8_STAGE(PG8_SA(1, 0), a3, voffA);
            PG8_BAR; PG8_WAIT_L(0); PG8_MMA(1, 0, At, B0); PG8_BAR; PG8_SCHED;
            PG8_STAGE(PG8_SB(1, 1), b3 + hstep, voffB);
            PG8_WAIT_V(6); PG8_BAR; PG8_MMA(1, 1, At, B1); PG8_BAR;
            }
        }
        if constexpr (ALIGN_EPI) { if (wr == 0) PG8_BAR; }
        if constexpr (!Epi::AFTER_DRAIN) { E(acc, cur, wr, wc, fr, fq); S.done(cur); }
        if (!has_next) break;
#pragma unroll
        for (int a = 0; a < 2; ++a)
#pragma unroll
            for (int b = 0; b < 2; ++b)
#pragma unroll
                for (int m = 0; m < 4; ++m)
#pragma unroll
                    for (int n = 0; n < 2; ++n) acc[a][b][m][n] = (f32x4){0.f, 0.f, 0.f, 0.f};
        cur = nxt; cA = nA; cB = nB; ++ui;
        if constexpr (ALIGN_EPI) { if (wr == 1) PG8_BAR; }
    }
    PG8_WAIT_V(0);
    if constexpr (!ALIGN_EPI) { if (wr == 0) PG8_BAR; }
    PG8_BAR;
    if constexpr (Epi::AFTER_DRAIN) { E.fused(acc, cur, wr, wc, fr, fq, lds, wid, lane); S.done(cur); }
#undef PG8_SA
#undef PG8_SB
#undef PG8_STAGE
#undef PG8_LDA
#undef PG8_LDB
#undef PG8_MMA
#undef PG8_WAIT_V
#undef PG8_WAIT_L
#undef PG8_BAR
#undef PG8_SCHED
}
}

constexpr int NB = 8, SEQ = 4096, DM = 1024, M = NB * SEQ;
constexpr int NHEAD = 8;
constexpr int PH_P = 1536, PR_P = 1920, PG_P = 2048;
constexpr int NP = 5632;
constexpr int FFH = 2816, NGU = 5632;
constexpr int LORA_K = 384, LORA_N = 2560;
constexpr float DN_ALPHA = 1.18920711500272f;
constexpr float LN_EPS = 1e-5f, GN_EPS = 64e-5f;
constexpr float HY_MIN_DECAY = -3.07011346f, HY_MAX_DECAY = -15.3505673f;
constexpr int NWAVES = 8;

constexpr size_t MiB = 1u << 20;
constexpr size_t WS_H3T = 1 * MiB;
constexpr size_t WS_STATS = 2 * MiB;
constexpr size_t WS_BONUS = 3 * MiB;
constexpr size_t WS_WIN = 5 * MiB, WS_WGU = 16 * MiB, WS_WD = 27 * MiB, WS_WO = 33 * MiB, WS_WHY = 35 * MiB, WS_WRW = 36 * MiB, WS_WLORA = 37 * MiB;
constexpr size_t WS_FT = 39 * MiB;
constexpr size_t WS_XB = 71 * MiB;
constexpr size_t WS_LW = 71 * MiB;
constexpr size_t WS_PH = 135 * MiB, WS_PR = 231 * MiB, WS_PG = 351 * MiB;
constexpr size_t WS_TOP = 479 * MiB;
constexpr size_t WS_ZH = 71 * MiB, WS_T = 103 * MiB, WS_MIXIN = 167 * MiB;
constexpr size_t WS_H1 = 351 * MiB, WS_X1B = 71 * MiB, WS_HID = 135 * MiB;
constexpr size_t WS_NEED = 511 * MiB;
constexpr size_t DO_HT = 0, DO_YSF = 96 * MiB;

#define GAS __attribute__((address_space(1)))
#define LAS __attribute__((address_space(3)))
typedef unsigned short bf16;
typedef unsigned v4u __attribute__((ext_vector_type(4)));
typedef unsigned v2u __attribute__((ext_vector_type(2)));
typedef float f32x4 __attribute__((ext_vector_type(4)));
typedef float f32x16 __attribute__((ext_vector_type(16)));
typedef short bf16x8 __attribute__((ext_vector_type(8)));

__device__ __forceinline__ float bf2f(unsigned b) { return __uint_as_float(b << 16); }
__device__ __forceinline__ float bflo(unsigned w) { return __uint_as_float(w << 16); }
__device__ __forceinline__ float bfhi(unsigned w) { return __uint_as_float(w & 0xffff0000u); }
__device__ __forceinline__ unsigned f2bf(float f) { unsigned u = __float_as_uint(f); return (u + 0x7fffu + ((u >> 16) & 1u)) >> 16; }
__device__ __forceinline__ unsigned pk2(float lo, float hi) { return f2bf(lo) | (f2bf(hi) << 16); }
__device__ __forceinline__ float sigmoidf_(float x) { return 1.0f / (1.0f + __expf(-x)); }
typedef float f32x2c __attribute__((ext_vector_type(2)));
typedef __bf16 bf16x2c __attribute__((ext_vector_type(2)));
__device__ __forceinline__ unsigned cvtpk2(float lo, float hi) { const f32x2c v = {lo, hi}; return __builtin_bit_cast(unsigned, __builtin_convertvector(v, bf16x2c)); }
__device__ __forceinline__ float fsig(float x) { return __builtin_amdgcn_rcpf(1.0f + __expf(-x)); }
__device__ __forceinline__ float wave_sum(float v) {
#pragma unroll
    for (int o = 1; o < 64; o <<= 1) v += __shfl_xor(v, o);
    return v;
}

struct Frame {
    LAS unsigned char* lds;
    int tid, lane, wave, G, bid;
    float* out; unsigned char* ws;
};
struct Args { const float* in[34]; float* out; unsigned char* ws; int ph_lo, ph_hi; };

using pg8::Unit; using pg8::cvt_pk_bf16; constexpr int HALF = 128, BM = 256;

__device__ __forceinline__ v4u pack8(f32x4 v0, f32x4 v1) { v4u w; w.x = cvt_pk_bf16(v0[0], v0[1]); w.y = cvt_pk_bf16(v0[2], v0[3]); w.z = cvt_pk_bf16(v1[0], v1[1]); w.w = cvt_pk_bf16(v1[2], v1[3]); return w; }

struct EpiProj {
    static constexpr bool PERM = true, AFTER_DRAIN = false;
    bf16 *PH, *PR, *PG;
    __device__ __forceinline__ void operator()(const f32x4 (&acc)[2][2][4][2], const Unit& u, int wr, int wc, int fr, int fq) const {
        const int row0 = u.pm * BM + wr * 64 + fr;
#pragma unroll
        for (int bj = 0; bj < 2; ++bj) {
            const int hb = 2 * u.pn + bj; bf16* base; int pitch, col;
            if (hb < 12) { base = PH; pitch = PH_P; col = 128 * hb; }
            else if (hb < 27) { base = PR; pitch = PR_P; col = 128 * (hb - 12); }
            else if (hb < 43) { base = PG; pitch = PG_P; col = 128 * (hb - 27); }
            else continue;
            col += wc * 32 + 8 * fq;
#pragma unroll
            for (int ai = 0; ai < 2; ++ai)
#pragma unroll
                for (int m = 0; m < 4; ++m)
                    *(v4u*)(base + (size_t)(row0 + ai * HALF + m * 16) * pitch + col) = pack8(acc[ai][bj][m][0], acc[ai][bj][m][1]);
        }
    }
};

struct EpiLora {
    static constexpr bool PERM = true, AFTER_DRAIN = false;
    bf16* LW;
    __device__ __forceinline__ void operator()(const f32x4 (&acc)[2][2][4][2], const Unit& u, int wr, int wc, int fr, int fq) const {
        const int row0 = u.pm * BM + wr * 64 + fr;
        bf16* base = LW + (size_t)(u.pn >> 1) * ((size_t)M * 512) + (u.pn & 1) * 256 + wc * 32 + 8 * fq;
#pragma unroll
        for (int ai = 0; ai < 2; ++ai)
#pragma unroll
            for (int m = 0; m < 4; ++m) { bf16* rowp = base + (size_t)(row0 + ai * HALF + m * 16) * 512;
#pragma unroll
                for (int bj = 0; bj < 2; ++bj) *(v4u*)(rowp + bj * HALF) = pack8(acc[ai][bj][m][0], acc[ai][bj][m][1]); }
    }
};

template <int STAGE> struct EpiGate {
    static constexpr bool PERM = true, AFTER_DRAIN = false;
    const bf16* PG; bf16* T; bf16* O;
    __device__ __forceinline__ void operator()(const f32x4 (&acc)[2][2][4][2], const Unit& u, int wr, int wc, int fr, int fq) const {
        const int row0 = u.pm * BM + wr * 64 + fr;
#pragma unroll
        for (int bj = 0; bj < 2; ++bj) {
            const int col = u.pn * BM + bj * HALF + wc * 32 + 8 * fq;
#pragma unroll
            for (int ai = 0; ai < 2; ++ai)
#pragma unroll
                for (int m = 0; m < 4; ++m) {
                    const size_t row = (size_t)(row0 + ai * HALF + m * 16);
                    const v4u g = *(const v4u*)(PG + row * PG_P + STAGE * 1024 + col);
                    f32x4 v0 = acc[ai][bj][m][0], v1 = acc[ai][bj][m][1];
                    v0[0] *= sigmoidf_(bflo(g.x)); v0[1] *= sigmoidf_(bfhi(g.x)); v0[2] *= sigmoidf_(bflo(g.y)); v0[3] *= sigmoidf_(bfhi(g.y));
                    v1[0] *= sigmoidf_(bflo(g.z)); v1[1] *= sigmoidf_(bfhi(g.z)); v1[2] *= sigmoidf_(bflo(g.w)); v1[3] *= sigmoidf_(bfhi(g.w));
                    if (STAGE == 1) {
                        const v4u t = *(const v4u*)(T + row * 1024 + col);
                        v0[0] += bflo(t.x); v0[1] += bfhi(t.x); v0[2] += bflo(t.y); v0[3] += bfhi(t.y);
                        v1[0] += bflo(t.z); v1[1] += bfhi(t.z); v1[2] += bflo(t.w); v1[3] += bfhi(t.w);
                        *(v4u*)(O + row * 1024 + col) = pack8(v0, v1);
                    } else {
                        *(v4u*)(T + row * 1024 + col) = pack8(v0, v1);
                    }
                }
        }
    }
};

struct EpiWo {
    static constexpr bool PERM = false, AFTER_DRAIN = false;
    const float* X; float* H1;
    __device__ __forceinline__ void operator()(const f32x4 (&acc)[2][2][4][2], const Unit& u, int wr, int wc, int fr, int fq) const {
        const int row0 = u.pm * BM + wr * 64 + fr, col0 = u.pn * BM + wc * 32 + 4 * fq;
#pragma unroll
        for (int ai = 0; ai < 2; ++ai)
#pragma unroll
            for (int m = 0; m < 4; ++m) {
                const size_t off = (size_t)(row0 + ai * HALF + m * 16) * DM + col0;
#pragma unroll
                for (int bj = 0; bj < 2; ++bj)
#pragma unroll
                    for (int n = 0; n < 2; ++n) {
                        const f32x4 xv = *(const f32x4*)(X + off + bj * HALF + n * 16);
                        *(f32x4*)(H1 + off + bj * HALF + n * 16) = xv * DN_ALPHA + acc[ai][bj][m][n];
                    }
            }
    }
};

struct EpiSwiGLU {
    static constexpr bool PERM = true, AFTER_DRAIN = false;
    bf16* HID;
    __device__ __forceinline__ void operator()(const f32x4 (&acc)[2][2][4][2], const Unit& u, int wr, int wc, int fr, int fq) const {
        const int row0 = u.pm * BM + wr * 64 + fr, col = u.pn * HALF + wc * 32 + 8 * fq;
#pragma unroll
        for (int ai = 0; ai < 2; ++ai)
#pragma unroll
            for (int m = 0; m < 4; ++m) {
                f32x4 g0 = acc[ai][0][m][0], g1 = acc[ai][0][m][1]; const f32x4 u0 = acc[ai][1][m][0], u1 = acc[ai][1][m][1];
#pragma unroll
                for (int j = 0; j < 4; ++j) { g0[j] = g0[j] * sigmoidf_(g0[j]) * u0[j]; g1[j] = g1[j] * sigmoidf_(g1[j]) * u1[j]; }
                *(v4u*)(HID + (size_t)(row0 + ai * HALF + m * 16) * FFH + col) = pack8(g0, g1);
            }
    }
};

struct EpiDown {
    static constexpr bool PERM = false, AFTER_DRAIN = false;
    const float* H1; const float* STATS; const float* lnw; const float* lnb; float* O;
    __device__ __forceinline__ void operator()(const f32x4 (&acc)[2][2][4][2], const Unit& u, int wr, int wc, int fr, int fq) const {
        const int row0 = u.pm * BM + wr * 64 + fr, col0 = u.pn * BM + wc * 32 + 4 * fq;
#pragma unroll
        for (int ai = 0; ai < 2; ++ai)
#pragma unroll
            for (int m = 0; m < 4; ++m) {
                const int row = row0 + ai * HALF + m * 16; const size_t off = (size_t)row * DM + col0;
                const float mean = STATS[2 * row], rstd = STATS[2 * row + 1];
#pragma unroll
                for (int bj = 0; bj < 2; ++bj)
#pragma unroll
                    for (int n = 0; n < 2; ++n) {
                        const f32x4 hv = *(const f32x4*)(H1 + off + bj * HALF + n * 16);
                        const f32x4 wv = *(const f32x4*)(lnw + col0 + bj * HALF + n * 16), bv = *(const f32x4*)(lnb + col0 + bj * HALF + n * 16);
                        const f32x4 x1 = (hv - mean) * rstd * wv + bv;
                        *(f32x4*)(O + off + bj * HALF + n * 16) = x1 * DN_ALPHA + acc[ai][bj][m][n];
                    }
            }
    }
};

__device__ __forceinline__ void p0_transpose_item(const float* W, int K, int N, bf16* WT, int dst_row0, int k0, int n0, LAS float* scr, int lane) {
#pragma unroll 8
    for (int i = 0; i < 32; ++i) { const int kk = 2 * i + (lane >> 5); scr[kk * 33 + (lane & 31)] = W[(size_t)(k0 + kk) * N + n0 + (lane & 31)]; }
    asm volatile("s_waitcnt lgkmcnt(0)" ::: "memory");
    const int c = lane & 7;
#pragma unroll
    for (int j = 0; j < 4; ++j) { const int n = (lane >> 3) + 8 * j; const LAS float* s = scr + (8 * c) * 33 + n;
        v4u o; o.x = pk2(s[0 * 33], s[1 * 33]); o.y = pk2(s[2 * 33], s[3 * 33]); o.z = pk2(s[4 * 33], s[5 * 33]); o.w = pk2(s[6 * 33], s[7 * 33]);
        *(v4u*)(WT + (size_t)(dst_row0 + n) * K + k0 + 8 * c) = o; }
    asm volatile("s_waitcnt lgkmcnt(0)" ::: "memory");
}

__device__ __forceinline__ void p0_prologue(Frame& F, const Args& AR) {
    LAS float* scr = (LAS float*)(F.lds + F.wave * 16384);
    const int gw = F.bid * NWAVES + F.wave, NGW = F.G * NWAVES, lane = F.lane;
    unsigned char* ws = F.ws;
    constexpr int I_IN = (1024 / 64) * (5504 / 32), I_GU = (1024 / 64) * (2816 / 32), I_D = (2816 / 64) * (1024 / 32), I_O = 16 * 32, I_HY = 8 * 32;
    constexpr int NITEMS = I_IN + 2 * I_GU + I_D + I_O + 2 * I_HY;
    for (int it = gw; it < NITEMS; it += NGW) {
        int r = it;
        if (r < I_IN) { const int nblk = 5504 / 32, kb = r / nblk, nb = r % nblk; p0_transpose_item(AR.in[1], 1024, 5504, (bf16*)(ws + WS_WIN), 32 * nb, 64 * kb, 32 * nb, scr, lane); continue; } r -= I_IN;
        if (r < 2 * I_GU) { const int up = r >= I_GU; if (up) r -= I_GU; const int nblk = 2816 / 32, kb = r / nblk, nb = r % nblk, n0 = 32 * nb;
            p0_transpose_item(AR.in[up ? 30 : 29], 1024, 2816, (bf16*)(ws + WS_WGU), (n0 >> 7) * 256 + (n0 & 127) + (up ? 128 : 0), 64 * kb, n0, scr, lane); continue; } r -= 2 * I_GU;
        if (r < I_D) { const int nblk = 32, kb = r / nblk, nb = r % nblk; p0_transpose_item(AR.in[31], 2816, 1024, (bf16*)(ws + WS_WD), 32 * nb, 64 * kb, 32 * nb, scr, lane); continue; } r -= I_D;
        if (r < I_O) { const int kb = r / 32, nb = r % 32; p0_transpose_item(AR.in[26], 1024, 1024, (bf16*)(ws + WS_WO), 32 * nb, 64 * kb, 32 * nb, scr, lane); continue; } r -= I_O;
        if (r < I_HY) { const int kb = r / 32, nb = r % 32; p0_transpose_item(AR.in[24], 512, 1024, (bf16*)(ws + WS_WHY), 32 * nb, 64 * kb, 32 * nb, scr, lane); continue; } r -= I_HY;
        { const int kb = r / 32, nb = r % 32; p0_transpose_item(AR.in[25], 512, 1024, (bf16*)(ws + WS_WRW), 32 * nb, 64 * kb, 32 * nb, scr, lane); }
    }
    const size_t gt = (size_t)F.bid * 512 + F.tid, NT = (size_t)F.G * 512;
    { v4u z = {0u, 0u, 0u, 0u}; v4u* p = (v4u*)((bf16*)(ws + WS_WIN) + (size_t)5504 * 1024); for (size_t i = gt; i < (size_t)128 * 1024 / 8; i += NT) p[i] = z; }
    { bf16* WL = (bf16*)(ws + WS_WLORA);
      for (size_t i = gt; i < (size_t)LORA_N * LORA_K; i += NT) {
          const int n = (int)(i / LORA_K), k = (int)(i % LORA_K), blk = n >> 9, c = n & 511; float v = 0.f;
          if (blk < 2) { if ((k >> 6) == blk) v = AR.in[15][((size_t)blk * 64 + (k & 63)) * 512 + c]; }
          else if (blk < 4) { if ((k >> 6) == blk) v = AR.in[17][((size_t)(blk - 2) * 64 + (k & 63)) * 512 + c]; }
          else { if (k >= 256) v = AR.in[18][(size_t)(k - 256) * 512 + c]; }
          WL[i] = (bf16)f2bf(v);
      } }
    { const f32x4* x4 = (const f32x4*)AR.in[0]; v4u* xb = (v4u*)(ws + WS_XB);
      for (size_t i = gt; i < (size_t)M * DM / 8; i += NT) { const f32x4 a = x4[2 * i], b = x4[2 * i + 1]; xb[i] = pack8(a, b); } }
    { float* H3T = (float*)(ws + WS_H3T);
      const float* fw1 = AR.in[4]; const float* fb1 = AR.in[5]; const float* fw2 = AR.in[6]; const float* fb2 = AR.in[7]; const float* fw3 = AR.in[8]; const float* fb3 = AR.in[9]; const float* sf = AR.in[11];
      for (int pos = gw; pos < SEQ; pos += NGW) {
          const float t = (float)pos / 4095.0f, wv = 6.283185307179586f * (float)pos / 4096.0f;
          float feat = 0.f;
          if (lane == 0) feat = t;
          else if (lane <= 32) { const int j = (lane - 1) & 15; const float f = 1e-4f + (float)j * ((15.0f - 1e-4f) / 15.0f); const float ang = wv * f; feat = (lane <= 16) ? cosf(ang) : -sinf(ang); }
          float z = fb1[lane];
#pragma unroll
          for (int f = 0; f < 33; ++f) z += __shfl(feat, f) * fw1[f * 64 + lane];
          float h = sinf(sf[lane] * z);
          z = fb2[lane];
#pragma unroll 8
          for (int j = 0; j < 64; ++j) z += __shfl(h, j) * fw2[j * 64 + lane];
          h = sinf(sf[64 + lane] * z);
          z = fb3[lane];
#pragma unroll 8
          for (int j = 0; j < 64; ++j) z += __shfl(h, j) * fw3[j * 64 + lane];
          h = sinf(sf[128 + lane] * z);
          H3T[lane * SEQ + pos] = h;
      } }
}

__device__ __forceinline__ void p2_prep(Frame& F, const Args& AR) {
    unsigned char* ws = F.ws; const int tid = F.tid, lane = F.lane;
    const int gw = F.bid * NWAVES + F.wave, NGW = F.G * NWAVES;
    { const bf16* PH = (const bf16*)(ws + WS_PH); bf16* HT = (bf16*)((unsigned char*)F.out + DO_HT);
      const float* cw = AR.in[2]; const float* cb = AR.in[3];
      LAS bf16* raw = (LAS bf16*)(F.lds + F.wave * 9216);
      constexpr int NIT = NB * (SEQ / 64) * (PH_P / 64);
      const int lr = lane >> 3, lc = lane & 7;
      for (int it = gw; it < NIT; it += NGW) {
          const int cbk = it % 24, tb = (it / 24) % 64, b = it / (24 * 64); const int t0 = tb * 64, c0 = cbk * 64;
          const bf16* src = PH + ((size_t)b * SEQ + t0) * PH_P + c0 + 8 * lc;
          v4u v[9];
#pragma unroll
          for (int i = 0; i < 8; ++i) v[i] = *(const v4u*)(src + (size_t)(lr + 8 * i) * PH_P);
          { const int hrow = (lane < 8) ? -1 : 64; const int t = t0 + hrow; v[8] = (v4u){0u, 0u, 0u, 0u};
            if (lane < 16 && t >= 0 && t < SEQ) v[8] = *(const v4u*)(src + (ptrdiff_t)hrow * PH_P); }
#pragma unroll
          for (int i = 0; i < 8; ++i) { LAS unsigned* d = (LAS unsigned*)(raw + (1 + lr + 8 * i) * 66 + 8 * lc); d[0] = v[i].x; d[1] = v[i].y; d[2] = v[i].z; d[3] = v[i].w; }
          if (lane < 16) { LAS unsigned* d = (LAS unsigned*)(raw + ((lane < 8) ? 0 : 65) * 66 + 8 * lc); d[0] = v[8].x; d[1] = v[8].y; d[2] = v[8].z; d[3] = v[8].w; }
          asm volatile("s_waitcnt lgkmcnt(0)" ::: "memory");
          const int col = c0 + lane;
          const float w0 = cw[col], w1 = cw[PH_P + col], w2 = cw[2 * PH_P + col], bb = cb[col];
          const int which = col >> 9, c = col & 511;
          v4u* dst = (v4u*)(HT + (((size_t)which * 512 + c) * NB + b) * SEQ + t0);
          float pv = bf2f(raw[lane]), cv = bf2f(raw[66 + lane]);
#pragma unroll
          for (int q8 = 0; q8 < 8; ++q8) {
              float o[8];
#pragma unroll
              for (int i = 0; i < 8; ++i) { const float nv = bf2f(raw[(8 * q8 + i + 2) * 66 + lane]); o[i] = w0 * pv + w1 * cv + w2 * nv + bb; pv = cv; cv = nv; }
              v4u w; w.x = pk2(o[0], o[1]); w.y = pk2(o[2], o[3]); w.z = pk2(o[4], o[5]); w.w = pk2(o[6], o[7]);
              dst[q8] = w;
          }
          asm volatile("s_waitcnt lgkmcnt(0)" ::: "memory");
      }
    }
    const size_t gt = (size_t)F.bid * 512 + tid, NT = (size_t)F.G * 512;
    { const bf16* PR = (const bf16*)(ws + WS_PR); bf16* LIN = (bf16*)(ws + WS_TOP); const float* mu = AR.in[13];
      for (size_t i = gt; i < (size_t)M * 96; i += NT) {
          const int m = (int)(i / 96), cg4 = (int)(i % 96), t = m & (SEQ - 1); const int col = 1536 + 4 * cg4;
          const bf16* p = PR + (size_t)m * PR_P + col;
          const v2u c = *(const v2u*)p; v2u pv = {0u, 0u}, nv = {0u, 0u};
          if (t > 0) pv = *(const v2u*)(p - PR_P);
          if (t < SEQ - 1) nv = *(const v2u*)(p + PR_P);
          const f32x4 muv = *(const f32x4*)(mu + col);
          float u[4], pr[4], nx[4];
          u[0] = bflo(c.x); u[1] = bfhi(c.x); u[2] = bflo(c.y); u[3] = bfhi(c.y);
          pr[0] = bflo(pv.x); pr[1] = bfhi(pv.x); pr[2] = bflo(pv.y); pr[3] = bfhi(pv.y);
          nx[0] = bflo(nv.x); nx[1] = bfhi(nv.x); nx[2] = bflo(nv.y); nx[3] = bfhi(nv.y);
#pragma unroll
          for (int j = 0; j < 4; ++j) { float sft = u[j] + muv[j] * (0.5f * (pr[j] + nx[j]) - u[j]);
              if (cg4 < 32) sft = 2.0f * fsig(2.0f * sft) - 1.0f; else if (cg4 >= 64) sft = fsig(sft); u[j] = sft; }
          v2u o; o.x = pk2(u[0], u[1]); o.y = pk2(u[2], u[3]);
          *(v2u*)(LIN + (size_t)m * LORA_K + 4 * cg4) = o;
      } }
    { const float* H3T = (const float*)(ws + WS_H3T); const float* fw4 = AR.in[10]; const float* skip = AR.in[12];
      bf16* FT = (bf16*)(ws + WS_FT);
      for (int it = gw; it < 64 * 128; it += NGW) {
          const int pb = it & 63, cb8 = it >> 6; const int o = cb8 >> 6, c0 = (cb8 & 63) * 8;
          const int pos = pb * 64 + lane;
          float hf[8], hb[8];
#pragma unroll
          for (int e = 0; e < 8; ++e) { hf[e] = 0.f; hb[e] = 0.f; }
          const float* wrow = fw4 + o * 1024 + c0;
#pragma unroll 4
          for (int j = 0; j < 64; ++j) {
              const float hv = H3T[j * SEQ + pos];
              const f32x4 a0 = *(const f32x4*)(wrow + (size_t)j * 2048), a1 = *(const f32x4*)(wrow + (size_t)j * 2048 + 4);
              const f32x4 b0 = *(const f32x4*)(wrow + (size_t)j * 2048 + 512), b1 = *(const f32x4*)(wrow + (size_t)j * 2048 + 516);
#pragma unroll
              for (int e = 0; e < 4; ++e) { hf[e] += hv * a0[e]; hf[4 + e] += hv * a1[e]; hb[e] += hv * b0[e]; hb[4 + e] += hv * b1[e]; }
          }
          const float tpos = (float)pos / 4095.0f;
#pragma unroll
          for (int e = 0; e < 8; ++e) {
              const int c = c0 + e;
              const float delta = fabsf(HY_MIN_DECAY + (float)c * ((HY_MAX_DECAY - HY_MIN_DECAY) / 511.0f));
              bf16* TE = FT + (size_t)(o * 512 + c) * 16384; bf16* TO = TE + 8192;
              const float win = expf(-tpos * delta);
              if (pos == 0) { const bf16 v = (bf16)f2bf(hf[e] + hb[e] + skip[o * 512 + c]); TE[2 * 2048] = v; TO[2 * 2048 + 1] = v; TE[0] = 0; TE[1] = 0; TO[1] = 0; }
              else {
                  const bf16 vf = (bf16)f2bf(hf[e] * win), vb = (bf16)f2bf(hb[e] * win);
                  { const int d = pos, n = d >> 1;
                    if (d & 1) { TO[2 * (n + 2048)] = vf; if (n + 1 + 2048 < 4096) TE[2 * (n + 1 + 2048) + 1] = vf; }
                    else { TE[2 * (n + 2048)] = vf; TO[2 * (n + 2048) + 1] = vf; } }
                  { const int d = -pos, n = d >> 1;
                    if (d & 1) { TO[2 * (n + 2048)] = vb; TE[2 * (n + 1 + 2048) + 1] = vb; }
                    else { TE[2 * (n + 2048)] = vb; TO[2 * (n + 2048) + 1] = vb; } }
              }
          }
      } }
}

constexpr int HL_TE = 0, HL_TO = 16384 + 64, HL_Z = 32896, HZ_ROW = 80, HZ_PAD = 24;

__device__ __forceinline__ void hyena_item(Frame& F, const Args& AR, int c, bool dry) {
    LAS unsigned char* lds = F.lds; const int tid = F.tid, lane = F.lane, wave = F.wave;
    bf16* HT = (bf16*)((unsigned char*)F.out + DO_HT);
    const bf16* FT = (const bf16*)(F.ws + WS_FT);
    const int r = lane & 31, h = lane >> 5, par = r & 1;
    __syncthreads();
    if (tid < 240) { const int rr = tid / 5, ch = tid % 5; const int row = rr < 24 ? rr : 1024 + rr; v4u z = {0u, 0u, 0u, 0u}; *(LAS v4u*)(lds + HL_Z + row * HZ_ROW + 16 * ch) = z; }
    { const v4u* src = (const v4u*)(HT + ((size_t)0 * 512 + c) * NB * SEQ);
#pragma unroll
      for (int it = 0; it < 8; ++it) { const int rem = tid; const v4u v = src[it * 512 + rem];
          *(LAS v4u*)(lds + HL_Z + (((rem >> 2) * 8 + it) + HZ_PAD) * HZ_ROW + (rem & 3) * 16) = v; } }
    const int nb0 = 4 * wave;
    const int ta = (par ? HL_TO : HL_TE) + 4 * (((r - par) >> 1) - 4 * h + 2048);
    const int zb = HL_Z + (32 * nb0 + r + HZ_PAD) * HZ_ROW + 16 * h;
#define HY_LOADA(q_, AV) do { const LAS unsigned* tp_ = (const LAS unsigned*)(lds + ta + 64 * (q_)); \
        AV[0].x = tp_[0]; AV[0].y = tp_[-1]; AV[0].z = tp_[-2]; AV[0].w = tp_[-3]; AV[1].x = tp_[-8]; AV[1].y = tp_[-9]; AV[1].z = tp_[-10]; AV[1].w = tp_[-11]; } while (0)
#define HY_LOADB1(q_, BV, nn_) do { const LAS unsigned char* zp_ = lds + zb - 640 * (q_) + 2560 * (nn_); BV[0][nn_] = *(const LAS bf16x8*)zp_; BV[1][nn_] = *(const LAS bf16x8*)(zp_ + 32); } while (0)
#define HY_MMA1(AV, BV, nn_) do { acc[nn_] = __builtin_amdgcn_mfma_f32_32x32x16_bf16(__builtin_bit_cast(bf16x8, AV[0]), BV[0][nn_], acc[nn_], 0, 0, 0); \
        acc[nn_] = __builtin_amdgcn_mfma_f32_32x32x16_bf16(__builtin_bit_cast(bf16x8, AV[1]), BV[1][nn_], acc[nn_], 0, 0, 0); } while (0)
#define HY_PART(q_, M0, M1, M2, M3) do { v4u av_[2]; bf16x8 bv_[2][4]; HY_LOADA(q_, av_); \
        if (M0) HY_LOADB1(q_, bv_, 0); if (M1) HY_LOADB1(q_, bv_, 1); if (M2) HY_LOADB1(q_, bv_, 2); if (M3) HY_LOADB1(q_, bv_, 3); \
        if (M0) HY_MMA1(av_, bv_, 0); if (M1) HY_MMA1(av_, bv_, 1); if (M2) HY_MMA1(av_, bv_, 2); if (M3) HY_MMA1(av_, bv_, 3); } while (0)
#pragma unroll 1
    for (int o = 0; o < 2; ++o) {
        { const v4u* src = (const v4u*)(FT + ((size_t)o * 512 + c) * 16384);
#pragma unroll
          for (int it = 0; it < 4; ++it) { const int e = it * 512 + tid; const v4u v = src[e]; *(LAS v4u*)(lds + (e < 1024 ? HL_TE + e * 16 : HL_TO + (e - 1024) * 16)) = v; } }
        const bf16* XG = HT + ((size_t)(1 + o) * 512 + c) * NB * SEQ;
        v2u xv[4][4];
#pragma unroll
        for (int nn = 0; nn < 4; ++nn) { const int colg = 32 * (nb0 + nn) + r, tb = colg >> 3, b = colg & 7;
#pragma unroll
            for (int g = 0; g < 4; ++g) xv[nn][g] = *(const v2u*)(XG + (size_t)b * SEQ + 32 * tb + 8 * g + 4 * h); }
        __syncthreads();
        f32x16 acc[4];
#pragma unroll
        for (int nn = 0; nn < 4; ++nn)
#pragma unroll
            for (int j = 0; j < 16; ++j) acc[nn][j] = 0.f;
        const int qw = 16 * wave;
#pragma unroll 1
        for (int q = qw - 127; q < qw - 123; ++q) HY_PART(q, 1, 0, 0, 0);
#pragma unroll 1
        for (int q = qw - 123; q < qw - 119; ++q) HY_PART(q, 1, 1, 0, 0);
#pragma unroll 1
        for (int q = qw - 119; q < qw - 115; ++q) HY_PART(q, 1, 1, 1, 0);
        {
            v4u a0[2], a1[2]; bf16x8 b0[2][4], b1[2][4];
            HY_LOADA(qw - 115, a0); HY_LOADB1(qw - 115, b0, 0); HY_LOADB1(qw - 115, b0, 1); HY_LOADB1(qw - 115, b0, 2); HY_LOADB1(qw - 115, b0, 3);
#pragma unroll 1
            for (int q = qw - 115; q <= qw + 3; q += 2) {
                HY_LOADA(q + 1, a1); HY_LOADB1(q + 1, b1, 0); HY_LOADB1(q + 1, b1, 1); HY_LOADB1(q + 1, b1, 2); HY_LOADB1(q + 1, b1, 3);
                HY_MMA1(a0, b0, 0); HY_MMA1(a0, b0, 1); HY_MMA1(a0, b0, 2); HY_MMA1(a0, b0, 3);
                if (q + 1 <= qw + 3) {
                    HY_LOADA(q + 2, a0); HY_LOADB1(q + 2, b0, 0); HY_LOADB1(q + 2, b0, 1); HY_LOADB1(q + 2, b0, 2); HY_LOADB1(q + 2, b0, 3);
                    HY_MMA1(a1, b1, 0); HY_MMA1(a1, b1, 1); HY_MMA1(a1, b1, 2); HY_MMA1(a1, b1, 3);
                }
            }
        }
#pragma unroll 1
        for (int q = qw + 4; q < qw + 8; ++q) HY_PART(q, 0, 1, 1, 1);
#pragma unroll 1
        for (int q = qw + 8; q < qw + 12; ++q) HY_PART(q, 0, 0, 1, 1);
#pragma unroll 1
        for (int q = qw + 12; q < qw + 16; ++q) HY_PART(q, 0, 0, 0, 1);
        __syncthreads();
#pragma unroll
        for (int nn = 0; nn < 4; ++nn) {
            const int colg = 32 * (nb0 + nn) + r;
#pragma unroll
            for (int g = 0; g < 4; ++g) {
                const int i0 = 8 * g + 4 * h; const v2u x = xv[nn][g];
                v2u w; w.x = pk2(acc[nn][4 * g + 0] * bflo(x.x), acc[nn][4 * g + 1] * bfhi(x.x)); w.y = pk2(acc[nn][4 * g + 2] * bflo(x.y), acc[nn][4 * g + 3] * bfhi(x.y));
                *(LAS v2u*)(lds + HL_Z + (colg + HZ_PAD) * HZ_ROW + i0 * 2) = w;
            }
        }
        __syncthreads();
    }
#undef HY_LOADA
#undef HY_LOADB1
#undef HY_MMA1
#undef HY_PART
    if (!dry) { v4u* dst = (v4u*)(HT + ((size_t)0 * 512 + c) * NB * SEQ);
#pragma unroll
      for (int it = 0; it < 8; ++it) { const int rem = tid; dst[it * 512 + rem] = *(const LAS v4u*)(lds + HL_Z + (((rem >> 2) * 8 + it) + HZ_PAD) * HZ_ROW + (rem & 3) * 16); } }
}

constexpr int SC_SLOT = 464;
template <int CTRL> __device__ __forceinline__ float dppf(float x) { return __builtin_bit_cast(float, __builtin_amdgcn_update_dpp(0, __builtin_bit_cast(int, x), CTRL, 0xf, 0xf, true)); }
__device__ __forceinline__ float xsum16(float x) { float a = x, b = x; asm volatile("s_nop 1\n\tv_permlane16_swap_b32 %0, %1" : "+v"(a), "+v"(b)); return a + b; }
__device__ __forceinline__ float xsum32(float x) { float a = x, b = x; asm volatile("s_nop 1\n\tv_permlane32_swap_b32 %0, %1" : "+v"(a), "+v"(b)); return a + b; }
__device__ __forceinline__ float allsum4(const float (&p)[4], bool b0, bool b1) {
    const float m0 = b0 ? p[1] : p[0], g0 = b0 ? p[0] : p[1], m1 = b0 ? p[3] : p[2], g1 = b0 ? p[2] : p[3];
    const float q0 = m0 + dppf<0xB1>(g0), q1 = m1 + dppf<0xB1>(g1);
    const float mm = b1 ? q1 : q0, gg = b1 ? q0 : q1;
    float q = mm + dppf<0x4E>(gg);
    q += dppf<0x124>(q);
    q += dppf<0x128>(q);
    q = xsum16(q);
    q = xsum32(q);
    return q;
}
__device__ __forceinline__ float wave_allsum(float q) {
    q += dppf<0xB1>(q); q += dppf<0x4E>(q); q += dppf<0x124>(q); q += dppf<0x128>(q); q = xsum16(q); q = xsum32(q); return q;
}
constexpr int SC_YOFF = 16 * SC_SLOT;
struct ScanRaw { unsigned rc, kc, vc, rp, kp, vp, rn, kn, vn, wd, ad; };
__device__ __forceinline__ void rwkv_scan(Frame& F, const Args& AR, int bid) {
    const int seq = (bid & 7) + 8 * (bid >> 4), half = (bid >> 3) & 1;
    const int dir = seq >> 6, b = (seq >> 3) & 7, h = seq & 7, lane = F.lane, wave = F.wave, tid = F.tid;
    LAS float* ring = (LAS float*)F.lds;
    const int ch = h * 64 + lane, rbase = 32 * half + 4 * wave;
    const float* mu = AR.in[13];
    const float mu_r = mu[ch], mu_k = mu[512 + ch], mu_v = mu[1024 + ch];
    const float kk_c = AR.in[19][ch], ka_c = AR.in[20][ch], rk_c = AR.in[21][ch];
    const float w0_c = AR.in[14][dir * 512 + ch], a0_c = AR.in[16][dir * 512 + ch];
    const bf16* PRb = (const bf16*)(F.ws + WS_PR) + (size_t)b * SEQ * PR_P + ch;
    const bf16* Wd = (const bf16*)(F.ws + WS_LW) + (size_t)dir * ((size_t)M * 512) + (size_t)b * SEQ * 512 + ch;
    const bf16* Ad = (const bf16*)(F.ws + WS_LW) + (size_t)(2 + dir) * ((size_t)M * 512) + (size_t)b * SEQ * 512 + ch;
    bf16* YS = dir ? (bf16*)(F.ws + WS_TOP) : (bf16*)((unsigned char*)F.out + DO_YSF);
    YS += (size_t)b * SEQ * 512 + h * 64 + 32 * half;
    float* BON = (float*)(F.ws + WS_BONUS) + ((size_t)dir * M + (size_t)b * SEQ) * 8;
    float S[4];
#pragma unroll
    for (int i = 0; i < 4; ++i) S[i] = 0.f;
    const bool b0 = (lane & 1) != 0, b1 = (lane & 2) != 0;
    ScanRaw R;
#define SC_LOAD(jj) do { const int s_ = 8 * (jj) + wave, tau_ = dir ? SEQ - 1 - s_ : s_; const bf16* row_ = PRb + (size_t)tau_ * PR_P; \
        const int up_ = tau_ > 0 ? -PR_P : 0, dn_ = tau_ < SEQ - 1 ? PR_P : 0; \
        R.rc = row_[0]; R.kc = row_[512]; R.vc = row_[1024]; R.rp = row_[up_]; R.kp = row_[512 + up_]; R.vp = row_[1024 + up_]; \
        R.rn = row_[dn_]; R.kn = row_[512 + dn_]; R.vn = row_[1024 + dn_]; R.wd = Wd[(size_t)tau_ * 512]; R.ad = Ad[(size_t)tau_ * 512]; } while (0)
    SC_LOAD(0);
    __syncthreads();
#pragma unroll 1
    for (int j = 0; j < SEQ / 8; ++j) {
        {
            const int s = 8 * j + wave, tau = dir ? SEQ - 1 - s : s;
            const float rc = bf2f(R.rc), kc = bf2f(R.kc), vc = bf2f(R.vc);
            const float pm = tau > 0 ? 1.f : 0.f, nm = tau < SEQ - 1 ? 1.f : 0.f;
            const float rp = pm * bf2f(R.rp), kp = pm * bf2f(R.kp), vp = pm * bf2f(R.vp), rn = nm * bf2f(R.rn), kn = nm * bf2f(R.kn), vn = nm * bf2f(R.vn);
            const float rr = rc + mu_r * (0.5f * (rp + rn) - rc), kx = kc + mu_k * (0.5f * (kp + kn) - kc), vx = vc + mu_v * (0.5f * (vp + vn) - vc);
            const float wv = __expf(-0.60653065971f * sigmoidf_(w0_c + bf2f(R.wd))), av = sigmoidf_(a0_c + bf2f(R.ad));
            const float kkr = kx * kk_c; const float ss = wave_allsum(kkr * kkr); const float kk = kkr / fmaxf(sqrtf(ss), 1e-12f);
            const float kd = kx * (1.0f + (av - 1.0f) * ka_c), kka = kk * av;
            const float c2 = wave_allsum(rr * kd), c1 = wave_allsum(rr * kka);
            const float bon = wave_allsum(rr * kd * rk_c);
            LAS float* sl = ring + ((j & 1) * 8 + wave) * SC_SLOT;
            sl[lane] = -kk; sl[64 + lane] = wv; sl[128 + lane] = kka; sl[192 + lane] = kd; sl[256 + lane] = wv * rr; sl[320 + lane] = vx; sl[384 + lane] = vx * c2;
            if (lane == 0) sl[448] = c1;
            if (lane == 0 && half == 0) BON[(size_t)tau * 8 + h] = bon;
        }
        if (j + 1 < SEQ / 8) SC_LOAD(j + 1);
        __syncthreads();
        if (j > 0 && tid < 256) {
            const int u = tid >> 5, rrow = tid & 31, s = 8 * (j - 1) + u, tau = dir ? SEQ - 1 - s : s;
            YS[(size_t)tau * 512 + rrow] = (bf16)f2bf(ring[SC_YOFF + (((j - 1) & 1) * 8 + u) * 32 + rrow]);
        }
        {
            const LAS float* sl0 = ring + ((j & 1) * 8) * SC_SLOT;
            float nkk = sl0[lane], w = sl0[64 + lane], kka = sl0[128 + lane], kd = sl0[192 + lane], wr = sl0[256 + lane], vc2 = sl0[384 + rbase + (lane & 3)], c1 = sl0[448];
            f32x4 va = *(const LAS f32x4*)(sl0 + 320 + rbase);
#pragma unroll
            for (int u = 0; u < 8; ++u) {
                float nkk_n = 0.f, w_n = 0.f, kka_n = 0.f, kd_n = 0.f, wr_n = 0.f, vc2_n = 0.f, c1_n = 0.f; f32x4 va_n = {0.f, 0.f, 0.f, 0.f};
                if (u < 7) { const LAS float* sl = sl0 + (u + 1) * SC_SLOT;
                    nkk_n = sl[lane]; w_n = sl[64 + lane]; kka_n = sl[128 + lane]; kd_n = sl[192 + lane]; wr_n = sl[256 + lane]; vc2_n = sl[384 + rbase + (lane & 3)]; c1_n = sl[448];
                    va_n = *(const LAS f32x4*)(sl + 320 + rbase); }
                float p[4], pp[4];
#pragma unroll
                for (int i = 0; i < 4; ++i) { p[i] = S[i] * nkk; pp[i] = S[i] * wr; }
                const float q = allsum4(p, b0, b1);
                const float qy = allsum4(pp, b0, b1);
                const float sa[4] = {dppf<0x00>(q), dppf<0x55>(q), dppf<0xAA>(q), dppf<0xFF>(q)};
#pragma unroll
                for (int i = 0; i < 4; ++i) S[i] = S[i] * w + (sa[i] * kka + va[i] * kd);
                const float y = qy + (q * c1 + vc2);
                if (lane < 4) ring[SC_YOFF + ((j & 1) * 8 + u) * 32 + 4 * wave + lane] = y;
                nkk = nkk_n; w = w_n; kka = kka_n; kd = kd_n; wr = wr_n; vc2 = vc2_n; c1 = c1_n; va = va_n;
            }
        }
    }
    __syncthreads();
    if (tid < 256) { const int j = SEQ / 8; const int u = tid >> 5, rrow = tid & 31, s = 8 * (j - 1) + u, tau = dir ? SEQ - 1 - s : s;
        YS[(size_t)tau * 512 + rrow] = (bf16)f2bf(ring[SC_YOFF + (((j - 1) & 1) * 8 + u) * 32 + rrow]); }
#undef SC_LOAD
}

constexpr int S2_W = 0, S2_KKA = 64, S2_KD = 128, S2_VX = 192, S2_C = 256, S2_NKKB = 260, S2_WRB = 292, S2_ZB = 324, S2_SLOT = 368;
constexpr int S2_YOFF = 16 * S2_SLOT;
__device__ __forceinline__ void rwkv_scan2(Frame& F, const Args& AR, int seq) {
    const int dir = seq >> 6, b = (seq >> 3) & 7, h = seq & 7, lane = F.lane, wave = F.wave, tid = F.tid;
    LAS float* ring = (LAS float*)F.lds;
    bf16* YS = dir ? (bf16*)(F.ws + WS_TOP) : (bf16*)((unsigned char*)F.out + DO_YSF);
    YS += (size_t)b * SEQ * 512 + h * 64;
    __syncthreads();
    for (int i = tid; i < 16 * 32; i += 512) ring[(i >> 5) * S2_SLOT + S2_ZB + (i & 31)] = 0.f;
    constexpr int NBLK = SEQ / 8;
    if (wave >= 4) {
        const int p = wave - 4, ch = h * 64 + lane;
        const float* mu = AR.in[13];
        const float mu_r = mu[ch], mu_k = mu[512 + ch], mu_v = mu[1024 + ch];
        const float kk_c = AR.in[19][ch], ka_c = AR.in[20][ch], rk_c = AR.in[21][ch];
        const float w0_c = AR.in[14][dir * 512 + ch], a0_c = AR.in[16][dir * 512 + ch];
        const bf16* PRb = (const bf16*)(F.ws + WS_PR) + (size_t)b * SEQ * PR_P + ch;
        const bf16* Wd = (const bf16*)(F.ws + WS_LW) + (size_t)dir * ((size_t)M * 512) + (size_t)b * SEQ * 512 + ch;
        const bf16* Ad = (const bf16*)(F.ws + WS_LW) + (size_t)(2 + dir) * ((size_t)M * 512) + (size_t)b * SEQ * 512 + ch;
        float* BON = (float*)(F.ws + WS_BONUS) + ((size_t)dir * M + (size_t)b * SEQ) * 8;
        ScanRaw R[2];
#define S2_LOAD(jj) do { _Pragma("unroll") for (int e_ = 0; e_ < 2; ++e_) { const int s_ = 8 * (jj) + p + 4 * e_, tau_ = dir ? SEQ - 1 - s_ : s_; const bf16* row_ = PRb + (size_t)tau_ * PR_P; \
            const int up_ = tau_ > 0 ? -PR_P : 0, dn_ = tau_ < SEQ - 1 ? PR_P : 0; \
            R[e_].rc = row_[0]; R[e_].kc = row_[512]; R[e_].vc = row_[1024]; R[e_].rp = row_[up_]; R[e_].kp = row_[512 + up_]; R[e_].vp = row_[1024 + up_]; \
            R[e_].rn = row_[dn_]; R[e_].kn = row_[512 + dn_]; R[e_].vn = row_[1024 + dn_]; R[e_].wd = Wd[(size_t)tau_ * 512]; R[e_].ad = Ad[(size_t)tau_ * 512]; } } while (0)
#define S2_PRODUCE(jj) do { _Pragma("unroll") for (int e_ = 0; e_ < 2; ++e_) { const int u_ = p + 4 * e_, s_ = 8 * (jj) + u_, tau_ = dir ? SEQ - 1 - s_ : s_; \
            const float rc = bf2f(R[e_].rc), kc = bf2f(R[e_].kc), vc = bf2f(R[e_].vc); \
            const float pm = tau_ > 0 ? 1.f : 0.f, nm = tau_ < SEQ - 1 ? 1.f : 0.f; \
            const float rp = pm * bf2f(R[e_].rp), kp = pm * bf2f(R[e_].kp), vp = pm * bf2f(R[e_].vp), rn = nm * bf2f(R[e_].rn), kn = nm * bf2f(R[e_].kn), vn = nm * bf2f(R[e_].vn); \
            const float rr = rc + mu_r * (0.5f * (rp + rn) - rc), kx = kc + mu_k * (0.5f * (kp + kn) - kc), vx = vc + mu_v * (0.5f * (vp + vn) - vc); \
            const float wv = __expf(-0.60653065971f * fsig(w0_c + bf2f(R[e_].wd))), av = fsig(a0_c + bf2f(R[e_].ad)); \
            const float kkr = kx * kk_c, kd = kx * (1.0f + (av - 1.0f) * ka_c), rkd = rr * kd; \
            const float ps_[4] = {kkr * kkr, rr * kkr * av, rkd, rkd * rk_c}; \
            const float tot_ = allsum4(ps_, (lane & 1) != 0, (lane & 2) != 0); \
            const float ss = dppf<0x00>(tot_), c1r = dppf<0x55>(tot_), c2 = dppf<0xAA>(tot_), bon = dppf<0xFF>(tot_); \
            const float rn_ = __builtin_amdgcn_rsqf(fmaxf(ss, 1e-24f)); const float kk = kkr * rn_, kka = kk * av, c1 = c1r * rn_; \
            LAS float* sl = ring + (((jj) & 1) * 8 + u_) * S2_SLOT; \
            sl[S2_W + lane] = wv; sl[S2_KKA + lane] = kka; sl[S2_KD + lane] = kd; sl[S2_VX + lane] = vx; \
            ((LAS bf16*)(sl + S2_NKKB))[lane] = (bf16)f2bf(-kk); ((LAS bf16*)(sl + S2_WRB))[lane] = (bf16)f2bf(wv * rr); \
            if (lane == 0) { sl[S2_C] = c1; sl[S2_C + 1] = c2; BON[(size_t)tau_ * 8 + h] = bon; } } } while (0)
        S2_LOAD(0); S2_PRODUCE(0); S2_LOAD(1);
        __syncthreads();
#pragma unroll 1
        for (int j = 0; j < NBLK; ++j) {
            if (j + 1 < NBLK) { S2_PRODUCE(j + 1); if (j + 2 < NBLK) S2_LOAD(j + 2); }
            if (j > 0) {
                const int pt = tid - 256;
#pragma unroll
                for (int e = 0; e < 2; ++e) { const int idx = pt + 256 * e, u = idx >> 6, rrow = idx & 63, s = 8 * (j - 1) + u, tau = dir ? SEQ - 1 - s : s;
                    YS[(size_t)tau * 512 + rrow] = (bf16)f2bf(ring[S2_YOFF + (((j - 1) & 1) * 8 + u) * 64 + rrow]); }
            }
            __syncthreads();
        }
        { const int j = NBLK; const int pt = tid - 256;
#pragma unroll
          for (int e = 0; e < 2; ++e) { const int idx = pt + 256 * e, u = idx >> 6, rrow = idx & 63, s = 8 * (j - 1) + u, tau = dir ? SEQ - 1 - s : s;
              YS[(size_t)tau * 512 + rrow] = (bf16)f2bf(ring[S2_YOFF + (((j - 1) & 1) * 8 + u) * 64 + rrow]); } }
#undef S2_LOAD
#undef S2_PRODUCE
    } else {
        const int c = lane & 15, g = lane >> 4, row = 16 * wave + c;
        const int aoff = (((c & 3) == 0) ? S2_NKKB : ((c & 3) == 1) ? S2_WRB : S2_ZB) * 4 + (((c & 3) < 2) ? 16 * g : 0);
        const int aoff1 = aoff + (((c & 3) < 2) ? 64 : 0);
        float S[16];
#pragma unroll
        for (int i = 0; i < 16; ++i) S[i] = 0.f;
        __syncthreads();
#pragma unroll 1
        for (int j = 0; j < NBLK; ++j) {
            const LAS float* sl0 = ring + ((j & 1) * 8) * S2_SLOT;
            f32x4 w4[4], ka4[4], kd4[4]; bf16x8 A0, A1; float vv, c1, c2;
#define S2_CLOAD(sl) do { const LAS float* sl_ = (sl); \
            w4[0] = *(const LAS f32x4*)(sl_ + S2_W + 8 * g); w4[1] = *(const LAS f32x4*)(sl_ + S2_W + 8 * g + 4); w4[2] = *(const LAS f32x4*)(sl_ + S2_W + 32 + 8 * g); w4[3] = *(const LAS f32x4*)(sl_ + S2_W + 36 + 8 * g); \
            ka4[0] = *(const LAS f32x4*)(sl_ + S2_KKA + 8 * g); ka4[1] = *(const LAS f32x4*)(sl_ + S2_KKA + 8 * g + 4); ka4[2] = *(const LAS f32x4*)(sl_ + S2_KKA + 32 + 8 * g); ka4[3] = *(const LAS f32x4*)(sl_ + S2_KKA + 36 + 8 * g); \
            kd4[0] = *(const LAS f32x4*)(sl_ + S2_KD + 8 * g); kd4[1] = *(const LAS f32x4*)(sl_ + S2_KD + 8 * g + 4); kd4[2] = *(const LAS f32x4*)(sl_ + S2_KD + 32 + 8 * g); kd4[3] = *(const LAS f32x4*)(sl_ + S2_KD + 36 + 8 * g); \
            A0 = *(const LAS bf16x8*)((const LAS unsigned char*)sl_ + aoff); A1 = *(const LAS bf16x8*)((const LAS unsigned char*)sl_ + aoff1); \
            vv = sl_[S2_VX + row]; c1 = sl_[S2_C]; c2 = sl_[S2_C + 1]; } while (0)
            S2_CLOAD(sl0);
#pragma unroll
            for (int u = 0; u < 8; ++u) {
                const f32x4 cw0 = w4[0], cw1 = w4[1], cw2 = w4[2], cw3 = w4[3], ca0 = ka4[0], ca1 = ka4[1], ca2 = ka4[2], ca3 = ka4[3], cd0 = kd4[0], cd1 = kd4[1], cd2 = kd4[2], cd3 = kd4[3];
                const bf16x8 cA0 = A0, cA1 = A1; const float cvv = vv, cc1 = c1, cc2 = c2;
                if (u < 7) S2_CLOAD(sl0 + (u + 1) * S2_SLOT);
                v4u b0v, b1v;
                b0v.x = cvt_pk_bf16(S[0], S[1]); b0v.y = cvt_pk_bf16(S[2], S[3]); b0v.z = cvt_pk_bf16(S[4], S[5]); b0v.w = cvt_pk_bf16(S[6], S[7]);
                b1v.x = cvt_pk_bf16(S[8], S[9]); b1v.y = cvt_pk_bf16(S[10], S[11]); b1v.z = cvt_pk_bf16(S[12], S[13]); b1v.w = cvt_pk_bf16(S[14], S[15]);
                const f32x4 zz = {0.f, 0.f, 0.f, 0.f};
                const f32x4 acc0 = __builtin_amdgcn_mfma_f32_16x16x32_bf16(cA0, __builtin_bit_cast(bf16x8, b0v), zz, 0, 0, 0);
                const f32x4 acc1 = __builtin_amdgcn_mfma_f32_16x16x32_bf16(cA1, __builtin_bit_cast(bf16x8, b1v), zz, 0, 0, 0);
                float t[16];
#pragma unroll
                for (int i = 0; i < 4; ++i) {
                    t[i] = S[i] * cw0[i] + cvv * cd0[i]; t[4 + i] = S[4 + i] * cw1[i] + cvv * cd1[i];
                    t[8 + i] = S[8 + i] * cw2[i] + cvv * cd2[i]; t[12 + i] = S[12 + i] * cw3[i] + cvv * cd3[i];
                }
                const float sa = acc0[0] + acc1[0], yp = acc0[1] + acc1[1];
#pragma unroll
                for (int i = 0; i < 4; ++i) {
                    S[i] = sa * ca0[i] + t[i]; S[4 + i] = sa * ca1[i] + t[4 + i]; S[8 + i] = sa * ca2[i] + t[8 + i]; S[12 + i] = sa * ca3[i] + t[12 + i];
                }
                const float y = yp + (sa * cc1 + cvv * cc2);
                if (g == 0) ring[S2_YOFF + ((j & 1) * 8 + u) * 64 + row] = y;
            }
            __syncthreads();
        }
#undef S2_CLOAD
    }
    __syncthreads();
}

constexpr int S3_IMG_A = 0, S3_IMG_R = 2048, S3_A4 = 4096, S3_ALU = 8192, S3_ALY = 9216, S3_VB = 10240, S3_PC = 12288, S3_SLOT = 12544;
constexpr int S3_NSLOT = 6;
constexpr int S3_SCR = S3_NSLOT * S3_SLOT;
constexpr int S3_SCR_SZ = 6144;
constexpr int S3_FLAGS = S3_SCR + 4 * S3_SCR_SZ;
constexpr unsigned S3_SPIN = 1u << 22;
struct S3Raw { unsigned r, k, v, wd, ad; };
__device__ __forceinline__ float allsum2_bcast(float p0, float p1, bool b0, float& o1) {
    const float m = b0 ? p1 : p0, g = b0 ? p0 : p1;
    float q = m + dppf<0xB1>(g);
    q += dppf<0x4E>(q); q += dppf<0x124>(q); q += dppf<0x128>(q); q = xsum16(q); q = xsum32(q);
    o1 = dppf<0xF5>(q);
    return dppf<0xA0>(q);
}
__device__ __forceinline__ void rwkv_scan3(Frame& F, const Args& AR, int seq) {
    const int dir = seq >> 6, b = (seq >> 3) & 7, h = seq & 7, lane = F.lane, wave = F.wave, tid = F.tid;
    LAS unsigned char* lds = F.lds;
    volatile LAS unsigned* flags = (volatile LAS unsigned*)(lds + S3_FLAGS);
    constexpr int NBLK = SEQ / 16;
    __syncthreads();
    if (tid < 64) flags[tid] = 0u;
    __syncthreads();
    if (wave >= 4) {
        const int p = wave - 4, ch = h * 64 + lane;
        const float* mu = AR.in[13];
        const float mu_r = mu[ch], mu_k = mu[512 + ch], mu_v = mu[1024 + ch];
        const float kk_c = AR.in[19][ch], ka_c = AR.in[20][ch], rk_c = AR.in[21][ch];
        const float w0_c = AR.in[14][dir * 512 + ch], a0_c = AR.in[16][dir * 512 + ch];
        const bf16* PRb = (const bf16*)(F.ws + WS_PR) + (size_t)b * SEQ * PR_P + ch;
        const bf16* Wd = (const bf16*)(F.ws + WS_LW) + (size_t)dir * ((size_t)M * 512) + (size_t)b * SEQ * 512 + ch;
        const bf16* Ad = (const bf16*)(F.ws + WS_LW) + (size_t)(2 + dir) * ((size_t)M * 512) + (size_t)b * SEQ * 512 + ch;
        float* BON = (float*)(F.ws + WS_BONUS) + ((size_t)dir * M + (size_t)b * SEQ) * 8;
        LAS unsigned char* scr = lds + S3_SCR + p * S3_SCR_SZ;
        const int k32 = lane & 31, kbk = lane >> 5, gk = (k32 >> 2) & 3, jk = 4 * (k32 >> 4) + (k32 & 3);
        const int img_off = ((kbk * 64 + 16 * gk) * 8 + jk) * 2;
        const bool b0 = (lane & 1) != 0;
#define S3_LOAD(RR, blk_, e_, with_da) do { const int t_ = 16 * (blk_) + (e_); const bool ok_ = (t_ >= 0) && (t_ < SEQ) && ((blk_) < NBLK); \
            const int tc_ = ok_ ? t_ : 0; const int tau_ = dir ? SEQ - 1 - tc_ : tc_; const bf16* row_ = PRb + (size_t)tau_ * PR_P; \
            RR.r = ok_ ? (unsigned)row_[0] : 0u; RR.k = ok_ ? (unsigned)row_[512] : 0u; RR.v = ok_ ? (unsigned)row_[1024] : 0u; \
            if (with_da) { RR.wd = Wd[(size_t)tau_ * 512]; RR.ad = Ad[(size_t)tau_ * 512]; } } while (0)
        S3Raw R[8], Hm, H16;
        {
            S3_LOAD(Hm, p, -1, false);
#pragma unroll
            for (int e = 0; e < 8; ++e) S3_LOAD(R[e], p, e, true);
        }
#pragma unroll 1
        for (int blk = p; blk < NBLK; blk += 4) {
            const int slot = blk % S3_NSLOT;
            LAS unsigned char* sl = lds + slot * S3_SLOT;
            if (blk >= S3_NSLOT) {
                unsigned sp = 0; const unsigned want = (unsigned)(blk - S3_NSLOT + 1);
                while (flags[8 + slot * 4 + 0] < want || flags[8 + slot * 4 + 1] < want || flags[8 + slot * 4 + 2] < want || flags[8 + slot * 4 + 3] < want) {
                    __builtin_amdgcn_s_sleep(2); if (++sp > S3_SPIN) { flags[63] = 1u; break; } }
            }
            asm volatile("" ::: "memory");
            float bbar[16], kbar[16];
            float P = 1.0f;
            float cr = 0.f, ck = 0.f, cv = 0.f, pr = bf2f(Hm.r), pk = bf2f(Hm.k), pv = bf2f(Hm.v);
            cr = bf2f(R[0].r); ck = bf2f(R[0].k); cv = bf2f(R[0].v);
#pragma unroll
            for (int s = 0; s < 16; ++s) {
                if (s == 8) S3_LOAD(H16, blk, 16, false);
                float nr, nk, nv;
                if (s < 15) { nr = bf2f(R[(s + 1) & 7].r); nk = bf2f(R[(s + 1) & 7].k); nv = bf2f(R[(s + 1) & 7].v); }
                else { nr = bf2f(H16.r); nk = bf2f(H16.k); nv = bf2f(H16.v); }
                const float wdv = bf2f(R[s & 7].wd), adv = bf2f(R[s & 7].ad);
                if (s < 8) S3_LOAD(R[s & 7], blk, s + 8, true); else S3_LOAD(R[s & 7], blk + 4, s - 8, true);
                if (s == 15) S3_LOAD(Hm, blk + 4, -1, false);
                const int t = 16 * blk + s, tau = dir ? SEQ - 1 - t : t;
                const float rr = cr + mu_r * (0.5f * (pr + nr) - cr), kx = ck + mu_k * (0.5f * (pk + nk) - ck), vx = cv + mu_v * (0.5f * (pv + nv) - cv);
                const float wv = __expf(-0.60653065971f * fsig(w0_c + wdv)), av = fsig(a0_c + adv);
                const float kkr = kx * kk_c, kd = kx * (1.0f + (av - 1.0f) * ka_c);
                float bon; const float ss = allsum2_bcast(kkr * kkr, rr * kd * rk_c, b0, bon);
                const float kk = kkr * __builtin_amdgcn_rsqf(fmaxf(ss, 1e-24f)), kka = kk * av;
                const float Pprev = P; P = P * wv; const float iP = __builtin_amdgcn_rcpf(P);
                const float ab = -Pprev * kk, bb = kka * iP, kb = kd * iP, rb = P * rr;
                bbar[s] = bb; kbar[s] = kb;
                *(LAS bf16*)(sl + S3_IMG_A + img_off + 16 * s) = (bf16)f2bf(ab);
                *(LAS bf16*)(sl + S3_IMG_R + img_off + 16 * s) = (bf16)f2bf(rb);
                *(LAS bf16*)(scr + img_off + 16 * s) = (bf16)f2bf(bb);
                *(LAS bf16*)(scr + 2048 + img_off + 16 * s) = (bf16)f2bf(kb);
                *(LAS bf16*)(sl + S3_VB + lane * 32 + 2 * s) = (bf16)f2bf(vx);
                if (lane == 0) BON[(size_t)tau * 8 + h] = bon;
                pr = cr; pk = ck; pv = cv; cr = nr; ck = nk; cv = nv;
            }
            *(LAS float*)(sl + S3_PC + 4 * lane) = P;
#pragma unroll
            for (int g = 0; g < 4; ++g) {
                v4u w4; w4.x = cvtpk2(bbar[4 * g] * P, bbar[4 * g + 1] * P); w4.y = cvtpk2(bbar[4 * g + 2] * P, bbar[4 * g + 3] * P);
                w4.z = cvtpk2(kbar[4 * g] * P, kbar[4 * g + 1] * P); w4.w = cvtpk2(kbar[4 * g + 2] * P, kbar[4 * g + 3] * P);
                *(LAS v4u*)(sl + S3_A4 + (((lane >> 4) * 64 + (lane & 15) + 16 * g) * 16)) = w4;
            }
            asm volatile("s_waitcnt lgkmcnt(0)" ::: "memory");
            {
                const bf16x8 Ab0 = *(const LAS bf16x8*)(scr + lane * 16), Ab1 = *(const LAS bf16x8*)(scr + 1024 + lane * 16);
                const bf16x8 Ak0 = *(const LAS bf16x8*)(scr + 2048 + lane * 16), Ak1 = *(const LAS bf16x8*)(scr + 3072 + lane * 16);
                const bf16x8 Ba0 = *(const LAS bf16x8*)(sl + S3_IMG_A + lane * 16), Ba1 = *(const LAS bf16x8*)(sl + S3_IMG_A + 1024 + lane * 16);
                const bf16x8 Br0 = *(const LAS bf16x8*)(sl + S3_IMG_R + lane * 16), Br1 = *(const LAS bf16x8*)(sl + S3_IMG_R + 1024 + lane * 16);
                const f32x4 zz = {0.f, 0.f, 0.f, 0.f};
                f32x4 gab = __builtin_amdgcn_mfma_f32_16x16x32_bf16(Ab0, Ba0, zz, 0, 0, 0); gab = __builtin_amdgcn_mfma_f32_16x16x32_bf16(Ab1, Ba1, gab, 0, 0, 0);
                f32x4 gak = __builtin_amdgcn_mfma_f32_16x16x32_bf16(Ak0, Ba0, zz, 0, 0, 0); gak = __builtin_amdgcn_mfma_f32_16x16x32_bf16(Ak1, Ba1, gak, 0, 0, 0);
                f32x4 gbr = __builtin_amdgcn_mfma_f32_16x16x32_bf16(Ab0, Br0, zz, 0, 0, 0); gbr = __builtin_amdgcn_mfma_f32_16x16x32_bf16(Ab1, Br1, gbr, 0, 0, 0);
                f32x4 gkr = __builtin_amdgcn_mfma_f32_16x16x32_bf16(Ak0, Br0, zz, 0, 0, 0); gkr = __builtin_amdgcn_mfma_f32_16x16x32_bf16(Ak1, Br1, gkr, 0, 0, 0);
                const int tt = lane & 15, g4 = 4 * (lane >> 4);
#pragma unroll
                for (int e = 0; e < 4; ++e) { const bool lt = (g4 + e) < tt, le = (g4 + e) <= tt;
                    gab[e] = lt ? gab[e] : 0.f; gak[e] = lt ? gak[e] : 0.f; gbr[e] = le ? gbr[e] : 0.f; gkr[e] = le ? gkr[e] : 0.f; }
                v2u wk; wk.x = cvtpk2(gak[0], gak[1]); wk.y = cvtpk2(gak[2], gak[3]);
                *(LAS v2u*)(sl + S3_ALU + lane * 16 + 8) = wk;
                wk.x = cvtpk2(gkr[0], gkr[1]); wk.y = cvtpk2(gkr[2], gkr[3]);
                *(LAS v2u*)(sl + S3_ALY + lane * 16 + 8) = wk;
                *(LAS f32x4*)(scr + 4096 + (tt * 16 + g4) * 4) = gab;
#pragma unroll
                for (int e = 0; e < 4; ++e) *(LAS float*)(scr + 5120 + ((g4 + e) * 16 + tt) * 4) = gbr[e];
            }
            asm volatile("s_waitcnt lgkmcnt(0)" ::: "memory");
            {
                const int ti = lane & 15, q4 = 4 * (lane >> 4);
                float Tr[16];
#pragma unroll
                for (int t = 0; t < 16; ++t) {
                    float a = (ti == t) ? 1.0f : 0.0f;
#pragma unroll
                    for (int m4 = 0; m4 < (t + 3) / 4; ++m4) { const f32x4 lv = *(const LAS f32x4*)(scr + 4096 + (t * 16 + 4 * m4) * 4);
#pragma unroll
                        for (int e = 0; e < 4; ++e) if (4 * m4 + e < t) a += Tr[4 * m4 + e] * lv[e]; }
                    Tr[t] = a;
                }
                float tl[4] = {0.f, 0.f, 0.f, 0.f};
#pragma unroll
                for (int m = 0; m < 16; ++m) { const f32x4 lv = *(const LAS f32x4*)(scr + 5120 + (m * 16 + q4) * 4);
#pragma unroll
                    for (int e = 0; e < 4; ++e) tl[e] += Tr[m] * lv[e]; }
#pragma unroll
                for (int e = 0; e < 4; ++e) { const int t = q4 + e;
                    float tv = 0.f;
#pragma unroll
                    for (int t2 = 0; t2 < 16; ++t2) tv = (t2 == t) ? Tr[t2] : tv;
                    tv -= (ti == t) ? 1.0f : 0.0f;
                    const int off = ((t + 16 * (ti >> 2)) * 8 + (ti & 3)) * 2;
                    *(LAS bf16*)(sl + S3_ALU + off) = (bf16)f2bf(tv);
                    *(LAS bf16*)(sl + S3_ALY + off) = (bf16)f2bf(tl[e]); }
            }
            asm volatile("s_waitcnt lgkmcnt(0)" ::: "memory");
            if (lane == 0) flags[slot] = (unsigned)(blk + 1);
        }
#undef S3_LOAD
    } else {
        const int c = lane & 15, g = lane >> 4, row = 16 * wave + c;
        bf16* YS = dir ? (bf16*)(F.ws + WS_TOP) : (bf16*)((unsigned char*)F.out + DO_YSF);
        YS += (size_t)b * SEQ * 512 + h * 64 + row;
        f32x4 S0 = {0.f, 0.f, 0.f, 0.f}, S1 = S0, S2 = S0, S3 = S0;
#pragma unroll 1
        for (int blk = 0; blk < NBLK; ++blk) {
            const int slot = blk % S3_NSLOT;
            const LAS unsigned char* sl = lds + slot * S3_SLOT;
            { unsigned sp = 0; const unsigned want = (unsigned)(blk + 1);
              while (flags[slot] != want) { __builtin_amdgcn_s_sleep(1); if (++sp > S3_SPIN) { flags[63] = 1u; break; } } }
            asm volatile("" ::: "memory");
            const bf16x8 Aa0 = *(const LAS bf16x8*)(sl + S3_IMG_A + lane * 16), Aa1 = *(const LAS bf16x8*)(sl + S3_IMG_A + 1024 + lane * 16);
            const bf16x8 Ar0 = *(const LAS bf16x8*)(sl + S3_IMG_R + lane * 16), Ar1 = *(const LAS bf16x8*)(sl + S3_IMG_R + 1024 + lane * 16);
            const bf16x8 ALU = *(const LAS bf16x8*)(sl + S3_ALU + lane * 16), ALY = *(const LAS bf16x8*)(sl + S3_ALY + lane * 16);
            const bf16x8 A40 = *(const LAS bf16x8*)(sl + S3_A4 + lane * 16), A41 = *(const LAS bf16x8*)(sl + S3_A4 + 1024 + lane * 16);
            const bf16x8 A42 = *(const LAS bf16x8*)(sl + S3_A4 + 2048 + lane * 16), A43 = *(const LAS bf16x8*)(sl + S3_A4 + 3072 + lane * 16);
            const v2u vb = *(const LAS v2u*)(sl + S3_VB + row * 32 + 8 * g);
            const f32x4 pc0 = *(const LAS f32x4*)(sl + S3_PC + (4 * g) * 4), pc1 = *(const LAS f32x4*)(sl + S3_PC + (16 + 4 * g) * 4);
            const f32x4 pc2 = *(const LAS f32x4*)(sl + S3_PC + (32 + 4 * g) * 4), pc3 = *(const LAS f32x4*)(sl + S3_PC + (48 + 4 * g) * 4);
            v4u bs0, bs1;
            bs0.x = cvtpk2(S0[0], S0[1]); bs0.y = cvtpk2(S0[2], S0[3]); bs0.z = cvtpk2(S1[0], S1[1]); bs0.w = cvtpk2(S1[2], S1[3]);
            bs1.x = cvtpk2(S2[0], S2[1]); bs1.y = cvtpk2(S2[2], S2[3]); bs1.z = cvtpk2(S3[0], S3[1]); bs1.w = cvtpk2(S3[2], S3[3]);
            const f32x4 zz = {0.f, 0.f, 0.f, 0.f};
            f32x4 d1u = __builtin_amdgcn_mfma_f32_16x16x32_bf16(Aa0, __builtin_bit_cast(bf16x8, bs0), zz, 0, 0, 0);
            d1u = __builtin_amdgcn_mfma_f32_16x16x32_bf16(Aa1, __builtin_bit_cast(bf16x8, bs1), d1u, 0, 0, 0);
            f32x4 d1y = __builtin_amdgcn_mfma_f32_16x16x32_bf16(Ar0, __builtin_bit_cast(bf16x8, bs0), zz, 0, 0, 0);
            d1y = __builtin_amdgcn_mfma_f32_16x16x32_bf16(Ar1, __builtin_bit_cast(bf16x8, bs1), d1y, 0, 0, 0);
            v4u bv; bv.x = 0u; bv.y = 0u; bv.z = vb.x; bv.w = vb.y;
            const f32x4 Wm = __builtin_amdgcn_mfma_f32_16x16x32_bf16(ALU, __builtin_bit_cast(bf16x8, bv), d1u, 0, 0, 0);
            v4u bw; bw.x = cvtpk2(Wm[0], Wm[1]); bw.y = cvtpk2(Wm[2], Wm[3]); bw.z = 0u; bw.w = 0u;
            const f32x4 Um = __builtin_amdgcn_mfma_f32_16x16x32_bf16(ALU, __builtin_bit_cast(bf16x8, bw), Wm, 0, 0, 0);
            bw.z = vb.x; bw.w = vb.y;
            const f32x4 Ym = __builtin_amdgcn_mfma_f32_16x16x32_bf16(ALY, __builtin_bit_cast(bf16x8, bw), d1y, 0, 0, 0);
            v4u bu; bu.x = cvtpk2(Um[0], Um[1]); bu.y = cvtpk2(Um[2], Um[3]); bu.z = vb.x; bu.w = vb.y;
            S0 = __builtin_amdgcn_mfma_f32_16x16x32_bf16(A40, __builtin_bit_cast(bf16x8, bu), S0 * pc0, 0, 0, 0);
            S1 = __builtin_amdgcn_mfma_f32_16x16x32_bf16(A41, __builtin_bit_cast(bf16x8, bu), S1 * pc1, 0, 0, 0);
            S2 = __builtin_amdgcn_mfma_f32_16x16x32_bf16(A42, __builtin_bit_cast(bf16x8, bu), S2 * pc2, 0, 0, 0);
            S3 = __builtin_amdgcn_mfma_f32_16x16x32_bf16(A43, __builtin_bit_cast(bf16x8, bu), S3 * pc3, 0, 0, 0);
            asm volatile("s_waitcnt lgkmcnt(0)" ::: "memory");
            if (lane == 0) flags[8 + slot * 4 + wave] = (unsigned)(blk + 1);
#pragma unroll
            for (int e = 0; e < 4; ++e) { const int t = 16 * blk + 4 * g + e, tau = dir ? SEQ - 1 - t : t; YS[(size_t)tau * 512] = (bf16)f2bf(Ym[e]); }
        }
    }
    __syncthreads();
}

constexpr int CW_HYQ = 512;
__device__ __forceinline__ void p4_mixers(Frame& F, const Args& AR, bool do_scan, bool do_hy, bool dry) {
    if (F.bid < 128) { if (do_scan) rwkv_scan3(F, AR, F.bid); }
    if (do_hy) {
        volatile LAS unsigned* MISC = (volatile LAS unsigned*)(F.lds + 131072 + 320);
        unsigned* ctr = (unsigned*)F.ws + CW_HYQ + (dry ? 64 : 0);
        for (;;) {
            __syncthreads();
            if (F.tid == 0) MISC[16] = __hip_atomic_fetch_add(ctr, 1u, __ATOMIC_RELAXED, __HIP_MEMORY_SCOPE_AGENT);
            __syncthreads();
            const int c = (int)MISC[16];
            if (c >= 512) break;
            hyena_item(F, AR, c, dry);
        }
    }
}

__device__ __forceinline__ float row16_allsum(float q) { q += dppf<0xB1>(q); q += dppf<0x4E>(q); q += dppf<0x124>(q); q += dppf<0x128>(q); return q; }
__device__ __forceinline__ void p5_combine(Frame& F, const Args& AR, bool dry) {
    unsigned char* ws = F.ws; const int lane = F.lane;
    const int gw = F.bid * NWAVES + F.wave, NGW = F.G * NWAVES;
    {
      bf16* YSF = (bf16*)((unsigned char*)F.out + DO_YSF); const bf16* YSB = (const bf16*)(ws + WS_TOP);
      const bf16* PR = (const bf16*)(ws + WS_PR); const bf16* Gt = (const bf16*)(ws + WS_LW) + (size_t)4 * ((size_t)M * 512);
      const float* BON = (const float*)(ws + WS_BONUS);
      const int hh = gw & 1, ch0 = 256 * hh + 4 * lane, head = 4 * hh + (lane >> 4);
      const f32x4 gnw = *(const f32x4*)(AR.in[22] + ch0), gnb = *(const f32x4*)(AR.in[23] + ch0), muv = *(const f32x4*)(AR.in[13] + 1024 + ch0);
      for (int it0 = gw; it0 < 2 * M; it0 += 2 * NGW) {
          v2u yf[2], yb[2], gg[2], vc[2], vp[2], vn[2]; float bon[2];
#pragma unroll
          for (int e = 0; e < 2; ++e) { const int m = (it0 + e * NGW) >> 1, t = m & (SEQ - 1);
              yf[e] = *(const v2u*)(YSF + (size_t)m * 512 + ch0); yb[e] = *(const v2u*)(YSB + (size_t)m * 512 + ch0); gg[e] = *(const v2u*)(Gt + (size_t)m * 512 + ch0);
              const bf16* p = PR + (size_t)m * PR_P + 1024 + ch0; vc[e] = *(const v2u*)p;
              vp[e] = *(const v2u*)(p - (t > 0 ? PR_P : 0)); vn[e] = *(const v2u*)(p + (t < SEQ - 1 ? PR_P : 0));
              bon[e] = BON[(size_t)m * 8 + head] + BON[((size_t)M + m) * 8 + head]; }
#pragma unroll
          for (int e = 0; e < 2; ++e) { const int m = (it0 + e * NGW) >> 1, t = m & (SEQ - 1);
              const float pm = t > 0 ? 1.f : 0.f, nm = t < SEQ - 1 ? 1.f : 0.f;
              float y[4] = {bflo(yf[e].x) + bflo(yb[e].x), bfhi(yf[e].x) + bfhi(yb[e].x), bflo(yf[e].y) + bflo(yb[e].y), bfhi(yf[e].y) + bfhi(yb[e].y)};
              const float mean = row16_allsum((y[0] + y[1]) + (y[2] + y[3])) * (1.0f / 64.0f);
#pragma unroll
              for (int i = 0; i < 4; ++i) y[i] -= mean;
              const float var = row16_allsum((y[0] * y[0] + y[1] * y[1]) + (y[2] * y[2] + y[3] * y[3])) * (1.0f / 64.0f);
              const float rs = rsqrtf(var + GN_EPS);
              const float vcur[4] = {bflo(vc[e].x), bfhi(vc[e].x), bflo(vc[e].y), bfhi(vc[e].y)};
              const float vprv[4] = {bflo(vp[e].x), bfhi(vp[e].x), bflo(vp[e].y), bfhi(vp[e].y)};
              const float vnxt[4] = {bflo(vn[e].x), bfhi(vn[e].x), bflo(vn[e].y), bfhi(vn[e].y)};
              const float gv[4] = {bflo(gg[e].x), bfhi(gg[e].x), bflo(gg[e].y), bfhi(gg[e].y)};
              float o[4];
#pragma unroll
              for (int i = 0; i < 4; ++i) { const float vx = vcur[i] + muv[i] * (0.5f * (pm * vprv[i] + nm * vnxt[i]) - vcur[i]);
                  o[i] = (y[i] * rs * gnw[i] + gnb[i] + bon[e] * vx) * gv[i]; }
              v2u w; w.x = pk2(o[0], o[1]); w.y = pk2(o[2], o[3]);
              if (!dry) *(v2u*)(YSF + (size_t)m * 512 + ch0) = w; }
      } }
    { const bf16* ZHT = (const bf16*)((unsigned char*)F.out + DO_HT); bf16* ZH = (bf16*)(ws + WS_ZH);
      LAS bf16* tile = (LAS bf16*)(F.lds + F.wave * 9216);
      const int lr = lane >> 3, lc = lane & 7;
      for (int it = gw; it < 8 * NB * 64; it += NGW) {
          const int tb = it & 63, b = (it >> 6) & 7, cbk = it >> 9; const int t0 = tb * 64, c0 = cbk * 64;
          v4u v[8];
#pragma unroll
          for (int i = 0; i < 8; ++i) v[i] = *(const v4u*)(ZHT + ((size_t)(c0 + lr + 8 * i) * NB + b) * SEQ + t0 + 8 * lc);
#pragma unroll
          for (int i = 0; i < 8; ++i) { LAS unsigned* d = (LAS unsigned*)(tile + (lr + 8 * i) * 66 + 8 * lc); d[0] = v[i].x; d[1] = v[i].y; d[2] = v[i].z; d[3] = v[i].w; }
          asm volatile("s_waitcnt lgkmcnt(0)" ::: "memory");
#pragma unroll
          for (int i = 0; i < 8; ++i) { const int tl = lr + 8 * i; unsigned e[8];
#pragma unroll
              for (int k = 0; k < 8; ++k) e[k] = tile[(8 * lc + k) * 66 + tl];
              v4u w; w.x = e[0] | (e[1] << 16); w.y = e[2] | (e[3] << 16); w.z = e[4] | (e[5] << 16); w.w = e[6] | (e[7] << 16);
              *(v4u*)(ZH + ((size_t)b * SEQ + t0 + tl) * 512 + c0 + 8 * lc) = w; }
          asm volatile("s_waitcnt lgkmcnt(0)" ::: "memory");
      }
    }
}

__device__ __forceinline__ void ln1_pass(Frame& F, const Args& AR) {
    const int gw = F.bid * NWAVES + F.wave, NGW = F.G * NWAVES, lane = F.lane;
    const float* H1 = (const float*)(F.ws + WS_H1); float* ST = (float*)(F.ws + WS_STATS); bf16* X1B = (bf16*)(F.ws + WS_X1B);
    const f32x4* w4 = (const f32x4*)AR.in[27]; const f32x4* b4 = (const f32x4*)AR.in[28];
    for (int m = gw; m < M; m += NGW) {
        const f32x4* xr = (const f32x4*)(H1 + (size_t)m * DM) + lane;
        f32x4 v[4]; float s = 0.f;
#pragma unroll
        for (int j = 0; j < 4; ++j) { v[j] = xr[64 * j]; s += (v[j].x + v[j].y) + (v[j].z + v[j].w); }
        const float mean = wave_sum(s) * (1.f / DM); float s2 = 0.f;
#pragma unroll
        for (int j = 0; j < 4; ++j) { v[j] = v[j] - mean; s2 += (v[j].x * v[j].x + v[j].y * v[j].y) + (v[j].z * v[j].z + v[j].w * v[j].w); }
        const float rstd = 1.f / sqrtf(wave_sum(s2) * (1.f / DM) + LN_EPS);
        if (lane == 0) { ST[2 * m] = mean; ST[2 * m + 1] = rstd; }
        v2u* o8 = (v2u*)(X1B + (size_t)m * DM) + lane;
#pragma unroll
        for (int j = 0; j < 4; ++j) { const f32x4 y = v[j] * rstd * w4[64 * j + lane] + b4[64 * j + lane]; v2u o; o.x = pk2(y.x, y.y); o.y = pk2(y.z, y.w); o8[64 * j] = o; }
    }
}
__device__ __forceinline__ void ln2_pass(Frame& F, const Args& AR, bool dry) {
    const int gw = F.bid * NWAVES + F.wave, NGW = F.G * NWAVES, lane = F.lane;
    const f32x4* w4 = (const f32x4*)AR.in[32]; const f32x4* b4 = (const f32x4*)AR.in[33];
    for (int m = gw; m < M; m += NGW) {
        f32x4* xr = (f32x4*)(F.out + (size_t)m * DM) + lane;
        f32x4 v[4]; float s = 0.f;
#pragma unroll
        for (int j = 0; j < 4; ++j) { v[j] = xr[64 * j]; s += (v[j].x + v[j].y) + (v[j].z + v[j].w); }
        const float mean = wave_sum(s) * (1.f / DM); float s2 = 0.f;
#pragma unroll
        for (int j = 0; j < 4; ++j) { v[j] = v[j] - mean; s2 += (v[j].x * v[j].x + v[j].y * v[j].y) + (v[j].z * v[j].z + v[j].w * v[j].w); }
        const float rstd = 1.f / sqrtf(wave_sum(s2) * (1.f / DM) + LN_EPS);
#pragma unroll
        for (int j = 0; j < 4; ++j) { const f32x4 y = v[j] * rstd * w4[64 * j + lane] + b4[64 * j + lane]; if (!dry) xr[64 * j] = y; }
    }
}

#define XB_TMO      128
#define XB_XCNT(j)  (256  + 64 * (j))
#define XB_XSUB(j)  (1280 + 64 * (j))
#define XB_XGEN(j)  (2304 + 64 * (j))
#define XB_TOP      3328
#define XB_TOPGEN   3392
#define XCD_BAR_WORDS 3456
#define XB_SPIN_CAP (1u << 18)

__device__ __forceinline__ unsigned xb_ld(unsigned* p)              { return __hip_atomic_load(p, __ATOMIC_RELAXED, __HIP_MEMORY_SCOPE_AGENT); }
__device__ __forceinline__ unsigned xb_add(unsigned* p, unsigned v) { return __hip_atomic_fetch_add(p, v, __ATOMIC_RELAXED, __HIP_MEMORY_SCOPE_AGENT); }
__device__ __forceinline__ unsigned xb_xcc_id() { return (unsigned)__builtin_amdgcn_s_getreg((3 << 11) | 20) & 0xFu; }
#define XB_SPIN(cond, bar) do { unsigned _sp = 0; while (cond) { __builtin_amdgcn_s_sleep(1); \
    if ((++_sp & 255u) == 0u) { if (xb_ld(&(bar)[XB_TMO])) break; if (_sp > XB_SPIN_CAP) { atomicAdd(&(bar)[XB_TMO], 1u); break; } } } } while (0)

struct XcdBarrier {
    unsigned* bar; unsigned x;
    volatile LAS unsigned* st;
};

__device__ __forceinline__ XcdBarrier xcd_barrier_post(unsigned* bar, volatile LAS unsigned* st) {
    XcdBarrier b; b.bar = bar; b.x = xb_xcc_id(); b.st = st;
    if (threadIdx.x == 0) (void)xb_add(&bar[XB_XCNT(b.x)], 1u);
    return b;
}
__device__ __forceinline__ void xcd_barrier_complete(unsigned* bar, unsigned x, unsigned& nloc, unsigned& nx) {
    const unsigned G = gridDim.x * gridDim.y * gridDim.z;
    unsigned sum, cnt, mine, sp = 0u;
    for (;;) {
        sum = 0u; cnt = 0u; mine = 0u;
#pragma unroll
        for (unsigned j = 0; j < 16; ++j) { const unsigned c = xb_ld(&bar[XB_XCNT(j)]); sum += c; cnt += (c > 0u) ? 1u : 0u; mine = (j == x) ? c : mine; }
        if (sum == G) break;
        __builtin_amdgcn_s_sleep(1);
        if ((++sp & 255u) == 0u) { if (xb_ld(&bar[XB_TMO])) break; if (sp > XB_SPIN_CAP) { atomicAdd(&bar[XB_TMO], 1u); break; } }
    }
    nloc = mine > 0u ? mine : 1u; nx = cnt > 0u ? cnt : 1u;
}

__device__ __forceinline__ void xcd_barrier(const XcdBarrier& b) {
    asm volatile("s_waitcnt vmcnt(0)" ::: "memory");
    __syncthreads();
    if (threadIdx.x == 0) {
        unsigned* bar = b.bar;
        __builtin_amdgcn_s_waitcnt(0);
        unsigned nloc = b.st[0], nx = b.st[1];
        if (nloc == 0u) { xcd_barrier_complete(bar, b.x, nloc, nx); b.st[0] = nloc; b.st[1] = nx; }
        const unsigned old = xb_add(&bar[XB_XSUB(b.x)], 1u);
        const unsigned gen = old / nloc;
        if (old + 1u == (gen + 1u) * nloc) {
            __builtin_amdgcn_fence(__ATOMIC_RELEASE, "agent");
            asm volatile("s_waitcnt vmcnt(0)" ::: "memory");
            const unsigned og = xb_add(&bar[XB_TOP], 1u);
            const unsigned tg = og / nx;
            if (og + 1u == (tg + 1u) * nx) xb_add(&bar[XB_TOPGEN], 1u);
            else XB_SPIN(xb_ld(&bar[XB_TOPGEN]) == tg, bar);
            __builtin_amdgcn_fence(__ATOMIC_ACQUIRE, "agent");
            xb_add(&bar[XB_XGEN(b.x)], 1u);
            asm volatile("s_waitcnt vmcnt(0)" ::: "memory");
        } else {
            XB_SPIN(xb_ld(&bar[XB_XGEN(b.x)]) == gen, bar);
            __builtin_amdgcn_fence(__ATOMIC_ACQUIRE, "agent");
            asm volatile("s_waitcnt vmcnt(0)" ::: "memory");
        }
    }
    __syncthreads();
}

constexpr int LDS_BYTES = 147456;
constexpr int N_PHASES = 13;
constexpr int CW_BAR = 1024;
#ifndef PROBE_DUP
#define PROBE_DUP -1
#endif
#ifndef PROBE_SUB
#define PROBE_SUB 0
#endif

__global__ void __launch_bounds__(512, 2) hybrid_fwd(Args args) {
    extern __shared__ __attribute__((aligned(16))) unsigned char lds_raw[];
    Frame F;
    F.lds = (LAS unsigned char*)lds_raw;
    F.tid = threadIdx.x; F.lane = F.tid & 63; F.wave = __builtin_amdgcn_readfirstlane(F.tid >> 6);
    F.G = gridDim.x; F.bid = blockIdx.x;
    F.out = args.out; F.ws = args.ws;
    unsigned char* ws = args.ws;
    volatile LAS unsigned* MISC = (volatile LAS unsigned*)(F.lds + 131072 + 320);
    if (F.tid < 32) MISC[F.tid] = 0u;
    __syncthreads();
    XcdBarrier bar = xcd_barrier_post((unsigned*)ws + CW_BAR, MISC + 8);
    const int lo = args.ph_lo, hi = args.ph_hi;
#define IN(k) (lo <= (k) && (k) < hi)
#define SEAM(k) do { if (IN(k) && IN((k) + 1)) xcd_barrier(bar); } while (0)
    using pg8::Gemm; using pg8::StaticOrder; using pg8::gemm_phase;

#define REP(k) for (int rep = 0; rep < ((PROBE_DUP == (k)) ? 2 : 1); ++rep, ((PROBE_DUP == (k)) ? xcd_barrier(bar) : (void)0))
    if (IN(0)) REP(0) { p0_prologue(F, args); } SEAM(0);
    if (IN(1)) REP(1) {
        Gemm g{(const bf16*)(ws + WS_XB), (const bf16*)(ws + WS_WIN), M, NP, DM}; StaticOrder S; S.init(M, NP, F.G, F.bid);
        EpiProj E{(bf16*)(ws + WS_PH), (bf16*)(ws + WS_PR), (bf16*)(ws + WS_PG)};
        gemm_phase<EpiProj, StaticOrder, true, true>(F.lds, g, S, E);
    } SEAM(1);
    if (IN(2)) REP(2) { p2_prep(F, args); } SEAM(2);
    if (IN(3)) REP(3) {
        Gemm g{(const bf16*)(ws + WS_TOP), (const bf16*)(ws + WS_WLORA), M, LORA_N, LORA_K}; StaticOrder S; S.init(M, LORA_N, F.G, F.bid);
        EpiLora E{(bf16*)(ws + WS_LW)};
        gemm_phase<EpiLora, StaticOrder, true, true>(F.lds, g, S, E);
    } SEAM(3);
    if (IN(4)) { if (PROBE_DUP == 4) { p4_mixers(F, args, PROBE_SUB != 2, PROBE_SUB != 1, true); xcd_barrier(bar); } p4_mixers(F, args, true, true, false); } SEAM(4);
    if (IN(5)) REP(5) { p5_combine(F, args, (PROBE_DUP == 5) && rep == 0); } SEAM(5);
    if (IN(6)) REP(6) {
        Gemm g{(const bf16*)(ws + WS_ZH), (const bf16*)(ws + WS_WHY), M, DM, 512}; StaticOrder S; S.init(M, DM, F.G, F.bid);
        EpiGate<0> E{(const bf16*)(ws + WS_PG), (bf16*)(ws + WS_T), nullptr};
        gemm_phase<EpiGate<0>, StaticOrder, true, true>(F.lds, g, S, E);
    } SEAM(6);
    if (IN(7)) REP(7) {
        Gemm g{(const bf16*)((unsigned char*)F.out + DO_YSF), (const bf16*)(ws + WS_WRW), M, DM, 512}; StaticOrder S; S.init(M, DM, F.G, F.bid);
        EpiGate<1> E{(const bf16*)(ws + WS_PG), (bf16*)(ws + WS_T), (bf16*)(ws + WS_MIXIN)};
        gemm_phase<EpiGate<1>, StaticOrder, true, true>(F.lds, g, S, E);
    } SEAM(7);
    if (IN(8)) REP(8) {
        Gemm g{(const bf16*)(ws + WS_MIXIN), (const bf16*)(ws + WS_WO), M, DM, DM}; StaticOrder S; S.init(M, DM, F.G, F.bid);
        EpiWo E{args.in[0], (float*)(ws + WS_H1)};
        gemm_phase<EpiWo, StaticOrder, true, true>(F.lds, g, S, E);
    } SEAM(8);
    if (IN(9)) REP(9) { ln1_pass(F, args); } SEAM(9);
    if (IN(10)) REP(10) {
        Gemm g{(const bf16*)(ws + WS_X1B), (const bf16*)(ws + WS_WGU), M, NGU, DM}; StaticOrder S; S.init(M, NGU, F.G, F.bid);
        EpiSwiGLU E{(bf16*)(ws + WS_HID)};
        gemm_phase<EpiSwiGLU, StaticOrder, true, true>(F.lds, g, S, E);
    } SEAM(10);
    if (IN(11)) REP(11) {
        Gemm g{(const bf16*)(ws + WS_HID), (const bf16*)(ws + WS_WD), M, DM, FFH}; StaticOrder S; S.init(M, DM, F.G, F.bid);
        EpiDown E{(const float*)(ws + WS_H1), (const float*)(ws + WS_STATS), args.in[27], args.in[28], F.out};
        gemm_phase<EpiDown, StaticOrder, true, true>(F.lds, g, S, E);
    } SEAM(11);
    if (IN(12)) REP(12) { ln2_pass(F, args, (PROBE_DUP == 12) && rep == 0); }
#undef IN
#undef SEAM
}

extern "C" void kernel_launch(void* const* d_in, const int* in_sizes, int n_in, void* d_out, int out_size, void* d_ws, size_t ws_size, hipStream_t stream) {
    static int grid = 0;
    if (grid == 0) {
        if (n_in != 34 || out_size != M * DM || ws_size < WS_NEED) { fprintf(stderr, "kernel_launch: unexpected shapes (n_in %d out %d ws %zu)\n", n_in, out_size, ws_size); grid = -1; return; }
        int dev = 0, cus = 0, per_cu = 0;
        if (hipGetDevice(&dev) != hipSuccess || hipDeviceGetAttribute(&cus, hipDeviceAttributeMultiprocessorCount, dev) != hipSuccess) { grid = -1; return; }
        if (hipFuncSetAttribute((const void*)hybrid_fwd, hipFuncAttributeMaxDynamicSharedMemorySize, LDS_BYTES) != hipSuccess) { fprintf(stderr, "kernel_launch: hipFuncSetAttribute failed\n"); grid = -1; return; }
        if (hipOccupancyMaxActiveBlocksPerMultiprocessor(&per_cu, (const void*)hybrid_fwd, 512, LDS_BYTES) != hipSuccess || per_cu < 1) { fprintf(stderr, "kernel_launch: occupancy query says %d\n", per_cu); per_cu = 1; }
        (void)hipGetLastError();
        grid = cus;
        if (grid != 256) fprintf(stderr, "kernel_launch: %d CUs (built for 256)\n", grid);
    }
    if (grid < 0) return;
    Args a{};
    for (int i = 0; i < 34; ++i) a.in[i] = (const float*)d_in[i];
    a.out = (float*)d_out; a.ws = (unsigned char*)d_ws; a.ph_lo = 0; a.ph_hi = N_PHASES;
    if (hipMemsetAsync(d_ws, 0, 65536, stream) != hipSuccess) { fprintf(stderr, "kernel_launch: memset failed\n"); return; }
    hipLaunchKernelGGL(hybrid_fwd, dim3(grid), dim3(512), LDS_BYTES, stream, a);
    const hipError_t e = hipPeekAtLastError();
    if (e != hipSuccess) fprintf(stderr, "kernel_launch: launch failed: %s\n", hipGetErrorString(e));
}
```

```cpp
#include <hip/hip_runtime.h>
#include <hip/hip_cooperative_groups.h>
#include <cstdio>
#include <cstdint>
namespace cg = cooperative_groups;
namespace pg8 {
#define PG8_LAS __attribute__((address_space(3)))
typedef unsigned short bf16_t;
typedef short bf16x8 __attribute__((ext_vector_type(8)));
typedef float f32x4 __attribute__((ext_vector_type(4)));
typedef unsigned u32x4 __attribute__((ext_vector_type(4)));
constexpr int BM = 256, BK = 64, HALF = 128, HTB = HALF * BK * 2  , STAGE_BYTES = 8 * HTB, NXCD = 8, WGM = 8;

__host__ __device__ __forceinline__ int lds_byte(int r, int c) { const int st = (r >> 4) * 2 + (c >> 5), rr = r & 15, cc = c & 31, ob = rr * 64 + cc * 2; return st * 1024 + (ob ^ (((ob >> 9) & 1) << 5)); }
__host__ __device__ __forceinline__ void stage_rc(int b, int& R, int& C) { const int st = b / 1024, sb = b % 1024, swz = sb ^ (((sb >> 9) & 1) << 5); R = (st >> 1) * 16 + swz / 64; C = (st & 1) * 32 + (swz % 64) / 2; }
__host__ __device__ __forceinline__ int perm32(int rho) { const int n = rho >> 4, i = rho & 15; return 8 * (i >> 2) + 4 * n + (i & 3); }

struct Unit { int pm, pn; };
struct Gemm { const bf16_t* A; const bf16_t* Bt; int M, N, K; };

struct StaticOrder {
    int nM, nN, nwg, G, c;
    __host__ __device__ void init(int M, int N, int G_, int c_) { nM = M / BM; nN = N / BM; nwg = nM * nN; G = G_; c = c_; }
    __host__ __device__ bool next(int i, Unit& u) const {
        const long L = (long)i * G + c; if (L >= nwg) return false;
        int wgid = (int)L; { const int q = nwg / NXCD, r = nwg % NXCD, xcd = wgid % NXCD, off = wgid / NXCD; wgid = (xcd < r ? xcd * (q + 1) : r * (q + 1) + (xcd - r) * q) + off; }
        const int nig = WGM * nN, gid = wgid / nig, fm = gid * WGM, gsz = (nM - fm) < WGM ? (nM - fm) : WGM;
        u.pm = fm + ((wgid % nig) % gsz); u.pn = (wgid % nig) / gsz; return true;
    }
    __device__ __forceinline__ void a_ready(const Unit&) const {}
    __device__ __forceinline__ void done(const Unit&) const {}
};

__device__ __forceinline__ unsigned cvt_pk_bf16(float lo, float hi) { unsigned r; asm volatile("v_cvt_pk_bf16_f32 %0, %1, %2" : "=v"(r) : "v"(lo), "v"(hi)); return r; }
typedef float f32x2 __attribute__((ext_vector_type(2)));
template <class Epi, class Sched, bool ALIGN_EPI = false, bool SP2 = false>
__device__ __forceinline__ void gemm_phase(PG8_LAS unsigned char* lds, const Gemm g, const Sched& S, const Epi& E) {
    const int tid = threadIdx.x, wid = __builtin_amdgcn_readfirstlane(tid >> 6), lane = tid & 63, wr = wid >> 2, wc = wid & 3, fr = lane & 15, fq = lane >> 4;
    const int K = g.K, nt = K / BK;
    unsigned voffA[2], voffB[2];
#pragma unroll
    for (int i = 0; i < 2; ++i) { int R, C; stage_rc(tid * 16 + i * 8192, R, C); const int Rb = Epi::PERM ? ((R & ~31) + perm32(R & 31)) : R;
        voffA[i] = (unsigned)(R * K + C) * 2u; voffB[i] = (unsigned)(Rb * K + C) * 2u; }
    const size_t kstep = (size_t)(BK * 2);
    const size_t hstep = (size_t)HALF * K * 2;
    const size_t tstep = 2 * hstep;
    const unsigned ldsw = (unsigned)wid * 1024u;
    const int aoff = lds_byte(wr * 64 + fr, fq * 8), boff = lds_byte(wc * 32 + fr, fq * 8);
#define PG8_SA(b, h) (((b) * 2 + (h)) * HTB)
#define PG8_SB(b, h) ((4 + (b) * 2 + (h)) * HTB)
#define PG8_STAGE(bufoff, gbase, voff) do { _Pragma("unroll") for (int _i = 0; _i < 2; ++_i) \
        __builtin_amdgcn_global_load_lds((const unsigned*)((const char*)(gbase) + (voff)[_i]), (PG8_LAS unsigned*)(lds + (bufoff) + ldsw + _i * 8192), 16, 0, 0); } while (0)
#define PG8_LDA(dst, b, h) do { _Pragma("unroll") for (int m = 0; m < 4; ++m) _Pragma("unroll") for (int k = 0; k < 2; ++k) dst[m][k] = *(const PG8_LAS bf16x8*)(lds + PG8_SA(b, h) + aoff + m * 2048 + k * 1024); } while (0)
#define PG8_LDB(dst, b, h) do { _Pragma("unroll") for (int n = 0; n < 2; ++n) _Pragma("unroll") for (int k = 0; k < 2; ++k) dst[n][k] = *(const PG8_LAS bf16x8*)(lds + PG8_SB(b, h) + boff + n * 2048 + k * 1024); } while (0)
#define PG8_MMA(ai, bj, At, Bt) do { __builtin_amdgcn_s_setprio(1); _Pragma("unroll") for (int m = 0; m < 4; ++m) _Pragma("unroll") for (int n = 0; n < 2; ++n) _Pragma("unroll") for (int k = 0; k < 2; ++k) \
        acc[ai][bj][m][n] = __builtin_amdgcn_mfma_f32_16x16x32_bf16(Bt[n][k], At[m][k], acc[ai][bj][m][n], 0, 0, 0); __builtin_amdgcn_s_setprio(0); } while (0)
#define PG8_WAIT_V(n) asm volatile("s_waitcnt vmcnt(" #n ")" ::: "memory")
#define PG8_WAIT_L(n) asm volatile("s_waitcnt lgkmcnt(" #n ")" ::: "memory")
#define PG8_BAR __builtin_amdgcn_s_barrier()
#define PG8_SCHED __builtin_amdgcn_sched_barrier(0)
    Unit cur, nxt; int ui = 0;
    if (!S.next(0, cur)) return;
    f32x4 acc[2][2][4][2];
#pragma unroll
    for (int a = 0; a < 2; ++a)
#pragma unroll
        for (int b = 0; b < 2; ++b)
#pragma unroll
            for (int m = 0; m < 4; ++m)
#pragma unroll
                for (int n = 0; n < 2; ++n) acc[a][b][m][n] = (f32x4){0.f, 0.f, 0.f, 0.f};
    bf16x8 At[4][2], B0[2][2], B1[2][2];
    const char* cA = (const char*)g.A + (size_t)cur.pm * tstep; const char* cB = (const char*)g.Bt + (size_t)cur.pn * tstep;
    S.a_ready(cur);
    if constexpr (SP2) {
        PG8_STAGE(PG8_SB(0, 0), cB, voffB); PG8_STAGE(PG8_SB(0, 1), cB + hstep, voffB); PG8_STAGE(PG8_SA(0, 0), cA, voffA); PG8_STAGE(PG8_SA(0, 1), cA + hstep, voffA);
        if (wr == 1) PG8_BAR;
        PG8_WAIT_V(2); PG8_BAR;
        PG8_STAGE(PG8_SB(1, 0), cB + kstep, voffB); PG8_STAGE(PG8_SA(1, 0), cA + kstep, voffA); PG8_STAGE(PG8_SB(1, 1), cB + hstep + kstep, voffB);
        PG8_WAIT_V(6); PG8_BAR;
    } else {
        PG8_STAGE(PG8_SB(0, 0), cB, voffB); PG8_STAGE(PG8_SA(0, 0), cA, voffA); PG8_STAGE(PG8_SB(0, 1), cB + hstep, voffB); PG8_STAGE(PG8_SA(0, 1), cA + hstep, voffA);
        if (wr == 1) PG8_BAR;
        PG8_WAIT_V(4); PG8_BAR;
        PG8_STAGE(PG8_SB(1, 0), cB + kstep, voffB); PG8_STAGE(PG8_SA(1, 0), cA + kstep, voffA); PG8_STAGE(PG8_SB(1, 1), cB + hstep + kstep, voffB);
        PG8_WAIT_V(6); PG8_BAR;
    }
    for (;;) {
        const bool has_next = S.next(ui + 1, nxt);
        const char* nA = has_next ? (const char*)g.A + (size_t)nxt.pm * tstep : cA; const char* nB = has_next ? (const char*)g.Bt + (size_t)nxt.pn * tstep : cB;
#pragma unroll 1
        for (int t = 0; t < nt; t += 2) {
            const bool last = (t == nt - 2);
            const char* a1 = cA + (size_t)(t + 1) * kstep;
            const char* a2 = last ? nA : cA + (size_t)(t + 2) * kstep; const char* b2 = last ? nB : cB + (size_t)(t + 2) * kstep;
            const char* a3 = a2 + kstep; const char* b3 = b2 + kstep;
            if (last && has_next) S.a_ready(nxt);
            if constexpr (SP2) {
            PG8_LDB(B0, 0, 0); PG8_LDB(B1, 0, 1); PG8_SCHED; PG8_LDA(At, 0, 0); PG8_STAGE(PG8_SA(1, 1), a1 + hstep, voffA);
            PG8_WAIT_V(8); PG8_WAIT_L(0); PG8_BAR; PG8_MMA(0, 0, At, B0); PG8_MMA(0, 1, At, B1); PG8_BAR; PG8_SCHED;
            PG8_LDA(At, 0, 1); PG8_STAGE(PG8_SB(0, 0), b2, voffB); PG8_STAGE(PG8_SB(0, 1), b2 + hstep, voffB); PG8_STAGE(PG8_SA(0, 0), a2, voffA);
            PG8_WAIT_V(8); PG8_WAIT_L(0); PG8_BAR; PG8_MMA(1, 0, At, B0); PG8_MMA(1, 1, At, B1); PG8_BAR; PG8_SCHED;
            PG8_LDB(B0, 1, 0); PG8_LDB(B1, 1, 1); PG8_SCHED; PG8_LDA(At, 1, 0); PG8_STAGE(PG8_SA(0, 1), a2 + hstep, voffA);
            PG8_WAIT_V(8); PG8_WAIT_L(0); PG8_BAR; PG8_MMA(0, 0, At, B0); PG8_MMA(0, 1, At, B1); PG8_BAR; PG8_SCHED;
            PG8_LDA(At, 1, 1); PG8_STAGE(PG8_SB(1, 0), b3, voffB); PG8_STAGE(PG8_SB(1, 1), b3 + hstep, voffB); PG8_STAGE(PG8_SA(1, 0), a3, voffA);
            PG8_WAIT_V(8); PG8_WAIT_L(0); PG8_BAR; PG8_MMA(1, 0, At, B0); PG8_MMA(1, 1, At, B1); PG8_BAR; PG8_SCHED;
            } else {
            PG8_LDB(B0, 0, 0); PG8_SCHED; PG8_LDA(At, 0, 0); PG8_STAGE(PG8_SA(1, 1), a1 + hstep, voffA);
            PG8_WAIT_L(8); PG8_BAR; PG8_WAIT_L(0); PG8_MMA(0, 0, At, B0); PG8_BAR; PG8_SCHED;
            PG8_LDB(B1, 0, 1); PG8_STAGE(PG8_SB(0, 0), b2, voffB);
            PG8_BAR; PG8_WAIT_L(0); PG8_MMA(0, 1, At, B1); PG8_BAR;
            PG8_LDA(At, 0, 1); PG8_STAGE(PG8_SA(0, 0), a2, voffA);
            PG8_BAR; PG8_WAIT_L(0); PG8_MMA(1, 0, At, B0); PG8_BAR; PG8_SCHED;
            PG8_STAGE(PG8_SB(0, 1), b2 + hstep, voffB);
            PG8_WAIT_V(6); PG8_BAR; PG8_MMA(1, 1, At, B1); PG8_BAR;
            PG8_LDB(B0, 1, 0); PG8_SCHED; PG8_LDA(At, 1, 0); PG8_STAGE(PG8_SA(0, 1), a2 + hstep, voffA);
            PG8_WAIT_L(8); PG8_BAR; PG8_WAIT_L(0); PG8_MMA(0, 0, At, B0); PG8_BAR; PG8_SCHED;
            PG8_LDB(B1, 1, 1); PG8_STAGE(PG8_SB(1, 0), b3, voffB);
            PG8_BAR; PG8_WAIT_L(0); PG8_MMA(0, 1, At, B1); PG8_BAR;
            PG8_LDA(At, 1, 1); PG8_STAGE(PG8_SA(1, 0), a3, voffA);
            PG8_BAR; PG8_WAIT_L(0); PG8_MMA(1, 0, At, B0); PG8_BAR; PG8_SCHED;
            PG8_STAGE(PG8_SB(1, 1), b3 + hstep, voffB);
            PG8_WAIT_V(6); PG8_BAR; PG8_MMA(1, 1, At, B1); PG8_BAR;
            }
        }
        if constexpr (ALIGN_EPI) { if (wr == 0) PG8_BAR; }
        if constexpr (!Epi::AFTER_DRAIN) { E(acc, cur, wr, wc, fr, fq); S.done(cur); }
        if (!has_next) break;
#pragma unroll
        for (int a = 0; a < 2; ++a)
#pragma unroll
            for (int b = 0; b < 2; ++b)
#pragma unroll
                for (int m = 0; m < 4; ++m)
#pragma unroll
                    for (int n = 0; n < 2; ++n) acc[a][b][m][n] = (f32x4){0.f, 0.f, 0.f, 0.f};
        cur = nxt; cA = nA; cB = nB; ++ui;
        if constexpr (ALIGN_EPI) { if (wr == 1) PG8_BAR; }
    }
    PG8_WAIT_V(0);
    if constexpr (!ALIGN_EPI) { if (wr == 0) PG8_BAR; }
    PG8_BAR;
    if constexpr (Epi::AFTER_DRAIN) { E.fused(acc, cur, wr, wc, fr, fq, lds, wid, lane); S.done(cur); }
#undef PG8_SA
#undef PG8_SB
#undef PG8_STAGE
#undef PG8_LDA
#undef PG8_LDB
#undef PG8_MMA
#undef PG8_WAIT_V
#undef PG8_WAIT_L
#undef PG8_BAR
#undef PG8_SCHED
}
}

constexpr int NB = 8, SEQ = 4096, DM = 1024, M = NB * SEQ;
constexpr int NHEAD = 8;
constexpr int PH_P = 1536, PR_P = 1920, PG_P = 2048;
constexpr int NP = 5632;
constexpr int FFH = 2816, NGU = 5632;
constexpr int LORA_K = 384, LORA_N = 2560;
constexpr float DN_ALPHA = 1.18920711500272f;
constexpr float LN_EPS = 1e-5f, GN_EPS = 64e-5f;
constexpr float HY_MIN_DECAY = -3.07011346f, HY_MAX_DECAY = -15.3505673f;
constexpr int NWAVES = 8;
constexpr int MISC_OFF = 147456 - 256;

constexpr size_t MiB = 1u << 20;
constexpr size_t WS_H3T = 1 * MiB;
constexpr size_t WS_STATS = 2 * MiB;
constexpr size_t WS_BONUS = 3 * MiB;
constexpr size_t WS_WIN = 5 * MiB, WS_WGU = 16 * MiB, WS_WD = 27 * MiB, WS_WO = 33 * MiB, WS_WHY = 35 * MiB, WS_WRW = 36 * MiB, WS_WLORA = 37 * MiB;
constexpr size_t WS_FT = 39 * MiB;
constexpr size_t WS_XB = 71 * MiB;
constexpr size_t WS_LW = 71 * MiB;
constexpr size_t WS_PH = 135 * MiB, WS_PR = 231 * MiB, WS_PG = 351 * MiB;
constexpr size_t WS_TOP = 479 * MiB;
constexpr size_t WS_ZH = 71 * MiB, WS_T = 103 * MiB, WS_MIXIN = 167 * MiB;
constexpr size_t WS_H1 = 351 * MiB, WS_X1B = 71 * MiB, WS_HID = 135 * MiB;
constexpr size_t WS_NEED = 511 * MiB;
constexpr size_t DO_HT = 0, DO_YSF = 96 * MiB;

#define GAS __attribute__((address_space(1)))
#define LAS __attribute__((address_space(3)))
typedef unsigned short bf16;
typedef unsigned v4u __attribute__((ext_vector_type(4)));
typedef unsigned v2u __attribute__((ext_vector_type(2)));
typedef float f32x4 __attribute__((ext_vector_type(4)));
typedef float f32x16 __attribute__((ext_vector_type(16)));
typedef short bf16x8 __attribute__((ext_vector_type(8)));

__device__ __forceinline__ float bf2f(unsigned b) { return __uint_as_float(b << 16); }
__device__ __forceinline__ float bflo(unsigned w) { return __uint_as_float(w << 16); }
__device__ __forceinline__ float bfhi(unsigned w) { return __uint_as_float(w & 0xffff0000u); }
__device__ __forceinline__ unsigned f2bf(float f) { unsigned u = __float_as_uint(f); return (u + 0x7fffu + ((u >> 16) & 1u)) >> 16; }
__device__ __forceinline__ unsigned pk2(float lo, float hi) { return f2bf(lo) | (f2bf(hi) << 16); }
__device__ __forceinline__ float sigmoidf_(float x) { return 1.0f / (1.0f + __expf(-x)); }
typedef float f32x2c __attribute__((ext_vector_type(2)));
typedef __bf16 bf16x2c __attribute__((ext_vector_type(2)));
__device__ __forceinline__ unsigned cvtpk2(float lo, float hi) { const f32x2c v = {lo, hi}; return __builtin_bit_cast(unsigned, __builtin_convertvector(v, bf16x2c)); }
__device__ __forceinline__ float fsig(float x) { return __builtin_amdgcn_rcpf(1.0f + __expf(-x)); }
__device__ __forceinline__ float wave_sum(float v) {
#pragma unroll
    for (int o = 1; o < 64; o <<= 1) v += __shfl_xor(v, o);
    return v;
}

struct Frame {
    LAS unsigned char* lds;
    int tid, lane, wave, G, bid;
    float* out; unsigned char* ws;
};
struct Args { const float* in[34]; float* out; unsigned char* ws; int ph_lo, ph_hi; };

using pg8::Unit; using pg8::cvt_pk_bf16; constexpr int HALF = 128, BM = 256;

__device__ __forceinline__ v4u pack8(f32x4 v0, f32x4 v1) { v4u w; w.x = cvt_pk_bf16(v0[0], v0[1]); w.y = cvt_pk_bf16(v0[2], v0[3]); w.z = cvt_pk_bf16(v1[0], v1[1]); w.w = cvt_pk_bf16(v1[2], v1[3]); return w; }

struct EpiProj {
    static constexpr bool PERM = true, AFTER_DRAIN = false;
    bf16 *PH, *PR, *PG;
    __device__ __forceinline__ void operator()(const f32x4 (&acc)[2][2][4][2], const Unit& u, int wr, int wc, int fr, int fq) const {
        const int row0 = u.pm * BM + wr * 64 + fr;
#pragma unroll
        for (int bj = 0; bj < 2; ++bj) {
            const int hb = 2 * u.pn + bj; bf16* base; int pitch, col;
            if (hb < 12) { base = PH; pitch = PH_P; col = 128 * hb; }
            else if (hb < 27) { base = PR; pitch = PR_P; col = 128 * (hb - 12); }
            else if (hb < 43) { base = PG; pitch = PG_P; col = 128 * (hb - 27); }
            else continue;
            col += wc * 32 + 8 * fq;
#pragma unroll
            for (int ai = 0; ai < 2; ++ai)
#pragma unroll
                for (int m = 0; m < 4; ++m)
                    *(v4u*)(base + (size_t)(row0 + ai * HALF + m * 16) * pitch + col) = pack8(acc[ai][bj][m][0], acc[ai][bj][m][1]);
        }
    }
};

struct EpiLora {
    static constexpr bool PERM = true, AFTER_DRAIN = false;
    bf16* LW;
    __device__ __forceinline__ void operator()(const f32x4 (&acc)[2][2][4][2], const Unit& u, int wr, int wc, int fr, int fq) const {
        const int row0 = u.pm * BM + wr * 64 + fr;
        bf16* base = LW + (size_t)(u.pn >> 1) * ((size_t)M * 512) + (u.pn & 1) * 256 + wc * 32 + 8 * fq;
#pragma unroll
        for (int ai = 0; ai < 2; ++ai)
#pragma unroll
            for (int m = 0; m < 4; ++m) { bf16* rowp = base + (size_t)(row0 + ai * HALF + m * 16) * 512;
#pragma unroll
                for (int bj = 0; bj < 2; ++bj) *(v4u*)(rowp + bj * HALF) = pack8(acc[ai][bj][m][0], acc[ai][bj][m][1]); }
    }
};

template <int STAGE> struct EpiGate {
    static constexpr bool PERM = true, AFTER_DRAIN = false;
    const bf16* PG; bf16* T; bf16* O;
    __device__ __forceinline__ void operator()(const f32x4 (&acc)[2][2][4][2], const Unit& u, int wr, int wc, int fr, int fq) const {
        const int row0 = u.pm * BM + wr * 64 + fr;
#pragma unroll
        for (int bj = 0; bj < 2; ++bj) {
            const int col = u.pn * BM + bj * HALF + wc * 32 + 8 * fq;
#pragma unroll
            for (int ai = 0; ai < 2; ++ai)
#pragma unroll
                for (int m = 0; m < 4; ++m) {
                    const size_t row = (size_t)(row0 + ai * HALF + m * 16);
                    const v4u g = *(const v4u*)(PG + row * PG_P + STAGE * 1024 + col);
                    f32x4 v0 = acc[ai][bj][m][0], v1 = acc[ai][bj][m][1];
                    v0[0] *= sigmoidf_(bflo(g.x)); v0[1] *= sigmoidf_(bfhi(g.x)); v0[2] *= sigmoidf_(bflo(g.y)); v0[3] *= sigmoidf_(bfhi(g.y));
                    v1[0] *= sigmoidf_(bflo(g.z)); v1[1] *= sigmoidf_(bfhi(g.z)); v1[2] *= sigmoidf_(bflo(g.w)); v1[3] *= sigmoidf_(bfhi(g.w));
                    if (STAGE == 1) {
                        const v4u t = *(const v4u*)(T + row * 1024 + col);
                        v0[0] += bflo(t.x); v0[1] += bfhi(t.x); v0[2] += bflo(t.y); v0[3] += bfhi(t.y);
                        v1[0] += bflo(t.z); v1[1] += bfhi(t.z); v1[2] += bflo(t.w); v1[3] += bfhi(t.w);
                        *(v4u*)(O + row * 1024 + col) = pack8(v0, v1);
                    } else {
                        *(v4u*)(T + row * 1024 + col) = pack8(v0, v1);
                    }
                }
        }
    }
};

struct EpiWo {
    static constexpr bool PERM = false, AFTER_DRAIN = false;
    const float* X; float* H1;
    __device__ __forceinline__ void operator()(const f32x4 (&acc)[2][2][4][2], const Unit& u, int wr, int wc, int fr, int fq) const {
        const int row0 = u.pm * BM + wr * 64 + fr, col0 = u.pn * BM + wc * 32 + 4 * fq;
#pragma unroll
        for (int ai = 0; ai < 2; ++ai)
#pragma unroll
            for (int m = 0; m < 4; ++m) {
                const size_t off = (size_t)(row0 + ai * HALF + m * 16) * DM + col0;
#pragma unroll
                for (int bj = 0; bj < 2; ++bj)
#pragma unroll
                    for (int n = 0; n < 2; ++n) {
                        const f32x4 xv = *(const f32x4*)(X + off + bj * HALF + n * 16);
                        *(f32x4*)(H1 + off + bj * HALF + n * 16) = xv * DN_ALPHA + acc[ai][bj][m][n];
                    }
            }
    }
};

struct EpiSwiGLU {
    static constexpr bool PERM = true, AFTER_DRAIN = false;
    bf16* HID;
    __device__ __forceinline__ void operator()(const f32x4 (&acc)[2][2][4][2], const Unit& u, int wr, int wc, int fr, int fq) const {
        const int row0 = u.pm * BM + wr * 64 + fr, col = u.pn * HALF + wc * 32 + 8 * fq;
#pragma unroll
        for (int ai = 0; ai < 2; ++ai)
#pragma unroll
            for (int m = 0; m < 4; ++m) {
                f32x4 g0 = acc[ai][0][m][0], g1 = acc[ai][0][m][1]; const f32x4 u0 = acc[ai][1][m][0], u1 = acc[ai][1][m][1];
#pragma unroll
                for (int j = 0; j < 4; ++j) { g0[j] = g0[j] * sigmoidf_(g0[j]) * u0[j]; g1[j] = g1[j] * sigmoidf_(g1[j]) * u1[j]; }
                *(v4u*)(HID + (size_t)(row0 + ai * HALF + m * 16) * FFH + col) = pack8(g0, g1);
            }
    }
};

struct EpiDown {
    static constexpr bool PERM = false, AFTER_DRAIN = false;
    const float* H1; const float* STATS; const float* lnw; const float* lnb; float* O;
    __device__ __forceinline__ void operator()(const f32x4 (&acc)[2][2][4][2], const Unit& u, int wr, int wc, int fr, int fq) const {
        const int row0 = u.pm * BM + wr * 64 + fr, col0 = u.pn * BM + wc * 32 + 4 * fq;
#pragma unroll
        for (int ai = 0; ai < 2; ++ai)
#pragma unroll
            for (int m = 0; m < 4; ++m) {
                const int row = row0 + ai * HALF + m * 16; const size_t off = (size_t)row * DM + col0;
                const float mean = STATS[2 * row], rstd = STATS[2 * row + 1];
#pragma unroll
                for (int bj = 0; bj < 2; ++bj)
#pragma unroll
                    for (int n = 0; n < 2; ++n) {
                        const f32x4 hv = *(const f32x4*)(H1 + off + bj * HALF + n * 16);
                        const f32x4 wv = *(const f32x4*)(lnw + col0 + bj * HALF + n * 16), bv = *(const f32x4*)(lnb + col0 + bj * HALF + n * 16);
                        const f32x4 x1 = (hv - mean) * rstd * wv + bv;
                        *(f32x4*)(O + off + bj * HALF + n * 16) = x1 * DN_ALPHA + acc[ai][bj][m][n];
                    }
            }
    }
};

__device__ __forceinline__ void p0_transpose_item(const float* W, int K, int N, bf16* WT, int dst_row0, int k0, int n0, LAS float* scr, int lane) {
#pragma unroll 8
    for (int i = 0; i < 32; ++i) { const int kk = 2 * i + (lane >> 5); scr[kk * 33 + (lane & 31)] = W[(size_t)(k0 + kk) * N + n0 + (lane & 31)]; }
    asm volatile("s_waitcnt lgkmcnt(0)" ::: "memory");
    const int c = lane & 7;
#pragma unroll
    for (int j = 0; j < 4; ++j) { const int n = (lane >> 3) + 8 * j; const LAS float* s = scr + (8 * c) * 33 + n;
        v4u o; o.x = pk2(s[0 * 33], s[1 * 33]); o.y = pk2(s[2 * 33], s[3 * 33]); o.z = pk2(s[4 * 33], s[5 * 33]); o.w = pk2(s[6 * 33], s[7 * 33]);
        *(v4u*)(WT + (size_t)(dst_row0 + n) * K + k0 + 8 * c) = o; }
    asm volatile("s_waitcnt lgkmcnt(0)" ::: "memory");
}

__device__ __forceinline__ void p0_prologue(Frame& F, const Args& AR) {
    LAS float* scr = (LAS float*)(F.lds + F.wave * 16384);
    const int gw = F.bid * NWAVES + F.wave, NGW = F.G * NWAVES, lane = F.lane;
    unsigned char* ws = F.ws;
    constexpr int I_IN = (1024 / 64) * (5504 / 32), I_GU = (1024 / 64) * (2816 / 32), I_D = (2816 / 64) * (1024 / 32), I_O = 16 * 32, I_HY = 8 * 32;
    constexpr int NITEMS = I_IN + 2 * I_GU + I_D + I_O + 2 * I_HY;
    for (int it = gw; it < NITEMS; it += NGW) {
        int r = it;
        if (r < I_IN) { const int nblk = 5504 / 32, kb = r / nblk, nb = r % nblk; p0_transpose_item(AR.in[1], 1024, 5504, (bf16*)(ws + WS_WIN), 32 * nb, 64 * kb, 32 * nb, scr, lane); continue; } r -= I_IN;
        if (r < 2 * I_GU) { const int up = r >= I_GU; if (up) r -= I_GU; const int nblk = 2816 / 32, kb = r / nblk, nb = r % nblk, n0 = 32 * nb;
            p0_transpose_item(AR.in[up ? 30 : 29], 1024, 2816, (bf16*)(ws + WS_WGU), (n0 >> 7) * 256 + (n0 & 127) + (up ? 128 : 0), 64 * kb, n0, scr, lane); continue; } r -= 2 * I_GU;
        if (r < I_D) { const int nblk = 32, kb = r / nblk, nb = r % nblk; p0_transpose_item(AR.in[31], 2816, 1024, (bf16*)(ws + WS_WD), 32 * nb, 64 * kb, 32 * nb, scr, lane); continue; } r -= I_D;
        if (r < I_O) { const int kb = r / 32, nb = r % 32; p0_transpose_item(AR.in[26], 1024, 1024, (bf16*)(ws + WS_WO), 32 * nb, 64 * kb, 32 * nb, scr, lane); continue; } r -= I_O;
        if (r < I_HY) { const int kb = r / 32, nb = r % 32; p0_transpose_item(AR.in[24], 512, 1024, (bf16*)(ws + WS_WHY), 32 * nb, 64 * kb, 32 * nb, scr, lane); continue; } r -= I_HY;
        { const int kb = r / 32, nb = r % 32; p0_transpose_item(AR.in[25], 512, 1024, (bf16*)(ws + WS_WRW), 32 * nb, 64 * kb, 32 * nb, scr, lane); }
    }
    const size_t gt = (size_t)F.bid * 512 + F.tid, NT = (size_t)F.G * 512;
    { v4u z = {0u, 0u, 0u, 0u}; v4u* p = (v4u*)((bf16*)(ws + WS_WIN) + (size_t)5504 * 1024); for (size_t i = gt; i < (size_t)128 * 1024 / 8; i += NT) p[i] = z; }
    { bf16* WL = (bf16*)(ws + WS_WLORA);
      for (size_t i = gt; i < (size_t)LORA_N * LORA_K; i += NT) {
          const int n = (int)(i / LORA_K), k = (int)(i % LORA_K), blk = n >> 9, c = n & 511; float v = 0.f;
          if (blk < 2) { if ((k >> 6) == blk) v = AR.in[15][((size_t)blk * 64 + (k & 63)) * 512 + c]; }
          else if (blk < 4) { if ((k >> 6) == blk) v = AR.in[17][((size_t)(blk - 2) * 64 + (k & 63)) * 512 + c]; }
          else { if (k >= 256) v = AR.in[18][(size_t)(k - 256) * 512 + c]; }
          WL[i] = (bf16)f2bf(v);
      } }
    { const f32x4* x4 = (const f32x4*)AR.in[0]; v4u* xb = (v4u*)(ws + WS_XB);
      for (size_t i = gt; i < (size_t)M * DM / 8; i += NT) { const f32x4 a = x4[2 * i], b = x4[2 * i + 1]; xb[i] = pack8(a, b); } }
    { float* H3T = (float*)(ws + WS_H3T);
      const float* fw1 = AR.in[4]; const float* fb1 = AR.in[5]; const float* fw2 = AR.in[6]; const float* fb2 = AR.in[7]; const float* fw3 = AR.in[8]; const float* fb3 = AR.in[9]; const float* sf = AR.in[11];
      for (int pos = gw; pos < SEQ; pos += NGW) {
          const float t = (float)pos / 4095.0f, wv = 6.283185307179586f * (float)pos / 4096.0f;
          float feat = 0.f;
          if (lane == 0) feat = t;
          else if (lane <= 32) { const int j = (lane - 1) & 15; const float f = 1e-4f + (float)j * ((15.0f - 1e-4f) / 15.0f); const float ang = wv * f; feat = (lane <= 16) ? cosf(ang) : -sinf(ang); }
          float z = fb1[lane];
#pragma unroll
          for (int f = 0; f < 33; ++f) z += __shfl(feat, f) * fw1[f * 64 + lane];
          float h = sinf(sf[lane] * z);
          z = fb2[lane];
#pragma unroll 8
          for (int j = 0; j < 64; ++j) z += __shfl(h, j) * fw2[j * 64 + lane];
          h = sinf(sf[64 + lane] * z);
          z = fb3[lane];
#pragma unroll 8
          for (int j = 0; j < 64; ++j) z += __shfl(h, j) * fw3[j * 64 + lane];
          h = sinf(sf[128 + lane] * z);
          H3T[lane * SEQ + pos] = h;
      } }
}

__device__ __forceinline__ void p2_prep(Frame& F, const Args& AR) {
    unsigned char* ws = F.ws; const int tid = F.tid, lane = F.lane;
    const int gw = F.bid * NWAVES + F.wave, NGW = F.G * NWAVES;
    { const bf16* PH = (const bf16*)(ws + WS_PH); bf16* HT = (bf16*)((unsigned char*)F.out + DO_HT);
      const float* cw = AR.in[2]; const float* cb = AR.in[3];
      LAS bf16* raw = (LAS bf16*)(F.lds + F.wave * 9216);
      constexpr int NIT = NB * (SEQ / 64) * (PH_P / 64);
      const int lr = lane >> 3, lc = lane & 7;
      for (int it = gw; it < NIT; it += NGW) {
          const int cbk = it % 24, tb = (it / 24) % 64, b = it / (24 * 64); const int t0 = tb * 64, c0 = cbk * 64;
          const bf16* src = PH + ((size_t)b * SEQ + t0) * PH_P + c0 + 8 * lc;
          v4u v[9];
#pragma unroll
          for (int i = 0; i < 8; ++i) v[i] = *(const v4u*)(src + (size_t)(lr + 8 * i) * PH_P);
          { const int hrow = (lane < 8) ? -1 : 64; const int t = t0 + hrow; v[8] = (v4u){0u, 0u, 0u, 0u};
            if (lane < 16 && t >= 0 && t < SEQ) v[8] = *(const v4u*)(src + (ptrdiff_t)hrow * PH_P); }
#pragma unroll
          for (int i = 0; i < 8; ++i) { LAS unsigned* d = (LAS unsigned*)(raw + (1 + lr + 8 * i) * 66 + 8 * lc); d[0] = v[i].x; d[1] = v[i].y; d[2] = v[i].z; d[3] = v[i].w; }
          if (lane < 16) { LAS unsigned* d = (LAS unsigned*)(raw + ((lane < 8) ? 0 : 65) * 66 + 8 * lc); d[0] = v[8].x; d[1] = v[8].y; d[2] = v[8].z; d[3] = v[8].w; }
          asm volatile("s_waitcnt lgkmcnt(0)" ::: "memory");
          const int col = c0 + lane;
          const float w0 = cw[col], w1 = cw[PH_P + col], w2 = cw[2 * PH_P + col], bb = cb[col];
          const int which = col >> 9, c = col & 511;
          v4u* dst = (v4u*)(HT + (((size_t)which * 512 + c) * NB + b) * SEQ + t0);
          float pv = bf2f(raw[lane]), cv = bf2f(raw[66 + lane]);
#pragma unroll
          for (int q8 = 0; q8 < 8; ++q8) {
              float o[8];
#pragma unroll
              for (int i = 0; i < 8; ++i) { const float nv = bf2f(raw[(8 * q8 + i + 2) * 66 + lane]); o[i] = w0 * pv + w1 * cv + w2 * nv + bb; pv = cv; cv = nv; }
              v4u w; w.x = pk2(o[0], o[1]); w.y = pk2(o[2], o[3]); w.z = pk2(o[4], o[5]); w.w = pk2(o[6], o[7]);
              dst[q8] = w;
          }
          asm volatile("s_waitcnt lgkmcnt(0)" ::: "memory");
      }
    }
    const size_t gt = (size_t)F.bid * 512 + tid, NT = (size_t)F.G * 512;
    { const bf16* PR = (const bf16*)(ws + WS_PR); bf16* LIN = (bf16*)(ws + WS_TOP); const float* mu = AR.in[13];
      for (size_t i = gt; i < (size_t)M * 96; i += NT) {
          const int m = (int)(i / 96), cg4 = (int)(i % 96), t = m & (SEQ - 1); const int col = 1536 + 4 * cg4;
          const bf16* p = PR + (size_t)m * PR_P + col;
          const v2u c = *(const v2u*)p; v2u pv = {0u, 0u}, nv = {0u, 0u};
          if (t > 0) pv = *(const v2u*)(p - PR_P);
          if (t < SEQ - 1) nv = *(const v2u*)(p + PR_P);
          const f32x4 muv = *(const f32x4*)(mu + col);
          float u[4], pr[4], nx[4];
          u[0] = bflo(c.x); u[1] = bfhi(c.x); u[2] = bflo(c.y); u[3] = bfhi(c.y);
          pr[0] = bflo(pv.x); pr[1] = bfhi(pv.x); pr[2] = bflo(pv.y); pr[3] = bfhi(pv.y);
          nx[0] = bflo(nv.x); nx[1] = bfhi(nv.x); nx[2] = bflo(nv.y); nx[3] = bfhi(nv.y);
#pragma unroll
          for (int j = 0; j < 4; ++j) { float sft = u[j] + muv[j] * (0.5f * (pr[j] + nx[j]) - u[j]);
              if (cg4 < 32) sft = 2.0f * fsig(2.0f * sft) - 1.0f; else if (cg4 >= 64) sft = fsig(sft); u[j] = sft; }
          v2u o; o.x = pk2(u[0], u[1]); o.y = pk2(u[2], u[3]);
          *(v2u*)(LIN + (size_t)m * LORA_K + 4 * cg4) = o;
      } }
    { const float* H3T = (const float*)(ws + WS_H3T); const float* fw4 = AR.in[10]; const float* skip = AR.in[12];
      bf16* FT = (bf16*)(ws + WS_FT);
      for (int it = gw; it < 64 * 128; it += NGW) {
          const int pb = it & 63, cb8 = it >> 6; const int o = cb8 >> 6, c0 = (cb8 & 63) * 8;
          const int pos = pb * 64 + lane;
          float hf[8], hb[8];
#pragma unroll
          for (int e = 0; e < 8; ++e) { hf[e] = 0.f; hb[e] = 0.f; }
          const float* wrow = fw4 + o * 1024 + c0;
#pragma unroll 4
          for (int j = 0; j < 64; ++j) {
              const float hv = H3T[j * SEQ + pos];
              const f32x4 a0 = *(const f32x4*)(wrow + (size_t)j * 2048), a1 = *(const f32x4*)(wrow + (size_t)j * 2048 + 4);
              const f32x4 b0 = *(const f32x4*)(wrow + (size_t)j * 2048 + 512), b1 = *(const f32x4*)(wrow + (size_t)j * 2048 + 516);
#pragma unroll
              for (int e = 0; e < 4; ++e) { hf[e] += hv * a0[e]; hf[4 + e] += hv * a1[e]; hb[e] += hv * b0[e]; hb[4 + e] += hv * b1[e]; }
          }
          const float tpos = (float)pos / 4095.0f;
#pragma unroll
          for (int e = 0; e < 8; ++e) {
              const int c = c0 + e;
              const float delta = fabsf(HY_MIN_DECAY + (float)c * ((HY_MAX_DECAY - HY_MIN_DECAY) / 511.0f));
              bf16* TE = FT + (size_t)(o * 512 + c) * 16384; bf16* TO = TE + 8192;
              const float win = expf(-tpos * delta);
              if (pos == 0) { const bf16 v = (bf16)f2bf(hf[e] + hb[e] + skip[o * 512 + c]); TE[2 * 2048] = v; TO[2 * 2048 + 1] = v; TE[0] = 0; TE[1] = 0; TO[1] = 0; }
              else {
                  const bf16 vf = (bf16)f2bf(hf[e] * win), vb = (bf16)f2bf(hb[e] * win);
                  { const int d = pos, n = d >> 1;
                    if (d & 1) { TO[2 * (n + 2048)] = vf; if (n + 1 + 2048 < 4096) TE[2 * (n + 1 + 2048) + 1] = vf; }
                    else { TE[2 * (n + 2048)] = vf; TO[2 * (n + 2048) + 1] = vf; } }
                  { const int d = -pos, n = d >> 1;
                    if (d & 1) { TO[2 * (n + 2048)] = vb; TE[2 * (n + 1 + 2048) + 1] = vb; }
                    else { TE[2 * (n + 2048)] = vb; TO[2 * (n + 2048) + 1] = vb; } }
              }
          }
      } }
}

constexpr int HL_TE = 0, HL_TO = 16384 + 64, HL_Z = 32896, HZ_ROW = 80, HZ_PAD = 24;

__device__ __forceinline__ void hyena_item(Frame& F, const Args& AR, int c, bool dry) {
    LAS unsigned char* lds = F.lds; const int tid = F.tid, lane = F.lane, wave = F.wave;
    bf16* HT = (bf16*)((unsigned char*)F.out + DO_HT);
    const bf16* FT = (const bf16*)(F.ws + WS_FT);
    const int r = lane & 31, h = lane >> 5, par = r & 1;
    __syncthreads();
    if (tid < 240) { const int rr = tid / 5, ch = tid % 5; const int row = rr < 24 ? rr : 1024 + rr; v4u z = {0u, 0u, 0u, 0u}; *(LAS v4u*)(lds + HL_Z + row * HZ_ROW + 16 * ch) = z; }
    { const v4u* src = (const v4u*)(HT + ((size_t)0 * 512 + c) * NB * SEQ);
#pragma unroll
      for (int it = 0; it < 8; ++it) { const int rem = tid; const v4u v = src[it * 512 + rem];
          *(LAS v4u*)(lds + HL_Z + (((rem >> 2) * 8 + it) + HZ_PAD) * HZ_ROW + (rem & 3) * 16) = v; } }
    const int nb0 = 4 * wave;
    const int ta = (par ? HL_TO : HL_TE) + 4 * (((r - par) >> 1) - 4 * h + 2048);
    const int zb = HL_Z + (32 * nb0 + r + HZ_PAD) * HZ_ROW + 16 * h;
#define HY_LOADA(q_, AV) do { const LAS unsigned* tp_ = (const LAS unsigned*)(lds + ta + 64 * (q_)); \
        AV[0].x = tp_[0]; AV[0].y = tp_[-1]; AV[0].z = tp_[-2]; AV[0].w = tp_[-3]; AV[1].x = tp_[-8]; AV[1].y = tp_[-9]; AV[1].z = tp_[-10]; AV[1].w = tp_[-11]; } while (0)
#define HY_LOADB1(q_, BV, nn_) do { const LAS unsigned char* zp_ = lds + zb - 640 * (q_) + 2560 * (nn_); BV[0][nn_] = *(const LAS bf16x8*)zp_; BV[1][nn_] = *(const LAS bf16x8*)(zp_ + 32); } while (0)
#define HY_MMA1(AV, BV, nn_) do { acc[nn_] = __builtin_amdgcn_mfma_f32_32x32x16_bf16(__builtin_bit_cast(bf16x8, AV[0]), BV[0][nn_], acc[nn_], 0, 0, 0); \
        acc[nn_] = __builtin_amdgcn_mfma_f32_32x32x16_bf16(__builtin_bit_cast(bf16x8, AV[1]), BV[1][nn_], acc[nn_], 0, 0, 0); } while (0)
#define HY_PART(q_, M0, M1, M2, M3) do { v4u av_[2]; bf16x8 bv_[2][4]; HY_LOADA(q_, av_); \
        if (M0) HY_LOADB1(q_, bv_, 0); if (M1) HY_LOADB1(q_, bv_, 1); if (M2) HY_LOADB1(q_, bv_, 2); if (M3) HY_LOADB1(q_, bv_, 3); \
        if (M0) HY_MMA1(av_, bv_, 0); if (M1) HY_MMA1(av_, bv_, 1); if (M2) HY_MMA1(av_, bv_, 2); if (M3) HY_MMA1(av_, bv_, 3); } while (0)
#pragma unroll 1
    for (int o = 0; o < 2; ++o) {
        { const v4u* src = (const v4u*)(FT + ((size_t)o * 512 + c) * 16384);
#pragma unroll
          for (int it = 0; it < 4; ++it) { const int e = it * 512 + tid; const v4u v = src[e]; *(LAS v4u*)(lds + (e < 1024 ? HL_TE + e * 16 : HL_TO + (e - 1024) * 16)) = v; } }
        const bf16* XG = HT + ((size_t)(1 + o) * 512 + c) * NB * SEQ;
        v2u xv[4][4];
#pragma unroll
        for (int nn = 0; nn < 4; ++nn) { const int colg = 32 * (nb0 + nn) + r, tb = colg >> 3, b = colg & 7;
#pragma unroll
            for (int g = 0; g < 4; ++g) xv[nn][g] = *(const v2u*)(XG + (size_t)b * SEQ + 32 * tb + 8 * g + 4 * h); }
        __syncthreads();
        f32x16 acc[4];
#pragma unroll
        for (int nn = 0; nn < 4; ++nn)
#pragma unroll
            for (int j = 0; j < 16; ++j) acc[nn][j] = 0.f;
        const int qw = 16 * wave;
#pragma unroll 1
        for (int q = qw - 127; q < qw - 123; ++q) HY_PART(q, 1, 0, 0, 0);
#pragma unroll 1
        for (int q = qw - 123; q < qw - 119; ++q) HY_PART(q, 1, 1, 0, 0);
#pragma unroll 1
        for (int q = qw - 119; q < qw - 115; ++q) HY_PART(q, 1, 1, 1, 0);
        {
            v4u a0[2], a1[2]; bf16x8 b0[2][4], b1[2][4];
            HY_LOADA(qw - 115, a0); HY_LOADB1(qw - 115, b0, 0); HY_LOADB1(qw - 115, b0, 1); HY_LOADB1(qw - 115, b0, 2); HY_LOADB1(qw - 115, b0, 3);
#pragma unroll 1
            for (int q = qw - 115; q <= qw + 3; q += 2) {
                HY_LOADA(q + 1, a1); HY_LOADB1(q + 1, b1, 0); HY_LOADB1(q + 1, b1, 1); HY_LOADB1(q + 1, b1, 2); HY_LOADB1(q + 1, b1, 3);
                HY_MMA1(a0, b0, 0); HY_MMA1(a0, b0, 1); HY_MMA1(a0, b0, 2); HY_MMA1(a0, b0, 3);
                if (q + 1 <= qw + 3) {
                    HY_LOADA(q + 2, a0); HY_LOADB1(q + 2, b0, 0); HY_LOADB1(q + 2, b0, 1); HY_LOADB1(q + 2, b0, 2); HY_LOADB1(q + 2, b0, 3);
                    HY_MMA1(a1, b1, 0); HY_MMA1(a1, b1, 1); HY_MMA1(a1, b1, 2); HY_MMA1(a1, b1, 3);
                }
            }
        }
#pragma unroll 1
        for (int q = qw + 4; q < qw + 8; ++q) HY_PART(q, 0, 1, 1, 1);
#pragma unroll 1
        for (int q = qw + 8; q < qw + 12; ++q) HY_PART(q, 0, 0, 1, 1);
#pragma unroll 1
        for (int q = qw + 12; q < qw + 16; ++q) HY_PART(q, 0, 0, 0, 1);
        __syncthreads();
#pragma unroll
        for (int nn = 0; nn < 4; ++nn) {
            const int colg = 32 * (nb0 + nn) + r;
#pragma unroll
            for (int g = 0; g < 4; ++g) {
                const int i0 = 8 * g + 4 * h; const v2u x = xv[nn][g];
                v2u w; w.x = pk2(acc[nn][4 * g + 0] * bflo(x.x), acc[nn][4 * g + 1] * bfhi(x.x)); w.y = pk2(acc[nn][4 * g + 2] * bflo(x.y), acc[nn][4 * g + 3] * bfhi(x.y));
                *(LAS v2u*)(lds + HL_Z + (colg + HZ_PAD) * HZ_ROW + i0 * 2) = w;
            }
        }
        __syncthreads();
    }
#undef HY_LOADA
#undef HY_LOADB1
#undef HY_MMA1
#undef HY_PART
    if (!dry) { v4u* dst = (v4u*)(HT + ((size_t)0 * 512 + c) * NB * SEQ);
#pragma unroll
      for (int it = 0; it < 8; ++it) { const int rem = tid; dst[it * 512 + rem] = *(const LAS v4u*)(lds + HL_Z + (((rem >> 2) * 8 + it) + HZ_PAD) * HZ_ROW + (rem & 3) * 16); } }
}

constexpr int SC_SLOT = 464;
template <int CTRL> __device__ __forceinline__ float dppf(float x) { return __builtin_bit_cast(float, __builtin_amdgcn_update_dpp(0, __builtin_bit_cast(int, x), CTRL, 0xf, 0xf, true)); }
__device__ __forceinline__ float xsum16(float x) { float a = x, b = x; asm volatile("s_nop 1\n\tv_permlane16_swap_b32 %0, %1" : "+v"(a), "+v"(b)); return a + b; }
__device__ __forceinline__ float xsum32(float x) { float a = x, b = x; asm volatile("s_nop 1\n\tv_permlane32_swap_b32 %0, %1" : "+v"(a), "+v"(b)); return a + b; }
__device__ __forceinline__ float allsum4(const float (&p)[4], bool b0, bool b1) {
    const float m0 = b0 ? p[1] : p[0], g0 = b0 ? p[0] : p[1], m1 = b0 ? p[3] : p[2], g1 = b0 ? p[2] : p[3];
    const float q0 = m0 + dppf<0xB1>(g0), q1 = m1 + dppf<0xB1>(g1);
    const float mm = b1 ? q1 : q0, gg = b1 ? q0 : q1;
    float q = mm + dppf<0x4E>(gg);
    q += dppf<0x124>(q);
    q += dppf<0x128>(q);
    q = xsum16(q);
    q = xsum32(q);
    return q;
}
__device__ __forceinline__ float wave_allsum(float q) {
    q += dppf<0xB1>(q); q += dppf<0x4E>(q); q += dppf<0x124>(q); q += dppf<0x128>(q); q = xsum16(q); q = xsum32(q); return q;
}
constexpr int SC_YOFF = 16 * SC_SLOT;
struct ScanRaw { unsigned rc, kc, vc, rp, kp, vp, rn, kn, vn, wd, ad; };
__device__ __forceinline__ void rwkv_scan(Frame& F, const Args& AR, int bid) {
    const int seq = (bid & 7) + 8 * (bid >> 4), half = (bid >> 3) & 1;
    const int dir = seq >> 6, b = (seq >> 3) & 7, h = seq & 7, lane = F.lane, wave = F.wave, tid = F.tid;
    LAS float* ring = (LAS float*)F.lds;
    const int ch = h * 64 + lane, rbase = 32 * half + 4 * wave;
    const float* mu = AR.in[13];
    const float mu_r = mu[ch], mu_k = mu[512 + ch], mu_v = mu[1024 + ch];
    const float kk_c = AR.in[19][ch], ka_c = AR.in[20][ch], rk_c = AR.in[21][ch];
    const float w0_c = AR.in[14][dir * 512 + ch], a0_c = AR.in[16][dir * 512 + ch];
    const bf16* PRb = (const bf16*)(F.ws + WS_PR) + (size_t)b * SEQ * PR_P + ch;
    const bf16* Wd = (const bf16*)(F.ws + WS_LW) + (size_t)dir * ((size_t)M * 512) + (size_t)b * SEQ * 512 + ch;
    const bf16* Ad = (const bf16*)(F.ws + WS_LW) + (size_t)(2 + dir) * ((size_t)M * 512) + (size_t)b * SEQ * 512 + ch;
    bf16* YS = dir ? (bf16*)(F.ws + WS_TOP) : (bf16*)((unsigned char*)F.out + DO_YSF);
    YS += (size_t)b * SEQ * 512 + h * 64 + 32 * half;
    float* BON = (float*)(F.ws + WS_BONUS) + ((size_t)dir * M + (size_t)b * SEQ) * 8;
    float S[4];
#pragma unroll
    for (int i = 0; i < 4; ++i) S[i] = 0.f;
    const bool b0 = (lane & 1) != 0, b1 = (lane & 2) != 0;
    ScanRaw R;
#define SC_LOAD(jj) do { const int s_ = 8 * (jj) + wave, tau_ = dir ? SEQ - 1 - s_ : s_; const bf16* row_ = PRb + (size_t)tau_ * PR_P; \
        const int up_ = tau_ > 0 ? -PR_P : 0, dn_ = tau_ < SEQ - 1 ? PR_P : 0; \
        R.rc = row_[0]; R.kc = row_[512]; R.vc = row_[1024]; R.rp = row_[up_]; R.kp = row_[512 + up_]; R.vp = row_[1024 + up_]; \
        R.rn = row_[dn_]; R.kn = row_[512 + dn_]; R.vn = row_[1024 + dn_]; R.wd = Wd[(size_t)tau_ * 512]; R.ad = Ad[(size_t)tau_ * 512]; } while (0)
    SC_LOAD(0);
    __syncthreads();
#pragma unroll 1
    for (int j = 0; j < SEQ / 8; ++j) {
        {
            const int s = 8 * j + wave, tau = dir ? SEQ - 1 - s : s;
            const float rc = bf2f(R.rc), kc = bf2f(R.kc), vc = bf2f(R.vc);
            const float pm = tau > 0 ? 1.f : 0.f, nm = tau < SEQ - 1 ? 1.f : 0.f;
            const float rp = pm * bf2f(R.rp), kp = pm * bf2f(R.kp), vp = pm * bf2f(R.vp), rn = nm * bf2f(R.rn), kn = nm * bf2f(R.kn), vn = nm * bf2f(R.vn);
            const float rr = rc + mu_r * (0.5f * (rp + rn) - rc), kx = kc + mu_k * (0.5f * (kp + kn) - kc), vx = vc + mu_v * (0.5f * (vp + vn) - vc);
            const float wv = __expf(-0.60653065971f * sigmoidf_(w0_c + bf2f(R.wd))), av = sigmoidf_(a0_c + bf2f(R.ad));
            const float kkr = kx * kk_c; const float ss = wave_allsum(kkr * kkr); const float kk = kkr / fmaxf(sqrtf(ss), 1e-12f);
            const float kd = kx * (1.0f + (av - 1.0f) * ka_c), kka = kk * av;
            const float c2 = wave_allsum(rr * kd), c1 = wave_allsum(rr * kka);
            const float bon = wave_allsum(rr * kd * rk_c);
            LAS float* sl = ring + ((j & 1) * 8 + wave) * SC_SLOT;
            sl[lane] = -kk; sl[64 + lane] = wv; sl[128 + lane] = kka; sl[192 + lane] = kd; sl[256 + lane] = wv * rr; sl[320 + lane] = vx; sl[384 + lane] = vx * c2;
            if (lane == 0) sl[448] = c1;
            if (lane == 0 && half == 0) BON[(size_t)tau * 8 + h] = bon;
        }
        if (j + 1 < SEQ / 8) SC_LOAD(j + 1);
        __syncthreads();
        if (j > 0 && tid < 256) {
            const int u = tid >> 5, rrow = tid & 31, s = 8 * (j - 1) + u, tau = dir ? SEQ - 1 - s : s;
            YS[(size_t)tau * 512 + rrow] = (bf16)f2bf(ring[SC_YOFF + (((j - 1) & 1) * 8 + u) * 32 + rrow]);
        }
        {
            const LAS float* sl0 = ring + ((j & 1) * 8) * SC_SLOT;
            float nkk = sl0[lane], w = sl0[64 + lane], kka = sl0[128 + lane], kd = sl0[192 + lane], wr = sl0[256 + lane], vc2 = sl0[384 + rbase + (lane & 3)], c1 = sl0[448];
            f32x4 va = *(const LAS f32x4*)(sl0 + 320 + rbase);
#pragma unroll
            for (int u = 0; u < 8; ++u) {
                float nkk_n = 0.f, w_n = 0.f, kka_n = 0.f, kd_n = 0.f, wr_n = 0.f, vc2_n = 0.f, c1_n = 0.f; f32x4 va_n = {0.f, 0.f, 0.f, 0.f};
                if (u < 7) { const LAS float* sl = sl0 + (u + 1) * SC_SLOT;
                    nkk_n = sl[lane]; w_n = sl[64 + lane]; kka_n = sl[128 + lane]; kd_n = sl[192 + lane]; wr_n = sl[256 + lane]; vc2_n = sl[384 + rbase + (lane & 3)]; c1_n = sl[448];
                    va_n = *(const LAS f32x4*)(sl + 320 + rbase); }
                float p[4], pp[4];
#pragma unroll
                for (int i = 0; i < 4; ++i) { p[i] = S[i] * nkk; pp[i] = S[i] * wr; }
                const float q = allsum4(p, b0, b1);
                const float qy = allsum4(pp, b0, b1);
                const float sa[4] = {dppf<0x00>(q), dppf<0x55>(q), dppf<0xAA>(q), dppf<0xFF>(q)};
#pragma unroll
                for (int i = 0; i < 4; ++i) S[i] = S[i] * w + (sa[i] * kka + va[i] * kd);
                const float y = qy + (q * c1 + vc2);
                if (lane < 4) ring[SC_YOFF + ((j & 1) * 8 + u) * 32 + 4 * wave + lane] = y;
                nkk = nkk_n; w = w_n; kka = kka_n; kd = kd_n; wr = wr_n; vc2 = vc2_n; c1 = c1_n; va = va_n;
            }
        }
    }
    __syncthreads();
    if (tid < 256) { const int j = SEQ / 8; const int u = tid >> 5, rrow = tid & 31, s = 8 * (j - 1) + u, tau = dir ? SEQ - 1 - s : s;
        YS[(size_t)tau * 512 + rrow] = (bf16)f2bf(ring[SC_YOFF + (((j - 1) & 1) * 8 + u) * 32 + rrow]); }
#undef SC_LOAD
}

constexpr int S2_W = 0, S2_KKA = 64, S2_KD = 128, S2_VX = 192, S2_C = 256, S2_NKKB = 260, S2_WRB = 292, S2_ZB = 324, S2_SLOT = 368;
constexpr int S2_YOFF = 16 * S2_SLOT;
__device__ __forceinline__ void rwkv_scan2(Frame& F, const Args& AR, int seq) {
    const int dir = seq >> 6, b = (seq >> 3) & 7, h = seq & 7, lane = F.lane, wave = F.wave, tid = F.tid;
    LAS float* ring = (LAS float*)F.lds;
    bf16* YS = dir ? (bf16*)(F.ws + WS_TOP) : (bf16*)((unsigned char*)F.out + DO_YSF);
    YS += (size_t)b * SEQ * 512 + h * 64;
    __syncthreads();
    for (int i = tid; i < 16 * 32; i += 512) ring[(i >> 5) * S2_SLOT + S2_ZB + (i & 31)] = 0.f;
    constexpr int NBLK = SEQ / 8;
    if (wave >= 4) {
        const int p = wave - 4, ch = h * 64 + lane;
        const float* mu = AR.in[13];
        const float mu_r = mu[ch], mu_k = mu[512 + ch], mu_v = mu[1024 + ch];
        const float kk_c = AR.in[19][ch], ka_c = AR.in[20][ch], rk_c = AR.in[21][ch];
        const float w0_c = AR.in[14][dir * 512 + ch], a0_c = AR.in[16][dir * 512 + ch];
        const bf16* PRb = (const bf16*)(F.ws + WS_PR) + (size_t)b * SEQ * PR_P + ch;
        const bf16* Wd = (const bf16*)(F.ws + WS_LW) + (size_t)dir * ((size_t)M * 512) + (size_t)b * SEQ * 512 + ch;
        const bf16* Ad = (const bf16*)(F.ws + WS_LW) + (size_t)(2 + dir) * ((size_t)M * 512) + (size_t)b * SEQ * 512 + ch;
        float* BON = (float*)(F.ws + WS_BONUS) + ((size_t)dir * M + (size_t)b * SEQ) * 8;
        ScanRaw R[2];
#define S2_LOAD(jj) do { _Pragma("unroll") for (int e_ = 0; e_ < 2; ++e_) { const int s_ = 8 * (jj) + p + 4 * e_, tau_ = dir ? SEQ - 1 - s_ : s_; const bf16* row_ = PRb + (size_t)tau_ * PR_P; \
            const int up_ = tau_ > 0 ? -PR_P : 0, dn_ = tau_ < SEQ - 1 ? PR_P : 0; \
            R[e_].rc = row_[0]; R[e_].kc = row_[512]; R[e_].vc = row_[1024]; R[e_].rp = row_[up_]; R[e_].kp = row_[512 + up_]; R[e_].vp = row_[1024 + up_]; \
            R[e_].rn = row_[dn_]; R[e_].kn = row_[512 + dn_]; R[e_].vn = row_[1024 + dn_]; R[e_].wd = Wd[(size_t)tau_ * 512]; R[e_].ad = Ad[(size_t)tau_ * 512]; } } while (0)
#define S2_PRODUCE(jj) do { _Pragma("unroll") for (int e_ = 0; e_ < 2; ++e_) { const int u_ = p + 4 * e_, s_ = 8 * (jj) + u_, tau_ = dir ? SEQ - 1 - s_ : s_; \
            const float rc = bf2f(R[e_].rc), kc = bf2f(R[e_].kc), vc = bf2f(R[e_].vc); \
            const float pm = tau_ > 0 ? 1.f : 0.f, nm = tau_ < SEQ - 1 ? 1.f : 0.f; \
            const float rp = pm * bf2f(R[e_].rp), kp = pm * bf2f(R[e_].kp), vp = pm * bf2f(R[e_].vp), rn = nm * bf2f(R[e_].rn), kn = nm * bf2f(R[e_].kn), vn = nm * bf2f(R[e_].vn); \
            const float rr = rc + mu_r * (0.5f * (rp + rn) - rc), kx = kc + mu_k * (0.5f * (kp + kn) - kc), vx = vc + mu_v * (0.5f * (vp + vn) - vc); \
            const float wv = __expf(-0.60653065971f * fsig(w0_c + bf2f(R[e_].wd))), av = fsig(a0_c + bf2f(R[e_].ad)); \
            const float kkr = kx * kk_c, kd = kx * (1.0f + (av - 1.0f) * ka_c), rkd = rr * kd; \
            const float ps_[4] = {kkr * kkr, rr * kkr * av, rkd, rkd * rk_c}; \
            const float tot_ = allsum4(ps_, (lane & 1) != 0, (lane & 2) != 0); \
            const float ss = dppf<0x00>(tot_), c1r = dppf<0x55>(tot_), c2 = dppf<0xAA>(tot_), bon = dppf<0xFF>(tot_); \
            const float rn_ = __builtin_amdgcn_rsqf(fmaxf(ss, 1e-24f)); const float kk = kkr * rn_, kka = kk * av, c1 = c1r * rn_; \
            LAS float* sl = ring + (((jj) & 1) * 8 + u_) * S2_SLOT; \
            sl[S2_W + lane] = wv; sl[S2_KKA + lane] = kka; sl[S2_KD + lane] = kd; sl[S2_VX + lane] = vx; \
            ((LAS bf16*)(sl + S2_NKKB))[lane] = (bf16)f2bf(-kk); ((LAS bf16*)(sl + S2_WRB))[lane] = (bf16)f2bf(wv * rr); \
            if (lane == 0) { sl[S2_C] = c1; sl[S2_C + 1] = c2; BON[(size_t)tau_ * 8 + h] = bon; } } } while (0)
        S2_LOAD(0); S2_PRODUCE(0); S2_LOAD(1);
        __syncthreads();
#pragma unroll 1
        for (int j = 0; j < NBLK; ++j) {
            if (j + 1 < NBLK) { S2_PRODUCE(j + 1); if (j + 2 < NBLK) S2_LOAD(j + 2); }
            if (j > 0) {
                const int pt = tid - 256;
#pragma unroll
                for (int e = 0; e < 2; ++e) { const int idx = pt + 256 * e, u = idx >> 6, rrow = idx & 63, s = 8 * (j - 1) + u, tau = dir ? SEQ - 1 - s : s;
                    YS[(size_t)tau * 512 + rrow] = (bf16)f2bf(ring[S2_YOFF + (((j - 1) & 1) * 8 + u) * 64 + rrow]); }
            }
            __syncthreads();
        }
        { const int j = NBLK; const int pt = tid - 256;
#pragma unroll
          for (int e = 0; e < 2; ++e) { const int idx = pt + 256 * e, u = idx >> 6, rrow = idx & 63, s = 8 * (j - 1) + u, tau = dir ? SEQ - 1 - s : s;
              YS[(size_t)tau * 512 + rrow] = (bf16)f2bf(ring[S2_YOFF + (((j - 1) & 1) * 8 + u) * 64 + rrow]); } }
#undef S2_LOAD
#undef S2_PRODUCE
    } else {
        const int c = lane & 15, g = lane >> 4, row = 16 * wave + c;
        const int aoff = (((c & 3) == 0) ? S2_NKKB : ((c & 3) == 1) ? S2_WRB : S2_ZB) * 4 + (((c & 3) < 2) ? 16 * g : 0);
        const int aoff1 = aoff + (((c & 3) < 2) ? 64 : 0);
        float S[16];
#pragma unroll
        for (int i = 0; i < 16; ++i) S[i] = 0.f;
        __syncthreads();
#pragma unroll 1
        for (int j = 0; j < NBLK; ++j) {
            const LAS float* sl0 = ring + ((j & 1) * 8) * S2_SLOT;
            f32x4 w4[4], ka4[4], kd4[4]; bf16x8 A0, A1; float vv, c1, c2;
#define S2_CLOAD(sl) do { const LAS float* sl_ = (sl); \
            w4[0] = *(const LAS f32x4*)(sl_ + S2_W + 8 * g); w4[1] = *(const LAS f32x4*)(sl_ + S2_W + 8 * g + 4); w4[2] = *(const LAS f32x4*)(sl_ + S2_W + 32 + 8 * g); w4[3] = *(const LAS f32x4*)(sl_ + S2_W + 36 + 8 * g); \
            ka4[0] = *(const LAS f32x4*)(sl_ + S2_KKA + 8 * g); ka4[1] = *(const LAS f32x4*)(sl_ + S2_KKA + 8 * g + 4); ka4[2] = *(const LAS f32x4*)(sl_ + S2_KKA + 32 + 8 * g); ka4[3] = *(const LAS f32x4*)(sl_ + S2_KKA + 36 + 8 * g); \
            kd4[0] = *(const LAS f32x4*)(sl_ + S2_KD + 8 * g); kd4[1] = *(const LAS f32x4*)(sl_ + S2_KD + 8 * g + 4); kd4[2] = *(const LAS f32x4*)(sl_ + S2_KD + 32 + 8 * g); kd4[3] = *(const LAS f32x4*)(sl_ + S2_KD + 36 + 8 * g); \
            A0 = *(const LAS bf16x8*)((const LAS unsigned char*)sl_ + aoff); A1 = *(const LAS bf16x8*)((const LAS unsigned char*)sl_ + aoff1); \
            vv = sl_[S2_VX + row]; c1 = sl_[S2_C]; c2 = sl_[S2_C + 1]; } while (0)
            S2_CLOAD(sl0);
#pragma unroll
            for (int u = 0; u < 8; ++u) {
                const f32x4 cw0 = w4[0], cw1 = w4[1], cw2 = w4[2], cw3 = w4[3], ca0 = ka4[0], ca1 = ka4[1], ca2 = ka4[2], ca3 = ka4[3], cd0 = kd4[0], cd1 = kd4[1], cd2 = kd4[2], cd3 = kd4[3];
                const bf16x8 cA0 = A0, cA1 = A1; const float cvv = vv, cc1 = c1, cc2 = c2;
                if (u < 7) S2_CLOAD(sl0 + (u + 1) * S2_SLOT);
                v4u b0v, b1v;
                b0v.x = cvt_pk_bf16(S[0], S[1]); b0v.y = cvt_pk_bf16(S[2], S[3]); b0v.z = cvt_pk_bf16(S[4], S[5]); b0v.w = cvt_pk_bf16(S[6], S[7]);
                b1v.x = cvt_pk_bf16(S[8], S[9]); b1v.y = cvt_pk_bf16(S[10], S[11]); b1v.z = cvt_pk_bf16(S[12], S[13]); b1v.w = cvt_pk_bf16(S[14], S[15]);
                const f32x4 zz = {0.f, 0.f, 0.f, 0.f};
                const f32x4 acc0 = __builtin_amdgcn_mfma_f32_16x16x32_bf16(cA0, __builtin_bit_cast(bf16x8, b0v), zz, 0, 0, 0);
                const f32x4 acc1 = __builtin_amdgcn_mfma_f32_16x16x32_bf16(cA1, __builtin_bit_cast(bf16x8, b1v), zz, 0, 0, 0);
                float t[16];
#pragma unroll
                for (int i = 0; i < 4; ++i) {
                    t[i] = S[i] * cw0[i] + cvv * cd0[i]; t[4 + i] = S[4 + i] * cw1[i] + cvv * cd1[i];
                    t[8 + i] = S[8 + i] * cw2[i] + cvv * cd2[i]; t[12 + i] = S[12 + i] * cw3[i] + cvv * cd3[i];
                }
                const float sa = acc0[0] + acc1[0], yp = acc0[1] + acc1[1];
#pragma unroll
                for (int i = 0; i < 4; ++i) {
                    S[i] = sa * ca0[i] + t[i]; S[4 + i] = sa * ca1[i] + t[4 + i]; S[8 + i] = sa * ca2[i] + t[8 + i]; S[12 + i] = sa * ca3[i] + t[12 + i];
                }
                const float y = yp + (sa * cc1 + cvv * cc2);
                if (g == 0) ring[S2_YOFF + ((j & 1) * 8 + u) * 64 + row] = y;
            }
            __syncthreads();
        }
#undef S2_CLOAD
    }
    __syncthreads();
}

constexpr int S3_IMG_A = 0, S3_IMG_R = 2048, S3_A4 = 4096, S3_ALU = 8192, S3_ALY = 9216, S3_VB = 10240, S3_PC = 12288, S3_SLOT = 12544;
constexpr int S3_NSLOT = 8, S3_NPROD = 6;
constexpr int S3_SCR = S3_NSLOT * S3_SLOT;
constexpr int S3_SCR_SZ = 6144;
constexpr int S3_FLAGS = S3_SCR + S3_NPROD * S3_SCR_SZ;
static_assert(S3_FLAGS + 256 <= MISC_OFF, "scan LDS map");
constexpr unsigned S3_SPIN = 1u << 22;
struct S3Raw { unsigned r, k, v, wd, ad; };
__device__ __forceinline__ float allsum2_bcast(float p0, float p1, bool b0, float& o1) {
    const float m = b0 ? p1 : p0, g = b0 ? p0 : p1;
    float q = m + dppf<0xB1>(g);
    q += dppf<0x4E>(q); q += dppf<0x124>(q); q += dppf<0x128>(q); q = xsum16(q); q = xsum32(q);
    o1 = dppf<0xF5>(q);
    return dppf<0xA0>(q);
}
__device__ __forceinline__ void rwkv_scan3(Frame& F, const Args& AR, int seq) {
    const int dir = seq >> 6, b = (seq >> 3) & 7, h = seq & 7, lane = F.lane, wave = F.wave, tid = F.tid;
    LAS unsigned char* lds = F.lds;
    volatile LAS unsigned* flags = (volatile LAS unsigned*)(lds + S3_FLAGS);
    constexpr int NBLK = SEQ / 16;
    __syncthreads();
    if (tid < 64) flags[tid] = 0u;
    __syncthreads();
    if (wave >= 2) {
        const int p = wave - 2, ch = h * 64 + lane;
        const float* mu = AR.in[13];
        const float mu_r = mu[ch], mu_k = mu[512 + ch], mu_v = mu[1024 + ch];
        const float kk_c = AR.in[19][ch], ka_c = AR.in[20][ch], rk_c = AR.in[21][ch];
        const float w0_c = AR.in[14][dir * 512 + ch], a0_c = AR.in[16][dir * 512 + ch];
        const bf16* PRb = (const bf16*)(F.ws + WS_PR) + (size_t)b * SEQ * PR_P + ch;
        const bf16* Wd = (const bf16*)(F.ws + WS_LW) + (size_t)dir * ((size_t)M * 512) + (size_t)b * SEQ * 512 + ch;
        const bf16* Ad = (const bf16*)(F.ws + WS_LW) + (size_t)(2 + dir) * ((size_t)M * 512) + (size_t)b * SEQ * 512 + ch;
        float* BON = (float*)(F.ws + WS_BONUS) + ((size_t)dir * M + (size_t)b * SEQ) * 8;
        LAS unsigned char* scr = lds + S3_SCR + p * S3_SCR_SZ;
        const int k32 = lane & 31, kbk = lane >> 5, gk = (k32 >> 2) & 3, jk = 4 * (k32 >> 4) + (k32 & 3);
        const int img_off = ((kbk * 64 + 16 * gk) * 8 + jk) * 2;
        const bool b0 = (lane & 1) != 0;
#define S3_LOAD(RR, blk_, e_, with_da) do { const int t_ = 16 * (blk_) + (e_); const bool ok_ = (t_ >= 0) && (t_ < SEQ) && ((blk_) < NBLK); \
            const int tc_ = ok_ ? t_ : 0; const int tau_ = dir ? SEQ - 1 - tc_ : tc_; const bf16* row_ = PRb + (size_t)tau_ * PR_P; \
            RR.r = ok_ ? (unsigned)row_[0] : 0u; RR.k = ok_ ? (unsigned)row_[512] : 0u; RR.v = ok_ ? (unsigned)row_[1024] : 0u; \
            if (with_da) { RR.wd = Wd[(size_t)tau_ * 512]; RR.ad = Ad[(size_t)tau_ * 512]; } } while (0)
        S3Raw R[8], Hm, H16;
        {
            S3_LOAD(Hm, p, -1, false);
#pragma unroll
            for (int e = 0; e < 8; ++e) S3_LOAD(R[e], p, e, true);
        }
#pragma unroll 1
        for (int blk = p; blk < NBLK; blk += S3_NPROD) {
            const int slot = blk % S3_NSLOT;
            LAS unsigned char* sl = lds + slot * S3_SLOT;
            if (blk >= S3_NSLOT) {
                unsigned sp = 0; const unsigned want = (unsigned)(blk - S3_NSLOT + 1);
                while (flags[8 + slot * 2 + 0] < want || flags[8 + slot * 2 + 1] < want) {
                    __builtin_amdgcn_s_sleep(2); if (++sp > S3_SPIN) { flags[63] = 1u; break; } }
            }
            asm volatile("" ::: "memory");
            float bbar[16], kbar[16];
            float P = 1.0f;
            float cr = 0.f, ck = 0.f, cv = 0.f, pr = bf2f(Hm.r), pk = bf2f(Hm.k), pv = bf2f(Hm.v);
            cr = bf2f(R[0].r); ck = bf2f(R[0].k); cv = bf2f(R[0].v);
#pragma unroll
            for (int s = 0; s < 16; ++s) {
                if (s == 8) S3_LOAD(H16, blk, 16, false);
                float nr, nk, nv;
                if (s < 15) { nr = bf2f(R[(s + 1) & 7].r); nk = bf2f(R[(s + 1) & 7].k); nv = bf2f(R[(s + 1) & 7].v); }
                else { nr = bf2f(H16.r); nk = bf2f(H16.k); nv = bf2f(H16.v); }
                const float wdv = bf2f(R[s & 7].wd), adv = bf2f(R[s & 7].ad);
                if (s < 8) S3_LOAD(R[s & 7], blk, s + 8, true); else S3_LOAD(R[s & 7], blk + S3_NPROD, s - 8, true);
                if (s == 15) S3_LOAD(Hm, blk + S3_NPROD, -1, false);
                const int t = 16 * blk + s, tau = dir ? SEQ - 1 - t : t;
                const float rr = cr + mu_r * (0.5f * (pr + nr) - cr), kx = ck + mu_k * (0.5f * (pk + nk) - ck), vx = cv + mu_v * (0.5f * (pv + nv) - cv);
                const float wv = __expf(-0.60653065971f * fsig(w0_c + wdv)), av = fsig(a0_c + adv);
                const float kkr = kx * kk_c, kd = kx * (1.0f + (av - 1.0f) * ka_c);
                float bon; const float ss = allsum2_bcast(kkr * kkr, rr * kd * rk_c, b0, bon);
                const float kk = kkr * __builtin_amdgcn_rsqf(fmaxf(ss, 1e-24f)), kka = kk * av;
                const float Pprev = P; P = P * wv; const float iP = __builtin_amdgcn_rcpf(P);
                const float ab = -Pprev * kk, bb = kka * iP, kb = kd * iP, rb = P * rr;
                bbar[s] = bb; kbar[s] = kb;
                *(LAS bf16*)(sl + S3_IMG_A + img_off + 16 * s) = (bf16)f2bf(ab);
                *(LAS bf16*)(sl + S3_IMG_R + img_off + 16 * s) = (bf16)f2bf(rb);
                *(LAS bf16*)(scr + img_off + 16 * s) = (bf16)f2bf(bb);
                *(LAS bf16*)(scr + 2048 + img_off + 16 * s) = (bf16)f2bf(kb);
                *(LAS bf16*)(sl + S3_VB + lane * 32 + 2 * s) = (bf16)f2bf(vx);
                if (lane == 0) BON[(size_t)tau * 8 + h] = bon;
                pr = cr; pk = ck; pv = cv; cr = nr; ck = nk; cv = nv;
            }
            *(LAS float*)(sl + S3_PC + 4 * lane) = P;
#pragma unroll
            for (int g = 0; g < 4; ++g) {
                v4u w4; w4.x = cvtpk2(bbar[4 * g] * P, bbar[4 * g + 1] * P); w4.y = cvtpk2(bbar[4 * g + 2] * P, bbar[4 * g + 3] * P);
                w4.z = cvtpk2(kbar[4 * g] * P, kbar[4 * g + 1] * P); w4.w = cvtpk2(kbar[4 * g + 2] * P, kbar[4 * g + 3] * P);
                *(LAS v4u*)(sl + S3_A4 + (((lane >> 4) * 64 + (lane & 15) + 16 * g) * 16)) = w4;
            }
            asm volatile("s_waitcnt lgkmcnt(0)" ::: "memory");
            {
                const bf16x8 Ab0 = *(const LAS bf16x8*)(scr + lane * 16), Ab1 = *(const LAS bf16x8*)(scr + 1024 + lane * 16);
                const bf16x8 Ak0 = *(const LAS bf16x8*)(scr + 2048 + lane * 16), Ak1 = *(const LAS bf16x8*)(scr + 3072 + lane * 16);
                const bf16x8 Ba0 = *(const LAS bf16x8*)(sl + S3_IMG_A + lane * 16), Ba1 = *(const LAS bf16x8*)(sl + S3_IMG_A + 1024 + lane * 16);
                const bf16x8 Br0 = *(const LAS bf16x8*)(sl + S3_IMG_R + lane * 16), Br1 = *(const LAS bf16x8*)(sl + S3_IMG_R + 1024 + lane * 16);
                const f32x4 zz = {0.f, 0.f, 0.f, 0.f};
                f32x4 gab = __builtin_amdgcn_mfma_f32_16x16x32_bf16(Ab0, Ba0, zz, 0, 0, 0); gab = __builtin_amdgcn_mfma_f32_16x16x32_bf16(Ab1, Ba1, gab, 0, 0, 0);
                f32x4 gak = __builtin_amdgcn_mfma_f32_16x16x32_bf16(Ak0, Ba0, zz, 0, 0, 0); gak = __builtin_amdgcn_mfma_f32_16x16x32_bf16(Ak1, Ba1, gak, 0, 0, 0);
                f32x4 gbr = __builtin_amdgcn_mfma_f32_16x16x32_bf16(Ab0, Br0, zz, 0, 0, 0); gbr = __builtin_amdgcn_mfma_f32_16x16x32_bf16(Ab1, Br1, gbr, 0, 0, 0);
                f32x4 gkr = __builtin_amdgcn_mfma_f32_16x16x32_bf16(Ak0, Br0, zz, 0, 0, 0); gkr = __builtin_amdgcn_mfma_f32_16x16x32_bf16(Ak1, Br1, gkr, 0, 0, 0);
                const int tt = lane & 15, g4 = 4 * (lane >> 4);
#pragma unroll
                for (int e = 0; e < 4; ++e) { const bool lt = (g4 + e) < tt, le = (g4 + e) <= tt;
                    gab[e] = lt ? gab[e] : 0.f; gak[e] = lt ? gak[e] : 0.f; gbr[e] = le ? gbr[e] : 0.f; gkr[e] = le ? gkr[e] : 0.f; }
                v2u wk; wk.x = cvtpk2(gak[0], gak[1]); wk.y = cvtpk2(gak[2], gak[3]);
                *(LAS v2u*)(sl + S3_ALU + lane * 16 + 8) = wk;
                wk.x = cvtpk2(gkr[0], gkr[1]); wk.y = cvtpk2(gkr[2], gkr[3]);
                *(LAS v2u*)(sl + S3_ALY + lane * 16 + 8) = wk;
                *(LAS f32x4*)(scr + 4096 + (tt * 16 + g4) * 4) = gab;
#pragma unroll
                for (int e = 0; e < 4; ++e) *(LAS float*)(scr + 5120 + ((g4 + e) * 16 + tt) * 4) = gbr[e];
            }
            asm volatile("s_waitcnt lgkmcnt(0)" ::: "memory");
            {
                const int ti = lane & 15, q4 = 4 * (lane >> 4);
                float Tr[16];
#pragma unroll
                for (int t = 0; t < 16; ++t) {
                    float a = (ti == t) ? 1.0f : 0.0f;
#pragma unroll
                    for (int m4 = 0; m4 < (t + 3) / 4; ++m4) { const f32x4 lv = *(const LAS f32x4*)(scr + 4096 + (t * 16 + 4 * m4) * 4);
#pragma unroll
                        for (int e = 0; e < 4; ++e) if (4 * m4 + e < t) a += Tr[4 * m4 + e] * lv[e]; }
                    Tr[t] = a;
                }
                float tl[4] = {0.f, 0.f, 0.f, 0.f};
#pragma unroll
                for (int m = 0; m < 16; ++m) { const f32x4 lv = *(const LAS f32x4*)(scr + 5120 + (m * 16 + q4) * 4);
#pragma unroll
                    for (int e = 0; e < 4; ++e) tl[e] += Tr[m] * lv[e]; }
#pragma unroll
                for (int e = 0; e < 4; ++e) { const int t = q4 + e;
                    float tv = 0.f;
#pragma unroll
                    for (int t2 = 0; t2 < 16; ++t2) tv = (t2 == t) ? Tr[t2] : tv;
                    tv -= (ti == t) ? 1.0f : 0.0f;
                    const int off = ((t + 16 * (ti >> 2)) * 8 + (ti & 3)) * 2;
                    *(LAS bf16*)(sl + S3_ALU + off) = (bf16)f2bf(tv);
                    *(LAS bf16*)(sl + S3_ALY + off) = (bf16)f2bf(tl[e]); }
            }
            asm volatile("s_waitcnt lgkmcnt(0)" ::: "memory");
            if (lane == 0) flags[slot] = (unsigned)(blk + 1);
        }
#undef S3_LOAD
    } else {
        const int c = lane & 15, g = lane >> 4, row0 = 32 * wave + c;
        bf16* YS = dir ? (bf16*)(F.ws + WS_TOP) : (bf16*)((unsigned char*)F.out + DO_YSF);
        YS += (size_t)b * SEQ * 512 + h * 64 + row0;
        f32x4 St[2][4];
#pragma unroll
        for (int rt = 0; rt < 2; ++rt)
#pragma unroll
            for (int q = 0; q < 4; ++q) St[rt][q] = (f32x4){0.f, 0.f, 0.f, 0.f};
#pragma unroll 1
        for (int blk = 0; blk < NBLK; ++blk) {
            const int slot = blk % S3_NSLOT;
            const LAS unsigned char* sl = lds + slot * S3_SLOT;
            { unsigned sp = 0; const unsigned want = (unsigned)(blk + 1);
              while (flags[slot] != want) { __builtin_amdgcn_s_sleep(1); if (++sp > S3_SPIN) { flags[63] = 1u; break; } } }
            asm volatile("" ::: "memory");
            const bf16x8 Aa0 = *(const LAS bf16x8*)(sl + S3_IMG_A + lane * 16), Aa1 = *(const LAS bf16x8*)(sl + S3_IMG_A + 1024 + lane * 16);
            const bf16x8 Ar0 = *(const LAS bf16x8*)(sl + S3_IMG_R + lane * 16), Ar1 = *(const LAS bf16x8*)(sl + S3_IMG_R + 1024 + lane * 16);
            const bf16x8 ALU = *(const LAS bf16x8*)(sl + S3_ALU + lane * 16), ALY = *(const LAS bf16x8*)(sl + S3_ALY + lane * 16);
            const bf16x8 A40 = *(const LAS bf16x8*)(sl + S3_A4 + lane * 16), A41 = *(const LAS bf16x8*)(sl + S3_A4 + 1024 + lane * 16);
            const bf16x8 A42 = *(const LAS bf16x8*)(sl + S3_A4 + 2048 + lane * 16), A43 = *(const LAS bf16x8*)(sl + S3_A4 + 3072 + lane * 16);
            const f32x4 pc0 = *(const LAS f32x4*)(sl + S3_PC + (4 * g) * 4), pc1 = *(const LAS f32x4*)(sl + S3_PC + (16 + 4 * g) * 4);
            const f32x4 pc2 = *(const LAS f32x4*)(sl + S3_PC + (32 + 4 * g) * 4), pc3 = *(const LAS f32x4*)(sl + S3_PC + (48 + 4 * g) * 4);
            v2u vb[2];
#pragma unroll
            for (int rt = 0; rt < 2; ++rt) vb[rt] = *(const LAS v2u*)(sl + S3_VB + (row0 + 16 * rt) * 32 + 8 * g);
            f32x4 Ym[2];
#pragma unroll
            for (int rt = 0; rt < 2; ++rt) {
                v4u bs0, bs1;
                bs0.x = cvtpk2(St[rt][0][0], St[rt][0][1]); bs0.y = cvtpk2(St[rt][0][2], St[rt][0][3]); bs0.z = cvtpk2(St[rt][1][0], St[rt][1][1]); bs0.w = cvtpk2(St[rt][1][2], St[rt][1][3]);
                bs1.x = cvtpk2(St[rt][2][0], St[rt][2][1]); bs1.y = cvtpk2(St[rt][2][2], St[rt][2][3]); bs1.z = cvtpk2(St[rt][3][0], St[rt][3][1]); bs1.w = cvtpk2(St[rt][3][2], St[rt][3][3]);
                const f32x4 zz = {0.f, 0.f, 0.f, 0.f};
                f32x4 d1u = __builtin_amdgcn_mfma_f32_16x16x32_bf16(Aa0, __builtin_bit_cast(bf16x8, bs0), zz, 0, 0, 0);
                d1u = __builtin_amdgcn_mfma_f32_16x16x32_bf16(Aa1, __builtin_bit_cast(bf16x8, bs1), d1u, 0, 0, 0);
                f32x4 d1y = __builtin_amdgcn_mfma_f32_16x16x32_bf16(Ar0, __builtin_bit_cast(bf16x8, bs0), zz, 0, 0, 0);
                d1y = __builtin_amdgcn_mfma_f32_16x16x32_bf16(Ar1, __builtin_bit_cast(bf16x8, bs1), d1y, 0, 0, 0);
                v4u bv; bv.x = 0u; bv.y = 0u; bv.z = vb[rt].x; bv.w = vb[rt].y;
                const f32x4 Wm = __builtin_amdgcn_mfma_f32_16x16x32_bf16(ALU, __builtin_bit_cast(bf16x8, bv), d1u, 0, 0, 0);
                v4u bw; bw.x = cvtpk2(Wm[0], Wm[1]); bw.y = cvtpk2(Wm[2], Wm[3]); bw.z = 0u; bw.w = 0u;
                const f32x4 Um = __builtin_amdgcn_mfma_f32_16x16x32_bf16(ALU, __builtin_bit_cast(bf16x8, bw), Wm, 0, 0, 0);
                bw.z = vb[rt].x; bw.w = vb[rt].y;
                Ym[rt] = __builtin_amdgcn_mfma_f32_16x16x32_bf16(ALY, __builtin_bit_cast(bf16x8, bw), d1y, 0, 0, 0);
                v4u bu; bu.x = cvtpk2(Um[0], Um[1]); bu.y = cvtpk2(Um[2], Um[3]); bu.z = vb[rt].x; bu.w = vb[rt].y;
                St[rt][0] = __builtin_amdgcn_mfma_f32_16x16x32_bf16(A40, __builtin_bit_cast(bf16x8, bu), St[rt][0] * pc0, 0, 0, 0);
                St[rt][1] = __builtin_amdgcn_mfma_f32_16x16x32_bf16(A41, __builtin_bit_cast(bf16x8, bu), St[rt][1] * pc1, 0, 0, 0);
                St[rt][2] = __builtin_amdgcn_mfma_f32_16x16x32_bf16(A42, __builtin_bit_cast(bf16x8, bu), St[rt][2] * pc2, 0, 0, 0);
                St[rt][3] = __builtin_amdgcn_mfma_f32_16x16x32_bf16(A43, __builtin_bit_cast(bf16x8, bu), St[rt][3] * pc3, 0, 0, 0);
            }
            asm volatile("s_waitcnt lgkmcnt(0)" ::: "memory");
            if (lane == 0) flags[8 + slot * 2 + wave] = (unsigned)(blk + 1);
#pragma unroll
            for (int rt = 0; rt < 2; ++rt)
#pragma unroll
                for (int e = 0; e < 4; ++e) { const int t = 16 * blk + 4 * g + e, tau = dir ? SEQ - 1 - t : t; YS[(size_t)tau * 512 + 16 * rt] = (bf16)f2bf(Ym[rt][e]); }
        }
    }
    __syncthreads();
}

constexpr int CW_HYQ = 512;
__device__ __forceinline__ void p4_mixers(Frame& F, const Args& AR, bool do_scan, bool do_hy, bool dry) {
    if (F.bid < 128) { if (do_scan) rwkv_scan3(F, AR, F.bid); }
    if (do_hy) {
        volatile LAS unsigned* MISC = (volatile LAS unsigned*)(F.lds + MISC_OFF);
        unsigned* ctr = (unsigned*)F.ws + CW_HYQ + (dry ? 64 : 0);
        for (;;) {
            __syncthreads();
            if (F.tid == 0) MISC[16] = __hip_atomic_fetch_add(ctr, 1u, __ATOMIC_RELAXED, __HIP_MEMORY_SCOPE_AGENT);
            __syncthreads();
            const int c = (int)MISC[16];
            if (c >= 512) break;
            hyena_item(F, AR, c, dry);
        }
    }
}

__device__ __forceinline__ float row16_allsum(float q) { q += dppf<0xB1>(q); q += dppf<0x4E>(q); q += dppf<0x124>(q); q += dppf<0x128>(q); return q; }
__device__ __forceinline__ void p5_combine(Frame& F, const Args& AR, bool dry) {
    unsigned char* ws = F.ws; const int lane = F.lane;
    const int gw = F.bid * NWAVES + F.wave, NGW = F.G * NWAVES;
    {
      bf16* YSF = (bf16*)((unsigned char*)F.out + DO_YSF); const bf16* YSB = (const bf16*)(ws + WS_TOP);
      const bf16* PR = (const bf16*)(ws + WS_PR); const bf16* Gt = (const bf16*)(ws + WS_LW) + (size_t)4 * ((size_t)M * 512);
      const float* BON = (const float*)(ws + WS_BONUS);
      const int hh = gw & 1, ch0 = 256 * hh + 4 * lane, head = 4 * hh + (lane >> 4);
      const f32x4 gnw = *(const f32x4*)(AR.in[22] + ch0), gnb = *(const f32x4*)(AR.in[23] + ch0), muv = *(const f32x4*)(AR.in[13] + 1024 + ch0);
      for (int it0 = gw; it0 < 2 * M; it0 += 2 * NGW) {
          v2u yf[2], yb[2], gg[2], vc[2], vp[2], vn[2]; float bon[2];
#pragma unroll
          for (int e = 0; e < 2; ++e) { const int m = (it0 + e * NGW) >> 1, t = m & (SEQ - 1);
              yf[e] = *(const v2u*)(YSF + (size_t)m * 512 + ch0); yb[e] = *(const v2u*)(YSB + (size_t)m * 512 + ch0); gg[e] = *(const v2u*)(Gt + (size_t)m * 512 + ch0);
              const bf16* p = PR + (size_t)m * PR_P + 1024 + ch0; vc[e] = *(const v2u*)p;
              vp[e] = *(const v2u*)(p - (t > 0 ? PR_P : 0)); vn[e] = *(const v2u*)(p + (t < SEQ - 1 ? PR_P : 0));
              bon[e] = BON[(size_t)m * 8 + head] + BON[((size_t)M + m) * 8 + head]; }
#pragma unroll
          for (int e = 0; e < 2; ++e) { const int m = (it0 + e * NGW) >> 1, t = m & (SEQ - 1);
              const float pm = t > 0 ? 1.f : 0.f, nm = t < SEQ - 1 ? 1.f : 0.f;
              float y[4] = {bflo(yf[e].x) + bflo(yb[e].x), bfhi(yf[e].x) + bfhi(yb[e].x), bflo(yf[e].y) + bflo(yb[e].y), bfhi(yf[e].y) + bfhi(yb[e].y)};
              const float mean = row16_allsum((y[0] + y[1]) + (y[2] + y[3])) * (1.0f / 64.0f);
#pragma unroll
              for (int i = 0; i < 4; ++i) y[i] -= mean;
              const float var = row16_allsum((y[0] * y[0] + y[1] * y[1]) + (y[2] * y[2] + y[3] * y[3])) * (1.0f / 64.0f);
              const float rs = rsqrtf(var + GN_EPS);
              const float vcur[4] = {bflo(vc[e].x), bfhi(vc[e].x), bflo(vc[e].y), bfhi(vc[e].y)};
              const float vprv[4] = {bflo(vp[e].x), bfhi(vp[e].x), bflo(vp[e].y), bfhi(vp[e].y)};
              const float vnxt[4] = {bflo(vn[e].x), bfhi(vn[e].x), bflo(vn[e].y), bfhi(vn[e].y)};
              const float gv[4] = {bflo(gg[e].x), bfhi(gg[e].x), bflo(gg[e].y), bfhi(gg[e].y)};
              float o[4];
#pragma unroll
              for (int i = 0; i < 4; ++i) { const float vx = vcur[i] + muv[i] * (0.5f * (pm * vprv[i] + nm * vnxt[i]) - vcur[i]);
                  o[i] = (y[i] * rs * gnw[i] + gnb[i] + bon[e] * vx) * gv[i]; }
              v2u w; w.x = pk2(o[0], o[1]); w.y = pk2(o[2], o[3]);
              if (!dry) *(v2u*)(YSF + (size_t)m * 512 + ch0) = w; }
      } }
    { const bf16* ZHT = (const bf16*)((unsigned char*)F.out + DO_HT); bf16* ZH = (bf16*)(ws + WS_ZH);
      LAS bf16* tile = (LAS bf16*)(F.lds + F.wave * 9216);
      const int lr = lane >> 3, lc = lane & 7;
      for (int it = gw; it < 8 * NB * 64; it += NGW) {
          const int tb = it & 63, b = (it >> 6) & 7, cbk = it >> 9; const int t0 = tb * 64, c0 = cbk * 64;
          v4u v[8];
#pragma unroll
          for (int i = 0; i < 8; ++i) v[i] = *(const v4u*)(ZHT + ((size_t)(c0 + lr + 8 * i) * NB + b) * SEQ + t0 + 8 * lc);
#pragma unroll
          for (int i = 0; i < 8; ++i) { LAS unsigned* d = (LAS unsigned*)(tile + (lr + 8 * i) * 66 + 8 * lc); d[0] = v[i].x; d[1] = v[i].y; d[2] = v[i].z; d[3] = v[i].w; }
          asm volatile("s_waitcnt lgkmcnt(0)" ::: "memory");
#pragma unroll
          for (int i = 0; i < 8; ++i) { const int tl = lr + 8 * i; unsigned e[8];
#pragma unroll
              for (int k = 0; k < 8; ++k) e[k] = tile[(8 * lc + k) * 66 + tl];
              v4u w; w.x = e[0] | (e[1] << 16); w.y = e[2] | (e[3] << 16); w.z = e[4] | (e[5] << 16); w.w = e[6] | (e[7] << 16);
              *(v4u*)(ZH + ((size_t)b * SEQ + t0 + tl) * 512 + c0 + 8 * lc) = w; }
          asm volatile("s_waitcnt lgkmcnt(0)" ::: "memory");
      }
    }
}

__device__ __forceinline__ void ln1_pass(Frame& F, const Args& AR) {
    const int gw = F.bid * NWAVES + F.wave, NGW = F.G * NWAVES, lane = F.lane;
    const float* H1 = (const float*)(F.ws + WS_H1); float* ST = (float*)(F.ws + WS_STATS); bf16* X1B = (bf16*)(F.ws + WS_X1B);
    const f32x4* w4 = (const f32x4*)AR.in[27]; const f32x4* b4 = (const f32x4*)AR.in[28];
    for (int m = gw; m < M; m += NGW) {
        const f32x4* xr = (const f32x4*)(H1 + (size_t)m * DM) + lane;
        f32x4 v[4]; float s = 0.f;
#pragma unroll
        for (int j = 0; j < 4; ++j) { v[j] = xr[64 * j]; s += (v[j].x + v[j].y) + (v[j].z + v[j].w); }
        const float mean = wave_sum(s) * (1.f / DM); float s2 = 0.f;
#pragma unroll
        for (int j = 0; j < 4; ++j) { v[j] = v[j] - mean; s2 += (v[j].x * v[j].x + v[j].y * v[j].y) + (v[j].z * v[j].z + v[j].w * v[j].w); }
        const float rstd = 1.f / sqrtf(wave_sum(s2) * (1.f / DM) + LN_EPS);
        if (lane == 0) { ST[2 * m] = mean; ST[2 * m + 1] = rstd; }
        v2u* o8 = (v2u*)(X1B + (size_t)m * DM) + lane;
#pragma unroll
        for (int j = 0; j < 4; ++j) { const f32x4 y = v[j] * rstd * w4[64 * j + lane] + b4[64 * j + lane]; v2u o; o.x = pk2(y.x, y.y); o.y = pk2(y.z, y.w); o8[64 * j] = o; }
    }
}
__device__ __forceinline__ void ln2_pass(Frame& F, const Args& AR, bool dry) {
    const int gw = F.bid * NWAVES + F.wave, NGW = F.G * NWAVES, lane = F.lane;
    const f32x4* w4 = (const f32x4*)AR.in[32]; const f32x4* b4 = (const f32x4*)AR.in[33];
    for (int m = gw; m < M; m += NGW) {
        f32x4* xr = (f32x4*)(F.out + (size_t)m * DM) + lane;
        f32x4 v[4]; float s = 0.f;
#pragma unroll
        for (int j = 0; j < 4; ++j) { v[j] = xr[64 * j]; s += (v[j].x + v[j].y) + (v[j].z + v[j].w); }
        const float mean = wave_sum(s) * (1.f / DM); float s2 = 0.f;
#pragma unroll
        for (int j = 0; j < 4; ++j) { v[j] = v[j] - mean; s2 += (v[j].x * v[j].x + v[j].y * v[j].y) + (v[j].z * v[j].z + v[j].w * v[j].w); }
        const float rstd = 1.f / sqrtf(wave_sum(s2) * (1.f / DM) + LN_EPS);
#pragma unroll
        for (int j = 0; j < 4; ++j) { const f32x4 y = v[j] * rstd * w4[64 * j + lane] + b4[64 * j + lane]; if (!dry) xr[64 * j] = y; }
    }
}

#define XB_TMO      128
#define XB_XCNT(j)  (256  + 64 * (j))
#define XB_XSUB(j)  (1280 + 64 * (j))
#define XB_XGEN(j)  (2304 + 64 * (j))
#define XB_TOP      3328
#define XB_TOPGEN   3392
#define XCD_BAR_WORDS 3456
#define XB_SPIN_CAP (1u << 18)

__device__ __forceinline__ unsigned xb_ld(unsigned* p)              { return __hip_atomic_load(p, __ATOMIC_RELAXED, __HIP_MEMORY_SCOPE_AGENT); }
__device__ __forceinline__ unsigned xb_add(unsigned* p, unsigned v) { return __hip_atomic_fetch_add(p, v, __ATOMIC_RELAXED, __HIP_MEMORY_SCOPE_AGENT); }
__device__ __forceinline__ unsigned xb_xcc_id() { return (unsigned)__builtin_amdgcn_s_getreg((3 << 11) | 20) & 0xFu; }
#define XB_SPIN(cond, bar) do { unsigned _sp = 0; while (cond) { __builtin_amdgcn_s_sleep(1); \
    if ((++_sp & 255u) == 0u) { if (xb_ld(&(bar)[XB_TMO])) break; if (_sp > XB_SPIN_CAP) { atomicAdd(&(bar)[XB_TMO], 1u); break; } } } } while (0)

struct XcdBarrier {
    unsigned* bar; unsigned x;
    volatile LAS unsigned* st;
};

__device__ __forceinline__ XcdBarrier xcd_barrier_post(unsigned* bar, volatile LAS unsigned* st) {
    XcdBarrier b; b.bar = bar; b.x = xb_xcc_id(); b.st = st;
    if (threadIdx.x == 0) (void)xb_add(&bar[XB_XCNT(b.x)], 1u);
    return b;
}
__device__ __forceinline__ void xcd_barrier_complete(unsigned* bar, unsigned x, unsigned& nloc, unsigned& nx) {
    const unsigned G = gridDim.x * gridDim.y * gridDim.z;
    unsigned sum, cnt, mine, sp = 0u;
    for (;;) {
        sum = 0u; cnt = 0u; mine = 0u;
#pragma unroll
        for (unsigned j = 0; j < 16; ++j) { const unsigned c = xb_ld(&bar[XB_XCNT(j)]); sum += c; cnt += (c > 0u) ? 1u : 0u; mine = (j == x) ? c : mine; }
        if (sum == G) break;
        __builtin_amdgcn_s_sleep(1);
        if ((++sp & 255u) == 0u) { if (xb_ld(&bar[XB_TMO])) break; if (sp > XB_SPIN_CAP) { atomicAdd(&bar[XB_TMO], 1u); break; } }
    }
    nloc = mine > 0u ? mine : 1u; nx = cnt > 0u ? cnt : 1u;
}

__device__ __forceinline__ void xcd_barrier(const XcdBarrier& b) {
    asm volatile("s_waitcnt vmcnt(0)" ::: "memory");
    __syncthreads();
    if (threadIdx.x == 0) {
        unsigned* bar = b.bar;
        __builtin_amdgcn_s_waitcnt(0);
        unsigned nloc = b.st[0], nx = b.st[1];
        if (nloc == 0u) { xcd_barrier_complete(bar, b.x, nloc, nx); b.st[0] = nloc; b.st[1] = nx; }
        const unsigned old = xb_add(&bar[XB_XSUB(b.x)], 1u);
        const unsigned gen = old / nloc;
        if (old + 1u == (gen + 1u) * nloc) {
            __builtin_amdgcn_fence(__ATOMIC_RELEASE, "agent");
            asm volatile("s_waitcnt vmcnt(0)" ::: "memory");
            const unsigned og = xb_add(&bar[XB_TOP], 1u);
            const unsigned tg = og / nx;
            if (og + 1u == (tg + 1u) * nx) xb_add(&bar[XB_TOPGEN], 1u);
            else XB_SPIN(xb_ld(&bar[XB_TOPGEN]) == tg, bar);
            __builtin_amdgcn_fence(__ATOMIC_ACQUIRE, "agent");
            xb_add(&bar[XB_XGEN(b.x)], 1u);
            asm volatile("s_waitcnt vmcnt(0)" ::: "memory");
        } else {
            XB_SPIN(xb_ld(&bar[XB_XGEN(b.x)]) == gen, bar);
            __builtin_amdgcn_fence(__ATOMIC_ACQUIRE, "agent");
            asm volatile("s_waitcnt vmcnt(0)" ::: "memory");
        }
    }
    __syncthreads();
}

constexpr int LDS_BYTES = 147456;
constexpr int N_PHASES = 13;
constexpr int CW_BAR = 1024;
#ifndef PROBE_DUP
#define PROBE_DUP -1
#endif
#ifndef PROBE_SUB
#define PROBE_SUB 0
#endif

__global__ void __launch_bounds__(512, 2) hybrid_fwd(Args args) {
    extern __shared__ __attribute__((aligned(16))) unsigned char lds_raw[];
    Frame F;
    F.lds = (LAS unsigned char*)lds_raw;
    F.tid = threadIdx.x; F.lane = F.tid & 63; F.wave = __builtin_amdgcn_readfirstlane(F.tid >> 6);
    F.G = gridDim.x; F.bid = blockIdx.x;
    F.out = args.out; F.ws = args.ws;
    unsigned char* ws = args.ws;
    volatile LAS unsigned* MISC = (volatile LAS unsigned*)(F.lds + MISC_OFF);
    if (F.tid < 32) MISC[F.tid] = 0u;
    __syncthreads();
    XcdBarrier bar = xcd_barrier_post((unsigned*)ws + CW_BAR, MISC + 8);
    const int lo = args.ph_lo, hi = args.ph_hi;
#define IN(k) (lo <= (k) && (k) < hi)
#define SEAM(k) do { if (IN(k) && IN((k) + 1)) xcd_barrier(bar); } while (0)
    using pg8::Gemm; using pg8::StaticOrder; using pg8::gemm_phase;

#define REP(k) for (int rep = 0; rep < ((PROBE_DUP == (k)) ? 2 : 1); ++rep, ((PROBE_DUP == (k)) ? xcd_barrier(bar) : (void)0))
    if (IN(0)) REP(0) { p0_prologue(F, args); } SEAM(0);
    if (IN(1)) REP(1) {
        Gemm g{(const bf16*)(ws + WS_XB), (const bf16*)(ws + WS_WIN), M, NP, DM}; StaticOrder S; S.init(M, NP, F.G, F.bid);
        EpiProj E{(bf16*)(ws + WS_PH), (bf16*)(ws + WS_PR), (bf16*)(ws + WS_PG)};
        gemm_phase<EpiProj, StaticOrder, true, true>(F.lds, g, S, E);
    } SEAM(1);
    if (IN(2)) REP(2) { p2_prep(F, args); } SEAM(2);
    if (IN(3)) REP(3) {
        Gemm g{(const bf16*)(ws + WS_TOP), (const bf16*)(ws + WS_WLORA), M, LORA_N, LORA_K}; StaticOrder S; S.init(M, LORA_N, F.G, F.bid);
        EpiLora E{(bf16*)(ws + WS_LW)};
        gemm_phase<EpiLora, StaticOrder, true, true>(F.lds, g, S, E);
    } SEAM(3);
    if (IN(4)) { if (PROBE_DUP == 4) { p4_mixers(F, args, PROBE_SUB != 2, PROBE_SUB != 1, true); xcd_barrier(bar); } p4_mixers(F, args, true, true, false); } SEAM(4);
    if (IN(5)) REP(5) { p5_combine(F, args, (PROBE_DUP == 5) && rep == 0); } SEAM(5);
    if (IN(6)) REP(6) {
        Gemm g{(const bf16*)(ws + WS_ZH), (const bf16*)(ws + WS_WHY), M, DM, 512}; StaticOrder S; S.init(M, DM, F.G, F.bid);
        EpiGate<0> E{(const bf16*)(ws + WS_PG), (bf16*)(ws + WS_T), nullptr};
        gemm_phase<EpiGate<0>, StaticOrder, true, true>(F.lds, g, S, E);
    } SEAM(6);
    if (IN(7)) REP(7) {
        Gemm g{(const bf16*)((unsigned char*)F.out + DO_YSF), (const bf16*)(ws + WS_WRW), M, DM, 512}; StaticOrder S; S.init(M, DM, F.G, F.bid);
        EpiGate<1> E{(const bf16*)(ws + WS_PG), (bf16*)(ws + WS_T), (bf16*)(ws + WS_MIXIN)};
        gemm_phase<EpiGate<1>, StaticOrder, true, true>(F.lds, g, S, E);
    } SEAM(7);
    if (IN(8)) REP(8) {
        Gemm g{(const bf16*)(ws + WS_MIXIN), (const bf16*)(ws + WS_WO), M, DM, DM}; StaticOrder S; S.init(M, DM, F.G, F.bid);
        EpiWo E{args.in[0], (float*)(ws + WS_H1)};
        gemm_phase<EpiWo, StaticOrder, true, true>(F.lds, g, S, E);
    } SEAM(8);
    if (IN(9)) REP(9) { ln1_pass(F, args); } SEAM(9);
    if (IN(10)) REP(10) {
        Gemm g{(const bf16*)(ws + WS_X1B), (const bf16*)(ws + WS_WGU), M, NGU, DM}; StaticOrder S; S.init(M, NGU, F.G, F.bid);
        EpiSwiGLU E{(bf16*)(ws + WS_HID)};
        gemm_phase<EpiSwiGLU, StaticOrder, true, true>(F.lds, g, S, E);
    } SEAM(10);
    if (IN(11)) REP(11) {
        Gemm g{(const bf16*)(ws + WS_HID), (const bf16*)(ws + WS_WD), M, DM, FFH}; StaticOrder S; S.init(M, DM, F.G, F.bid);
        EpiDown E{(const float*)(ws + WS_H1), (const float*)(ws + WS_STATS), args.in[27], args.in[28], F.out};
        gemm_phase<EpiDown, StaticOrder, true, true>(F.lds, g, S, E);
    } SEAM(11);
    if (IN(12)) REP(12) { ln2_pass(F, args, (PROBE_DUP == 12) && rep == 0); }
#undef IN
#undef SEAM
}

extern "C" void kernel_launch(void* const* d_in, const int* in_sizes, int n_in, void* d_out, int out_size, void* d_ws, size_t ws_size, hipStream_t stream) {
    static int grid = 0;
    if (grid == 0) {
        if (n_in != 34 || out_size != M * DM || ws_size < WS_NEED) { fprintf(stderr, "kernel_launch: unexpected shapes (n_in %d out %d ws %zu)\n", n_in, out_size, ws_size); grid = -1; return; }
        int dev = 0, cus = 0, per_cu = 0;
        if (hipGetDevice(&dev) != hipSuccess || hipDeviceGetAttribute(&cus, hipDeviceAttributeMultiprocessorCount, dev) != hipSuccess) { grid = -1; return; }
        if (hipFuncSetAttribute((const void*)hybrid_fwd, hipFuncAttributeMaxDynamicSharedMemorySize, LDS_BYTES) != hipSuccess) { fprintf(stderr, "kernel_launch: hipFuncSetAttribute failed\n"); grid = -1; return; }
        if (hipOccupancyMaxActiveBlocksPerMultiprocessor(&per_cu, (const void*)hybrid_fwd, 512, LDS_BYTES) != hipSuccess || per_cu < 1) { fprintf(stderr, "kernel_launch: occupancy query says %d\n", per_cu); per_cu = 1; }
        (void)hipGetLastError();
        grid = cus;
        if (grid != 256) fprintf(stderr, "kernel_launch: %d CUs (built for 256)\n", grid);
    }
    if (grid < 0) return;
    Args a{};
    for (int i = 0; i < 34; ++i) a.in[i] = (const float*)d_in[i];
    a.out = (float*)d_out; a.ws = (unsigned char*)d_ws; a.ph_lo = 0; a.ph_hi = N_PHASES;
    if (hipMemsetAsync(d_ws, 0, 65536, stream) != hipSuccess) { fprintf(stderr, "kernel_launch: memset failed\n"); return; }
    hipLaunchKernelGGL(hybrid_fwd, dim3(grid), dim3(512), LDS_BYTES, stream, a);
    const hipError_t e = hipPeekAtLastError();
    if (e != hipSuccess) fprintf(stderr, "kernel_launch: launch failed: %s\n", hipGetErrorString(e));
}
```
